# Optimizing an MI355X kernel written in HIP

```python
import math
import jax, jax.numpy as jnp
from jax import lax
import numpy as np

D_MODEL = 2048
BATCH = 2
SEQ = 4096
DEPTH = 1

MIX_WIDTH = D_MODEL
ATTN_HEAD_DIM = 64
ATTN_WIDTH = MIX_WIDTH // 2
ATTN_HEADS = ATTN_WIDTH // ATTN_HEAD_DIM
DILATION_PATTERNS = ((128, 1), (512, 4), (2048, 16))
QBLK = 128
GLA_WIDTH = MIX_WIDTH - ATTN_WIDTH
GLA_HEADS = 4
GLA_KEY_WIDTH = GLA_WIDTH // 2
GLA_HEAD_DK = GLA_KEY_WIDTH // GLA_HEADS
GLA_HEAD_DV = GLA_WIDTH // GLA_HEADS
GLA_GATE_RANK = 16
GLA_GATE_TAU = 16.0
GLA_CHUNK = 64
FFN_HIDDEN = -(-(8 * D_MODEL) // (3 * 256)) * 256
REL_BUCKETS = 32
REL_MAX_DISTANCE = 1024
NORM_EPS = 1e-6
IN_SIZES = (ATTN_WIDTH, ATTN_WIDTH, ATTN_WIDTH,
            GLA_KEY_WIDTH, GLA_KEY_WIDTH, GLA_WIDTH, GLA_WIDTH, 2 * GLA_GATE_RANK)
IN_WIDTH = 3 * ATTN_WIDTH + 2 * GLA_KEY_WIDTH + 2 * GLA_WIDTH + 2 * GLA_GATE_RANK

kernel_name = "hybrid_dilated_attn_gla_encoder_layer"


def rmsnorm(x, w):
    x32 = x.astype(jnp.float32)
    y = x32 * lax.rsqrt(jnp.mean(x32 * x32, axis=-1, keepdims=True) + NORM_EPS)
    return y.astype(x.dtype) * w


def _t5_bucket(rel):
    nb = REL_BUCKETS // 2
    ret = np.where(rel > 0, nb, 0)
    n = np.abs(rel)
    max_exact = nb // 2
    large = max_exact + (np.log(np.maximum(n, 1) / max_exact)
                         / math.log(REL_MAX_DISTANCE / max_exact)
                         * (nb - max_exact)).astype(np.int64)
    large = np.minimum(large, nb - 1)
    return (ret + np.where(n < max_exact, n, large)).astype(np.int32)


def _band_layout(L, radius, dilation):
    nb = -(-L // QBLK)
    span = QBLK + 2 * radius
    key_idx = np.arange(nb)[:, None] * QBLK + np.arange(span)[None, :]
    kpos = key_idx - radius
    qpos = np.arange(nb)[:, None] * QBLK + np.arange(QBLK)[None, :]
    off = kpos[:, None, :] - qpos[:, :, None]
    valid = (np.abs(off) <= radius) & (kpos[:, None, :] >= 0) & (kpos[:, None, :] < L)
    bucket = _t5_bucket(off[0] * dilation)
    return nb, key_idx, valid, bucket


def _from_sub(t, L, S):
    B, H, r = t.shape[:3]
    rest = t.shape[5:]
    t = t.reshape((B, H, r, -1) + rest)[:, :, :, :L]
    t = jnp.swapaxes(t, 2, 3)
    return t.reshape((B, H, S) + rest)


def dilated_window_attention(q, k, v, rel_table, window, dilation):
    B, H, S, Dh = q.shape
    L = S // dilation
    R = (window // 2) // dilation
    nb, key_idx, valid, bucket = _band_layout(L, R, dilation)
    Lp = nb * QBLK

    def to_sub(t):
        return t.reshape(B, H, L, dilation, Dh).transpose(0, 1, 3, 2, 4)

    zpad = ((0, 0), (0, 0), (0, 0))
    qs = jnp.pad(to_sub(q), zpad + ((0, Lp - L), (0, 0)))
    ks = jnp.pad(to_sub(k), zpad + ((R, Lp - L + R), (0, 0)))
    vs = jnp.pad(to_sub(v), zpad + ((R, Lp - L + R), (0, 0)))
    qb = qs.reshape(B, H, dilation, nb, QBLK, Dh)
    kb = ks[:, :, :, key_idx]
    vb = vs[:, :, :, key_idx]

    bias = jnp.transpose(rel_table[bucket].astype(jnp.float32), (2, 0, 1))
    logits = (jnp.einsum('bhrnqd,bhrnkd->bhrnqk', qb, kb).astype(jnp.float32)
              * (Dh ** -0.5) + bias[None, :, None, None])
    logits = jnp.where(valid[None, None, None], logits, -1e30)
    m = jnp.max(logits, axis=-1, keepdims=True)
    p = jnp.exp(logits - m)
    s = jnp.sum(p, axis=-1, keepdims=True)
    o = jnp.einsum('bhrnqk,bhrnkd->bhrnqd', p, vb.astype(jnp.float32)) / s
    lse = (m + jnp.log(s))[..., 0]
    return _from_sub(o, L, S), _from_sub(lse, L, S)


def mixture_of_dilations(q, k, v, rel_table):
    outs, lses = [], []
    for window, dilation in DILATION_PATTERNS:
        o, l = dilated_window_attention(q, k, v, rel_table, window, dilation)
        outs.append(o)
        lses.append(l)
    w = jax.nn.softmax(jnp.stack(lses, axis=0), axis=0)
    out = sum(w[i][..., None] * outs[i] for i in range(len(outs)))
    return out


def gla_causal(q, k, v, log_a):
    B, H, S, Dk = q.shape
    Dv = v.shape[-1]
    n = S // GLA_CHUNK
    qc = q.astype(jnp.float32).reshape(B, H, n, GLA_CHUNK, Dk)
    kc = k.astype(jnp.float32).reshape(B, H, n, GLA_CHUNK, Dk)
    vc = v.astype(jnp.float32).reshape(B, H, n, GLA_CHUNK, Dv)
    G = jnp.cumsum(log_a.astype(jnp.float32).reshape(B, H, n, GLA_CHUNK, Dk), axis=-2)
    q_in = qc * jnp.exp(G)
    k_in = kc * jnp.exp(-G)
    tril = jnp.tril(jnp.ones((GLA_CHUNK, GLA_CHUNK), jnp.float32))
    A = jnp.einsum('bhncd,bhnjd->bhncj', q_in, k_in) * tril
    intra = jnp.einsum('bhncj,bhnjv->bhncv', A, vc)
    G_last = G[..., -1:, :]
    k_end = kc * jnp.exp(G_last - G)
    U = jnp.einsum('bhnjd,bhnjv->bhndv', k_end, vc)
    decay = jnp.exp(G_last[..., 0, :])

    def step(state, inp):
        dec, u = inp
        return state * dec[..., None] + u, state

    _, S_prev = lax.scan(step, jnp.zeros((B, H, Dk, Dv), jnp.float32),
                         (jnp.moveaxis(decay, 2, 0), jnp.moveaxis(U, 2, 0)))
    S_prev = jnp.moveaxis(S_prev, 0, 2)
    inter = jnp.einsum('bhncd,bhndv->bhncv', q_in, S_prev)
    return (intra + inter).reshape(B, H, S, Dv)


def _heads(t, n_heads):
    B, S, W = t.shape
    return t.reshape(B, S, n_heads, W // n_heads).transpose(0, 2, 1, 3)


def _merge_heads(t):
    B, H, S, Dh = t.shape
    return t.transpose(0, 2, 1, 3).reshape(B, S, H * Dh)


def setup_inputs(seed: int = 0) -> dict:
    key = jax.random.key(seed)
    ks = jax.random.split(key, 16)
    f32 = jnp.float32
    nrm = lambda k, shape, scale: jax.random.normal(k, shape, f32) * scale
    return {
        "x": nrm(ks[0], (BATCH, SEQ, D_MODEL), 1.0),
        "attn_norm_w": 1.0 + nrm(ks[1], (DEPTH, D_MODEL), 0.02),
        "w_in": nrm(ks[2], (DEPTH, D_MODEL, IN_WIDTH), D_MODEL ** -0.5),
        "rel_bias_table": nrm(ks[3], (REL_BUCKETS, ATTN_HEADS), 0.3),
        "gla_gate_w_fwd": nrm(ks[4], (DEPTH, GLA_GATE_RANK, GLA_KEY_WIDTH), GLA_GATE_RANK ** -0.5),
        "gla_gate_b_fwd": nrm(ks[5], (DEPTH, GLA_KEY_WIDTH), 0.1),
        "gla_gate_w_bwd": nrm(ks[6], (DEPTH, GLA_GATE_RANK, GLA_KEY_WIDTH), GLA_GATE_RANK ** -0.5),
        "gla_gate_b_bwd": nrm(ks[7], (DEPTH, GLA_KEY_WIDTH), 0.1),
        "gla_norm_w": 1.0 + nrm(ks[8], (DEPTH, GLA_WIDTH), 0.02),
        "w_out": nrm(ks[9], (DEPTH, MIX_WIDTH, D_MODEL), MIX_WIDTH ** -0.5),
        "ffn_norm_w": 1.0 + nrm(ks[10], (DEPTH, D_MODEL), 0.02),
        "w_gate": nrm(ks[11], (DEPTH, D_MODEL, FFN_HIDDEN), D_MODEL ** -0.5),
        "w_up": nrm(ks[12], (DEPTH, D_MODEL, FFN_HIDDEN), D_MODEL ** -0.5),
        "w_down": nrm(ks[13], (DEPTH, FFN_HIDDEN, D_MODEL), FFN_HIDDEN ** -0.5),
        "final_norm_w": 1.0 + nrm(ks[14], (D_MODEL,), 0.02),
    }


def reference(x, attn_norm_w, w_in, rel_bias_table, gla_gate_w_fwd, gla_gate_b_fwd,
              gla_gate_w_bwd, gla_gate_b_bwd, gla_norm_w, w_out, ffn_norm_w,
              w_gate, w_up, w_down, final_norm_w):
    split_idx = []
    acc = 0
    for size in IN_SIZES[:-1]:
        acc += size
        split_idx.append(acc)

    for l in range(DEPTH):
        h = rmsnorm(x, attn_norm_w[l])
        proj = h @ w_in[l]
        aq, ak, av, gq, gk, gv, gr, glr = jnp.split(proj, split_idx, axis=-1)

        attn = mixture_of_dilations(_heads(aq, ATTN_HEADS), _heads(ak, ATTN_HEADS),
                                    _heads(av, ATTN_HEADS), rel_bias_table)
        attn_out = _merge_heads(attn).astype(x.dtype)

        lr_f, lr_b = glr[..., :GLA_GATE_RANK], glr[..., GLA_GATE_RANK:]
        log_a_f = jax.nn.log_sigmoid((lr_f @ gla_gate_w_fwd[l] + gla_gate_b_fwd[l])
                                     .astype(jnp.float32)) / GLA_GATE_TAU
        log_a_b = jax.nn.log_sigmoid((lr_b @ gla_gate_w_bwd[l] + gla_gate_b_bwd[l])
                                     .astype(jnp.float32)) / GLA_GATE_TAU
        qh = _heads(gq, GLA_HEADS) * (GLA_HEAD_DK ** -0.5)
        kh = _heads(gk, GLA_HEADS)
        vh = _heads(gv, GLA_HEADS)
        fwd = gla_causal(qh, kh, vh, _heads(log_a_f, GLA_HEADS))
        flip = lambda t: jnp.flip(t, axis=2)
        bwd = flip(gla_causal(flip(qh), flip(kh), flip(vh), flip(_heads(log_a_b, GLA_HEADS))))
        o = fwd + bwd
        o = o * lax.rsqrt(jnp.mean(o * o, axis=-1, keepdims=True) + NORM_EPS)
        gla_out = (_merge_heads(o).astype(x.dtype) * gla_norm_w[l]) * jax.nn.silu(gr)

        mixed = jnp.concatenate([attn_out, gla_out], axis=-1) @ w_out[l]
        x = x + mixed

        h = rmsnorm(x, ffn_norm_w[l])
        x = x + (jax.nn.silu(h @ w_gate[l]) * (h @ w_up[l])) @ w_down[l]

    return rmsnorm(x, final_norm_w)
```

```cpp
#include <hip/hip_runtime.h>
#include <hip/hip_cooperative_groups.h>
#include <cstdio>
#include <cstdint>
namespace cg = cooperative_groups;

namespace pg8 {
#define PG8_LAS __attribute__((address_space(3)))
typedef unsigned short bf16_t;
typedef short bf16x8 __attribute__((ext_vector_type(8)));
typedef float f32x4 __attribute__((ext_vector_type(4)));
typedef unsigned u32x4 __attribute__((ext_vector_type(4)));
constexpr int BM = 256, BK = 64, HALF = 128, HTB = HALF * BK * 2  , STAGE_BYTES = 8 * HTB, NXCD = 8, WGM = 8;

__host__ __device__ __forceinline__ int lds_byte(int r, int c) { const int st = (r >> 4) * 2 + (c >> 5), rr = r & 15, cc = c & 31, ob = rr * 64 + cc * 2; return st * 1024 + (ob ^ (((ob >> 9) & 1) << 5)); }
__host__ __device__ __forceinline__ void stage_rc(int b, int& R, int& C) { const int st = b / 1024, sb = b % 1024, swz = sb ^ (((sb >> 9) & 1) << 5); R = (st >> 1) * 16 + swz / 64; C = (st & 1) * 32 + (swz % 64) / 2; }
__host__ __device__ __forceinline__ int perm32(int rho) { const int n = rho >> 4, i = rho & 15; return 8 * (i >> 2) + 4 * n + (i & 3); }

struct Unit { int pm, pn; };
struct Gemm { const bf16_t* A; const bf16_t* Bt; int M, N, K; };

struct StaticOrder {
    int nM, nN, nwg, G, c;
    __host__ __device__ void init(int M, int N, int G_, int c_) { nM = M / BM; nN = N / BM; nwg = nM * nN; G = G_; c = c_; }
    __host__ __device__ bool next(int i, Unit& u) const {
        const long L = (long)i * G + c; if (L >= nwg) return false;
        int wgid = (int)L; { const int q = nwg / NXCD, r = nwg % NXCD, xcd = wgid % NXCD, off = wgid / NXCD; wgid = (xcd < r ? xcd * (q + 1) : r * (q + 1) + (xcd - r) * q) + off; }
        const int nig = WGM * nN, gid = wgid / nig, fm = gid * WGM, gsz = (nM - fm) < WGM ? (nM - fm) : WGM;
        u.pm = fm + ((wgid % nig) % gsz); u.pn = (wgid % nig) / gsz; return true;
    }
    __device__ __forceinline__ void a_ready(const Unit&) const {}
    __device__ __forceinline__ void done(const Unit&) const {}
};

__device__ __forceinline__ unsigned cvt_pk_bf16(float lo, float hi) { unsigned r; asm volatile("v_cvt_pk_bf16_f32 %0, %1, %2" : "=v"(r) : "v"(lo), "v"(hi)); return r; }
template <class Epi, class Sched, bool ALIGN_EPI = false, bool SP2 = false>
__device__ __forceinline__ void gemm_phase(PG8_LAS unsigned char* lds, const Gemm g, const Sched& S, const Epi& E) {
    const int tid = threadIdx.x, wid = __builtin_amdgcn_readfirstlane(tid >> 6), lane = tid & 63, wr = wid >> 2, wc = wid & 3, fr = lane & 15, fq = lane >> 4;
    const int K = g.K, nt = K / BK;
    unsigned voffA[2], voffB[2];
#pragma unroll
    for (int i = 0; i < 2; ++i) { int R, C; stage_rc(tid * 16 + i * 8192, R, C); const int Rb = Epi::PERM ? ((R & ~31) + perm32(R & 31)) : R;
        voffA[i] = (unsigned)(R * K + C) * 2u; voffB[i] = (unsigned)(Rb * K + C) * 2u; }
    const size_t kstep = (size_t)(BK * 2);
    const size_t hstep = (size_t)HALF * K * 2;
    const size_t tstep = 2 * hstep;
    const unsigned ldsw = (unsigned)wid * 1024u;
    const int aoff = lds_byte(wr * 64 + fr, fq * 8), boff = lds_byte(wc * 32 + fr, fq * 8);
#define PG8_SA(b, h) (((b) * 2 + (h)) * HTB)
#define PG8_SB(b, h) ((4 + (b) * 2 + (h)) * HTB)
#define PG8_STAGE(bufoff, gbase, voff) do { _Pragma("unroll") for (int _i = 0; _i < 2; ++_i) \
        __builtin_amdgcn_global_load_lds((const unsigned*)((const char*)(gbase) + (voff)[_i]), (PG8_LAS unsigned*)(lds + (bufoff) + ldsw + _i * 8192), 16, 0, 0); } while (0)
#define PG8_LDA(dst, b, h) do { _Pragma("unroll") for (int m = 0; m < 4; ++m) _Pragma("unroll") for (int k = 0; k < 2; ++k) dst[m][k] = *(const PG8_LAS bf16x8*)(lds + PG8_SA(b, h) + aoff + m * 2048 + k * 1024); } while (0)
#define PG8_LDB(dst, b, h) do { _Pragma("unroll") for (int n = 0; n < 2; ++n) _Pragma("unroll") for (int k = 0; k < 2; ++k) dst[n][k] = *(const PG8_LAS bf16x8*)(lds + PG8_SB(b, h) + boff + n * 2048 + k * 1024); } while (0)
#define PG8_MMA(ai, bj, At, Bt) do { __builtin_amdgcn_s_setprio(1); _Pragma("unroll") for (int m = 0; m < 4; ++m) _Pragma("unroll") for (int n = 0; n < 2; ++n) _Pragma("unroll") for (int k = 0; k < 2; ++k) \
        acc[ai][bj][m][n] = __builtin_amdgcn_mfma_f32_16x16x32_bf16(Bt[n][k], At[m][k], acc[ai][bj][m][n], 0, 0, 0); __builtin_amdgcn_s_setprio(0); } while (0)
#define PG8_WAIT_V(n) asm volatile("s_waitcnt vmcnt(" #n ")" ::: "memory")
#define PG8_WAIT_L(n) asm volatile("s_waitcnt lgkmcnt(" #n ")" ::: "memory")
#define PG8_BAR __builtin_amdgcn_s_barrier()
#define PG8_SCHED __builtin_amdgcn_sched_barrier(0)
    Unit cur, nxt; int ui = 0;
    if (!S.next(0, cur)) return;
    f32x4 acc[2][2][4][2];
#pragma unroll
    for (int a = 0; a < 2; ++a)
#pragma unroll
        for (int b = 0; b < 2; ++b)
#pragma unroll
            for (int m = 0; m < 4; ++m)
#pragma unroll
                for (int n = 0; n < 2; ++n) acc[a][b][m][n] = (f32x4){0.f, 0.f, 0.f, 0.f};
    bf16x8 At[4][2], B0[2][2], B1[2][2];
    const char* cA = (const char*)g.A + (size_t)cur.pm * tstep; const char* cB = (const char*)g.Bt + (size_t)cur.pn * tstep;
    S.a_ready(cur);
    if constexpr (SP2) {
        PG8_STAGE(PG8_SB(0, 0), cB, voffB); PG8_STAGE(PG8_SB(0, 1), cB + hstep, voffB); PG8_STAGE(PG8_SA(0, 0), cA, voffA); PG8_STAGE(PG8_SA(0, 1), cA + hstep, voffA);
        if (wr == 1) PG8_BAR;
        PG8_WAIT_V(2); PG8_BAR;
        PG8_STAGE(PG8_SB(1, 0), cB + kstep, voffB); PG8_STAGE(PG8_SA(1, 0), cA + kstep, voffA); PG8_STAGE(PG8_SB(1, 1), cB + hstep + kstep, voffB);
        PG8_WAIT_V(6); PG8_BAR;
    } else {
        PG8_STAGE(PG8_SB(0, 0), cB, voffB); PG8_STAGE(PG8_SA(0, 0), cA, voffA); PG8_STAGE(PG8_SB(0, 1), cB + hstep, voffB); PG8_STAGE(PG8_SA(0, 1), cA + hstep, voffA);
        if (wr == 1) PG8_BAR;
        PG8_WAIT_V(4); PG8_BAR;
        PG8_STAGE(PG8_SB(1, 0), cB + kstep, voffB); PG8_STAGE(PG8_SA(1, 0), cA + kstep, voffA); PG8_STAGE(PG8_SB(1, 1), cB + hstep + kstep, voffB);
        PG8_WAIT_V(6); PG8_BAR;
    }
    for (;;) {
        const bool has_next = S.next(ui + 1, nxt);
        const char* nA = has_next ? (const char*)g.A + (size_t)nxt.pm * tstep : cA; const char* nB = has_next ? (const char*)g.Bt + (size_t)nxt.pn * tstep : cB;
        for (int t = 0; t < nt; t += 2) {
            const bool last = (t == nt - 2);
            const char* a1 = cA + (size_t)(t + 1) * kstep;
            const char* a2 = last ? nA : cA + (size_t)(t + 2) * kstep; const char* b2 = last ? nB : cB + (size_t)(t + 2) * kstep;
            const char* a3 = a2 + kstep; const char* b3 = b2 + kstep;
            if (last && has_next) S.a_ready(nxt);
            if constexpr (SP2) {
            PG8_LDB(B0, 0, 0); PG8_LDB(B1, 0, 1); PG8_SCHED; PG8_LDA(At, 0, 0); PG8_STAGE(PG8_SA(1, 1), a1 + hstep, voffA);
            PG8_WAIT_V(8); PG8_WAIT_L(0); PG8_BAR; PG8_MMA(0, 0, At, B0); PG8_MMA(0, 1, At, B1); PG8_BAR; PG8_SCHED;
            PG8_LDA(At, 0, 1); PG8_STAGE(PG8_SB(0, 0), b2, voffB); PG8_STAGE(PG8_SB(0, 1), b2 + hstep, voffB); PG8_STAGE(PG8_SA(0, 0), a2, voffA);
            PG8_WAIT_V(8); PG8_WAIT_L(0); PG8_BAR; PG8_MMA(1, 0, At, B0); PG8_MMA(1, 1, At, B1); PG8_BAR; PG8_SCHED;
            PG8_LDB(B0, 1, 0); PG8_LDB(B1, 1, 1); PG8_SCHED; PG8_LDA(At, 1, 0); PG8_STAGE(PG8_SA(0, 1), a2 + hstep, voffA);
            PG8_WAIT_V(8); PG8_WAIT_L(0); PG8_BAR; PG8_MMA(0, 0, At, B0); PG8_MMA(0, 1, At, B1); PG8_BAR; PG8_SCHED;
            PG8_LDA(At, 1, 1); PG8_STAGE(PG8_SB(1, 0), b3, voffB); PG8_STAGE(PG8_SB(1, 1), b3 + hstep, voffB); PG8_STAGE(PG8_SA(1, 0), a3, voffA);
            PG8_WAIT_V(8); PG8_WAIT_L(0); PG8_BAR; PG8_MMA(1, 0, At, B0); PG8_MMA(1, 1, At, B1); PG8_BAR; PG8_SCHED;
            } else {
            PG8_LDB(B0, 0, 0); PG8_SCHED; PG8_LDA(At, 0, 0); PG8_STAGE(PG8_SA(1, 1), a1 + hstep, voffA);
            PG8_WAIT_L(8); PG8_BAR; PG8_WAIT_L(0); PG8_MMA(0, 0, At, B0); PG8_BAR; PG8_SCHED;
            PG8_LDB(B1, 0, 1); PG8_STAGE(PG8_SB(0, 0), b2, voffB);
            PG8_BAR; PG8_WAIT_L(0); PG8_MMA(0, 1, At, B1); PG8_BAR;
            PG8_LDA(At, 0, 1); PG8_STAGE(PG8_SA(0, 0), a2, voffA);
            PG8_BAR; PG8_WAIT_L(0); PG8_MMA(1, 0, At, B0); PG8_BAR; PG8_SCHED;
            PG8_STAGE(PG8_SB(0, 1), b2 + hstep, voffB);
            PG8_WAIT_V(6); PG8_BAR; PG8_MMA(1, 1, At, B1); PG8_BAR;
            PG8_LDB(B0, 1, 0); PG8_SCHED; PG8_LDA(At, 1, 0); PG8_STAGE(PG8_SA(0, 1), a2 + hstep, voffA);
            PG8_WAIT_L(8); PG8_BAR; PG8_WAIT_L(0); PG8_MMA(0, 0, At, B0); PG8_BAR; PG8_SCHED;
            PG8_LDB(B1, 1, 1); PG8_STAGE(PG8_SB(1, 0), b3, voffB);
            PG8_BAR; PG8_WAIT_L(0); PG8_MMA(0, 1, At, B1); PG8_BAR;
            PG8_LDA(At, 1, 1); PG8_STAGE(PG8_SA(1, 0), a3, voffA);
            PG8_BAR; PG8_WAIT_L(0); PG8_MMA(1, 0, At, B0); PG8_BAR; PG8_SCHED;
            PG8_STAGE(PG8_SB(1, 1), b3 + hstep, voffB);
            PG8_WAIT_V(6); PG8_BAR; PG8_MMA(1, 1, At, B1); PG8_BAR;
            }
        }
        if constexpr (ALIGN_EPI) { if (wr == 0) PG8_BAR; }
        if constexpr (!Epi::AFTER_DRAIN) { E(acc, cur, wr, wc, fr, fq); S.done(cur); }
        if (!has_next) break;
#pragma unroll
        for (int a = 0; a < 2; ++a)
#pragma unroll
            for (int b = 0; b < 2; ++b)
#pragma unroll
                for (int m = 0; m < 4; ++m)
#pragma unroll
                    for (int n = 0; n < 2; ++n) acc[a][b][m][n] = (f32x4){0.f, 0.f, 0.f, 0.f};
        cur = nxt; cA = nA; cB = nB; ++ui;
        if constexpr (ALIGN_EPI) { if (wr == 1) PG8_BAR; }
    }
    PG8_WAIT_V(0);
    if constexpr (!ALIGN_EPI) { if (wr == 0) PG8_BAR; }
    PG8_BAR;
    if constexpr (Epi::AFTER_DRAIN) { E.fused(acc, cur, wr, wc, fr, fq, lds, wid, lane); S.done(cur); }
#undef PG8_SA
#undef PG8_SB
#undef PG8_STAGE
#undef PG8_LDA
#undef PG8_LDB
#undef PG8_MMA
#undef PG8_WAIT_V
#undef PG8_WAIT_L
#undef PG8_BAR
#undef PG8_SCHED
}
}

constexpr int SEQ = 4096, NB = 2, T_ = NB * SEQ, DM = 2048, INW = 6176, FF = 5632;
constexpr int AH = 16, AD = 64, AW = 1024;
constexpr int GH = 4, GDK = 128, GDV = 256, GKW = 512, GVW = 1024, GRANK = 16;
constexpr float NORM_EPS = 1e-6f;
constexpr float LOG2E = 1.4426950408889634f;
constexpr int NWAVES = 8;
constexpr int NPHASE = 8;
#ifndef MK_LAUNCHES
#define MK_LAUNCHES 8
#endif

constexpr size_t MiB = 1u << 20;
constexpr size_t WS_CTL = 0;
constexpr size_t WS_BIAS2 = 64 * 1024;
constexpr size_t WS_SSQ1 = 128 * 1024;
constexpr size_t WS_WIN = 1 * MiB;
constexpr size_t WS_WOUT = 26 * MiB;
constexpr size_t WS_WGU = 34 * MiB;
constexpr size_t WS_WDN = 78 * MiB;
constexpr size_t WS_XN = 100 * MiB;
constexpr size_t WS_RB = 132 * MiB;
constexpr size_t WS_END = 229 * MiB;
constexpr size_t E_AQ = 0, E_AK = (size_t)T_ * 1024, E_AV = 2 * (size_t)T_ * 1024, E_GQ = 3 * (size_t)T_ * 1024, E_GK = E_GQ + (size_t)T_ * 512,
                 E_GVT = 4 * (size_t)T_ * 1024, E_GR = 5 * (size_t)T_ * 1024, E_GLR = 6 * (size_t)T_ * 1024;

#define GAS __attribute__((address_space(1)))
#define LAS __attribute__((address_space(3)))
typedef unsigned short bf16;
typedef unsigned v4u __attribute__((ext_vector_type(4)));
typedef unsigned v2u __attribute__((ext_vector_type(2)));
typedef float f32x4 __attribute__((ext_vector_type(4)));
#define LDS_WAIT() asm volatile("s_waitcnt lgkmcnt(0)" ::: "memory")
__device__ __forceinline__ unsigned f2bf(float f) { unsigned u = __builtin_bit_cast(unsigned, f); return (u + 0x7fffu + ((u >> 16) & 1u)) >> 16; }
__device__ __forceinline__ unsigned pk2(float lo, float hi) { return f2bf(lo) | (f2bf(hi) << 16); }
__device__ __forceinline__ float bf2f(unsigned b) { return __builtin_bit_cast(float, b << 16); }
__device__ __forceinline__ float bflo(unsigned w) { return __builtin_bit_cast(float, w << 16); }
__device__ __forceinline__ float bfhi(unsigned w) { return __builtin_bit_cast(float, w & 0xffff0000u); }
__device__ __forceinline__ float wave_sum(float v) {
#pragma unroll
    for (int o = 1; o < 64; o <<= 1) v += __shfl_xor(v, o);
    return v;
}
__device__ __forceinline__ float wave_max(float v) {
#pragma unroll
    for (int o = 1; o < 64; o <<= 1) v = fmaxf(v, __shfl_xor(v, o));
    return v;
}

namespace pg8 {
struct EpiProj {
    static constexpr bool PERM = true, AFTER_DRAIN = false;
    bf16_t* rb;
    __device__ __forceinline__ void operator()(const f32x4 (&acc)[2][2][4][2], const Unit& u, int wr, int wc, int fr, int fq) const {
        const int pn = u.pn; bf16_t* base; int ldc, colt;
        if (pn < 12) { base = rb + (size_t)(pn >> 2) * ((size_t)T_ * 1024); ldc = 1024; colt = (pn & 3) * 256; }
        else if (pn < 16) { base = rb + E_GQ + (size_t)((pn - 12) >> 1) * ((size_t)T_ * 512); ldc = 512; colt = ((pn - 12) & 1) * 256; }
        else { base = rb + E_GR; ldc = 1024; colt = (pn - 16) * 256; }
        const int row0 = u.pm * BM + wr * 64 + fr, col0 = colt + wc * 32 + 8 * fq;
#pragma unroll
        for (int ai = 0; ai < 2; ++ai)
#pragma unroll
            for (int m = 0; m < 4; ++m) { bf16_t* rowp = base + (size_t)(row0 + ai * HALF + m * 16) * ldc + col0;
#pragma unroll
                for (int bj = 0; bj < 2; ++bj) { const f32x4 v0 = acc[ai][bj][m][0], v1 = acc[ai][bj][m][1];
                    u32x4 w; w.x = cvt_pk_bf16(v0[0], v0[1]); w.y = cvt_pk_bf16(v0[2], v0[3]); w.z = cvt_pk_bf16(v1[0], v1[1]); w.w = cvt_pk_bf16(v1[2], v1[3]);
                    *(u32x4*)(rowp + bj * HALF) = w; } }
    }
};
struct EpiPlain {
    static constexpr bool PERM = true, AFTER_DRAIN = false;
    bf16_t* O; int ldc;
    __device__ __forceinline__ void operator()(const f32x4 (&acc)[2][2][4][2], const Unit& u, int wr, int wc, int fr, int fq) const {
        const int row0 = u.pm * BM + wr * 64 + fr, col0 = u.pn * BM + wc * 32 + 8 * fq;
#pragma unroll
        for (int ai = 0; ai < 2; ++ai)
#pragma unroll
            for (int m = 0; m < 4; ++m) { bf16_t* rowp = O + (size_t)(row0 + ai * HALF + m * 16) * ldc + col0;
#pragma unroll
                for (int bj = 0; bj < 2; ++bj) { const f32x4 v0 = acc[ai][bj][m][0], v1 = acc[ai][bj][m][1];
                    u32x4 w; w.x = cvt_pk_bf16(v0[0], v0[1]); w.y = cvt_pk_bf16(v0[2], v0[3]); w.z = cvt_pk_bf16(v1[0], v1[1]); w.w = cvt_pk_bf16(v1[2], v1[3]);
                    *(u32x4*)(rowp + bj * HALF) = w; } }
    }
};
template <bool AUX> struct EpiRes {
    static constexpr bool PERM = false, AFTER_DRAIN = true;
    const float* base; float* out; bf16_t* xb; float* ssq;
    __device__ __forceinline__ void fused(f32x4 (&acc)[2][2][4][2], const Unit& u, int wr, int wc, int fr, int fq, PG8_LAS unsigned char* lds, int wid, int lane) const {
        PG8_LAS float* P = (PG8_LAS float*)lds;
        const int col0 = u.pn * BM + wc * 32 + 4 * fq;
#pragma unroll
        for (int ai = 0; ai < 2; ++ai)
#pragma unroll
            for (int m = 0; m < 4; ++m) { const int rl = ai * HALF + wr * 64 + m * 16 + fr; const size_t off = (size_t)(u.pm * BM + rl) * DM + col0; float s = 0.f;
#pragma unroll
                for (int bj = 0; bj < 2; ++bj)
#pragma unroll
                    for (int n = 0; n < 2; ++n) { const f32x4 bs = *(const f32x4*)(base + off + bj * HALF + n * 16); const f32x4 v = bs + acc[ai][bj][m][n];
                        *(f32x4*)(out + off + bj * HALF + n * 16) = v;
                        if (AUX) { s += (v[0] * v[0] + v[1] * v[1]) + (v[2] * v[2] + v[3] * v[3]);
                            typedef unsigned u32x2 __attribute__((ext_vector_type(2))); u32x2 w; w.x = cvt_pk_bf16(v[0], v[1]); w.y = cvt_pk_bf16(v[2], v[3]);
                            *(u32x2*)(xb + off + bj * HALF + n * 16) = w; } }
                if (AUX) { s += __shfl_xor(s, 16); s += __shfl_xor(s, 32); if (fq == 0) P[rl * 4 + wc] = s; }
            }
        if (AUX) {
            asm volatile("s_waitcnt lgkmcnt(0)" ::: "memory"); __builtin_amdgcn_s_barrier(); asm volatile("" ::: "memory");
            const int tid = wid * 64 + lane;
            if (tid < 256) { const float s = (P[tid * 4 + 0] + P[tid * 4 + 1]) + (P[tid * 4 + 2] + P[tid * 4 + 3]); ssq[(size_t)(u.pm * BM + tid) * 8 + u.pn] = s; }
        }
    }
};
struct EpiSwiglu {
    static constexpr bool PERM = true, AFTER_DRAIN = false;
    bf16_t* H; const float* ssq;
    __device__ __forceinline__ void operator()(const f32x4 (&acc)[2][2][4][2], const Unit& u, int wr, int wc, int fr, int fq) const {
        const int row0 = u.pm * BM + wr * 64 + fr, col0 = u.pn * HALF + wc * 32 + 8 * fq;
#pragma unroll
        for (int ai = 0; ai < 2; ++ai)
#pragma unroll
            for (int m = 0; m < 4; ++m) { const int r = row0 + ai * HALF + m * 16;
                const f32x4 s0 = *(const f32x4*)(ssq + (size_t)r * 8), s1 = *(const f32x4*)(ssq + (size_t)r * 8 + 4);
                const float tot = ((s0[0] + s0[1]) + (s0[2] + s0[3])) + ((s1[0] + s1[1]) + (s1[2] + s1[3]));
                const float rstd = rsqrtf(tot * (1.0f / DM) + NORM_EPS);
                float hv[8];
#pragma unroll
                for (int n = 0; n < 2; ++n)
#pragma unroll
                    for (int i = 0; i < 4; ++i) { const float g = acc[ai][0][m][n][i] * rstd, up = acc[ai][1][m][n][i] * rstd; hv[n * 4 + i] = g / (1.0f + __expf(-g)) * up; }
                u32x4 w; w.x = cvt_pk_bf16(hv[0], hv[1]); w.y = cvt_pk_bf16(hv[2], hv[3]); w.z = cvt_pk_bf16(hv[4], hv[5]); w.w = cvt_pk_bf16(hv[6], hv[7]);
                *(u32x4*)(H + (size_t)r * FF + col0) = w; }
    }
};
}

constexpr int RING_BYTES = 131072;
constexpr int LDS_BYTES = 147456;
struct Args { const float* in[15]; float* out; unsigned char* ws; int ph_lo, ph_hi; };

__device__ __forceinline__ void p0_item(const float* __restrict__ W, int K, int N, bf16* WT, int k0, int n0, int drow0, const float* __restrict__ kscale, float nscale, LAS float* scr, int lane) {
#pragma unroll 8
    for (int i = 0; i < 32; ++i) { const int kk = 2 * i + (lane >> 5); float v = W[(size_t)(k0 + kk) * N + n0 + (lane & 31)]; if (kscale) v *= kscale[k0 + kk]; scr[kk * 33 + (lane & 31)] = v * nscale; }
    LDS_WAIT(); asm volatile("" ::: "memory");
    const int c = lane & 7;
#pragma unroll
    for (int j = 0; j < 4; ++j) { const int n = (lane >> 3) + 8 * j; const LAS float* s = scr + (8 * c) * 33 + n;
        v4u o; o.x = pk2(s[0 * 33], s[1 * 33]); o.y = pk2(s[2 * 33], s[3 * 33]); o.z = pk2(s[4 * 33], s[5 * 33]); o.w = pk2(s[6 * 33], s[7 * 33]);
        *(v4u*)(WT + (size_t)(drow0 + n) * K + k0 + 8 * c) = o; }
    LDS_WAIT(); asm volatile("" ::: "memory");
}

__device__ __forceinline__ int t5_bucket(int rel) {
    const int nb = 16, max_exact = 8; int ret = rel > 0 ? nb : 0; const int n = rel < 0 ? -rel : rel;
    if (n < max_exact) return ret + n;
    int large = max_exact + (int)(log((double)n / (double)max_exact) / log(1024.0 / 8.0) * (double)(nb - max_exact));
    if (large > nb - 1) large = nb - 1;
    return ret + large;
}

__global__ void __launch_bounds__(NWAVES * 64, 2) fwd(Args args) {
    extern __shared__ __attribute__((aligned(16))) unsigned char lds_raw[];
    LAS unsigned char* lds = (LAS unsigned char*)lds_raw;
    const int tid = threadIdx.x, lane = tid & 63, wave = __builtin_amdgcn_readfirstlane(tid >> 6);
    const int G = gridDim.x; const int bx = blockIdx.x; const int vcu = (G % 8 == 0) ? (bx % 8) * (G / 8) + bx / 8 : bx;
    const int gw = vcu * NWAVES + wave, NGW = G * NWAVES;
    unsigned char* ws = args.ws;
    const float* x = args.in[0]; float* out = args.out;
    bf16* Wt_in = (bf16*)(ws + WS_WIN); bf16* Wt_out = (bf16*)(ws + WS_WOUT); bf16* Wt_gu = (bf16*)(ws + WS_WGU); bf16* Wt_dn = (bf16*)(ws + WS_WDN);
    bf16* XN = (bf16*)(ws + WS_XN); bf16* RB = (bf16*)(ws + WS_RB);
    float* BIAS2 = (float*)(ws + WS_BIAS2); float* SSQ1 = (float*)(ws + WS_SSQ1);
    float* GLR = (float*)(RB + E_GLR);
    bf16* OF = (bf16*)(ws + WS_XN); bf16* OB = OF + (size_t)T_ * 1024;
    bf16* Y = RB;
    bf16* X1B = (bf16*)(ws + WS_XN);
    bf16* HB = RB;
    bf16* ATT = (bf16*)out;
    const int lo = args.ph_lo, hi = args.ph_hi;
#define IN(k) (lo <= (k) && (k) < hi)
#define SEAM(k) do { if (IN(k) && IN((k) + 1)) { cg::this_grid().sync(); } } while (0)

    if (IN(0)) {
        LAS float* scr = (LAS float*)(lds + wave * 16384);
        constexpr int I_IN = 32 * 193, I_OUT = 32 * 64, I_G = 32 * 176, I_D = 88 * 64, NITEMS = I_IN + I_OUT + 2 * I_G + I_D;
        for (int it = gw; it < NITEMS; it += NGW) {
            int r = it;
            if (r < I_IN) { const int kb = r / 193, nb = r % 193, n0 = nb * 32;
                int drow; float sc = 1.f;
                if (n0 < 1024) { drow = n0; sc = 0.125f * LOG2E; }
                else if (n0 < 3072) drow = n0;
                else if (n0 < 3584) { drow = n0; sc = 0.08838834764831845f; }
                else if (n0 < 4096) drow = n0;
                else if (n0 < 5120) drow = n0 + 1024;
                else if (n0 < 6144) drow = n0 - 1024;
                else drow = n0;
                p0_item(args.in[2], DM, INW, Wt_in, kb * 64, n0, drow, nullptr, sc, scr, lane); continue; }
            r -= I_IN;
            if (r < I_OUT) { const int kb = r / 64, nb = r % 64; p0_item(args.in[9], DM, DM, Wt_out, kb * 64, nb * 32, nb * 32, nullptr, 1.f, scr, lane); continue; }
            r -= I_OUT;
            if (r < I_G) { const int kb = r / 176, nb = r % 176, n0 = nb * 32; p0_item(args.in[11], DM, FF, Wt_gu, kb * 64, n0, (n0 >> 7) * 256 + (n0 & 127), args.in[10], 1.f, scr, lane); continue; }
            r -= I_G;
            if (r < I_G) { const int kb = r / 176, nb = r % 176, n0 = nb * 32; p0_item(args.in[12], DM, FF, Wt_gu, kb * 64, n0, (n0 >> 7) * 256 + 128 + (n0 & 127), args.in[10], 1.f, scr, lane); continue; }
            r -= I_G;
            { const int kb = r / 64, nb = r % 64; p0_item(args.in[13], FF, DM, Wt_dn, kb * 64, nb * 32, nb * 32, nullptr, 1.f, scr, lane); }
        }
        const float* nw = args.in[1];
        for (int m = gw; m < T_; m += NGW) {
            const f32x4* xr = (const f32x4*)(x + (size_t)m * DM) + lane; f32x4 v[8]; float s = 0.f;
#pragma unroll
            for (int j = 0; j < 8; ++j) { v[j] = xr[64 * j]; s += (v[j][0] * v[j][0] + v[j][1] * v[j][1]) + (v[j][2] * v[j][2] + v[j][3] * v[j][3]); }
            const float rstd = rsqrtf(wave_sum(s) * (1.f / DM) + NORM_EPS);
            v2u* o8 = (v2u*)(XN + (size_t)m * DM) + lane;
#pragma unroll
            for (int j = 0; j < 8; ++j) { const f32x4 w = ((const f32x4*)nw)[lane + 64 * j]; v2u o; o.x = pk2(v[j][0] * rstd * w[0], v[j][1] * rstd * w[1]); o.y = pk2(v[j][2] * rstd * w[2], v[j][3] * rstd * w[3]); o8[64 * j] = o; }
        }
        if (bx == 0) {
            const float* tbl = args.in[3];
            for (int idx = tid; idx < 3 * 129; idx += NWAVES * 64) { const int p = idx / 129, s = idx % 129; const int r = (p == 0) ? 1 : (p == 1 ? 4 : 16);
                const int bk = t5_bucket((s - 64) * r);
                for (int h = 0; h < 16; ++h) BIAS2[idx * 16 + h] = tbl[bk * 16 + h] * LOG2E; }
        }
    }
    SEAM(0);

    if (IN(1)) {
        { pg8::Gemm g{XN, Wt_in, T_, 5120, DM}; pg8::StaticOrder S; S.init(T_, 5120, G, bx); pg8::EpiProj E{RB};
          pg8::gemm_phase<pg8::EpiProj, pg8::StaticOrder, true, true>(lds, g, S, E); }
        { pg8::Gemm g{Wt_in + (size_t)5120 * DM, XN, 1024, T_, DM}; pg8::StaticOrder S; S.init(1024, T_, G, (bx + G / 2) % G); pg8::EpiPlain E{RB + E_GVT, T_};
          pg8::gemm_phase<pg8::EpiPlain, pg8::StaticOrder, true, true>(lds, g, S, E); }
        for (int o = vcu * 512 + tid; o < T_ * 32; o += G * 512) { const int t = o >> 5, j = o & 31;
            const v4u* a = (const v4u*)(XN + (size_t)t * DM); const v4u* b = (const v4u*)(Wt_in + (size_t)(6144 + j) * DM); float s = 0.f;
            for (int k = 0; k < DM / 8; ++k) { const v4u av = a[k], bv = b[k];
                s += bflo(av.x) * bflo(bv.x) + bfhi(av.x) * bfhi(bv.x) + bflo(av.y) * bflo(bv.y) + bfhi(av.y) * bfhi(bv.y)
                   + bflo(av.z) * bflo(bv.z) + bfhi(av.z) * bfhi(bv.z) + bflo(av.w) * bflo(bv.w) + bfhi(av.w) * bfhi(bv.w); }
            GLR[o] = s; }
    }
    SEAM(1);

    if (IN(2)) {
        const bf16* AQ = RB + E_AQ; const bf16* AK = RB + E_AK; const bf16* AV = RB + E_AV;
        const bf16* GQ = RB + E_GQ; const bf16* GK = RB + E_GK; const bf16* GVT = RB + E_GVT;
        if (bx < 16) {
            const int dir = bx & 1, h = (bx >> 1) & 3, b = bx >> 3;
            const float* gwt = dir ? args.in[6] : args.in[4]; const float* gbs = dir ? args.in[7] : args.in[5];
            LAS float* a_s = (LAS float*)lds; LAS float* q_s = a_s + 64 * 128; LAS float* k_s = q_s + 64 * 128;
            float S[128];
#pragma unroll
            for (int d = 0; d < 128; ++d) S[d] = 0.f;
            const int d_ = tid & 127, cg_ = tid >> 7;
            float gwr[16];
#pragma unroll
            for (int r = 0; r < 16; ++r) gwr[r] = gwt[r * GKW + h * 128 + d_];
            const float gb = gbs[h * 128 + d_];
            for (int blk = 0; blk < 64; ++blk) {
                __syncthreads();
                for (int cc = 0; cc < 16; ++cc) { const int c = cg_ * 16 + cc; const int t = dir ? (SEQ - 1 - (blk * 64 + c)) : (blk * 64 + c); const size_t row = (size_t)b * SEQ + t;
                    float z = gb;
#pragma unroll
                    for (int r = 0; r < 16; ++r) z += GLR[row * 32 + dir * 16 + r] * gwr[r];
                    const float la = (fminf(z, 0.f) - log1pf(__expf(-fabsf(z)))) * (1.0f / 16.0f);
                    a_s[c * 128 + d_] = __expf(la);
                    q_s[c * 128 + d_] = bf2f(GQ[row * GKW + h * 128 + d_]);
                    k_s[c * 128 + d_] = bf2f(GK[row * GKW + h * 128 + d_]); }
                __syncthreads();
                if (tid < 256) {
                    const int tlo = dir ? (SEQ - 1 - (blk * 64 + 63)) : (blk * 64);
                    const bf16* vrow = GVT + (size_t)(h * 256 + tid) * T_ + (size_t)b * SEQ + tlo;
                    bf16* orow = (dir ? OB : OF);
                    for (int c = 0; c < 64; ++c) { const int ti = dir ? (63 - c) : c; const float vt = bf2f(vrow[ti]); float o = 0.f;
                        const LAS f32x4* a4 = (const LAS f32x4*)(a_s + c * 128); const LAS f32x4* q4 = (const LAS f32x4*)(q_s + c * 128); const LAS f32x4* k4 = (const LAS f32x4*)(k_s + c * 128);
#pragma unroll
                        for (int d4 = 0; d4 < 32; ++d4) { const f32x4 av = a4[d4], qv = q4[d4], kv = k4[d4];
#pragma unroll
                            for (int i = 0; i < 4; ++i) { S[d4 * 4 + i] = av[i] * S[d4 * 4 + i] + kv[i] * vt; o += qv[i] * S[d4 * 4 + i]; } }
                        orow[((size_t)b * SEQ + tlo + ti) * GVW + h * 256 + tid] = (bf16)f2bf(o); }
                }
            }
            __syncthreads();
        }
        if (bx >= 16 || G <= 16) {
            const int nw0 = (G > 16) ? (bx - 16) * NWAVES + wave : gw; const int nws = (G > 16) ? (G - 16) * NWAVES : NGW;
            for (int item = nw0; item < NB * AH * SEQ; item += nws) {
                const int q = item & (SEQ - 1), h = (item >> 12) & 15, b = item >> 16;
                const size_t rowq = (size_t)b * SEQ + q;
                float qv[64];
                { const v4u* qp = (const v4u*)(AQ + rowq * AW + h * AD);
#pragma unroll
                  for (int i = 0; i < 8; ++i) { const v4u w = qp[i]; qv[8 * i + 0] = bflo(w.x); qv[8 * i + 1] = bfhi(w.x); qv[8 * i + 2] = bflo(w.y); qv[8 * i + 3] = bfhi(w.y); qv[8 * i + 4] = bflo(w.z); qv[8 * i + 5] = bfhi(w.z); qv[8 * i + 6] = bflo(w.w); qv[8 * i + 7] = bfhi(w.w); } }
                float op[3], lse[3];
#pragma unroll
                for (int p = 0; p < 3; ++p) { const int r = (p == 0) ? 1 : (p == 1 ? 4 : 16);
                    float lg[3];
#pragma unroll
                    for (int i = 0; i < 3; ++i) { const int s = lane + 64 * i; const int kp = q + (s - 64) * r; const bool valid = (s < 129) && (kp >= 0) && (kp < SEQ);
                        float dot = -INFINITY;
                        if (valid) { const v4u* kr = (const v4u*)(AK + ((size_t)b * SEQ + kp) * AW + h * AD); float a = 0.f;
#pragma unroll
                            for (int j = 0; j < 8; ++j) { const v4u w = kr[j]; a += qv[8 * j + 0] * bflo(w.x) + qv[8 * j + 1] * bfhi(w.x) + qv[8 * j + 2] * bflo(w.y) + qv[8 * j + 3] * bfhi(w.y) + qv[8 * j + 4] * bflo(w.z) + qv[8 * j + 5] * bfhi(w.z) + qv[8 * j + 6] * bflo(w.w) + qv[8 * j + 7] * bfhi(w.w); }
                            dot = a + BIAS2[(p * 129 + s) * 16 + h]; }
                        lg[i] = dot; }
                    const float m = wave_max(fmaxf(fmaxf(lg[0], lg[1]), lg[2]));
                    float pr[3];
#pragma unroll
                    for (int i = 0; i < 3; ++i) pr[i] = exp2f(lg[i] - m);
                    const float ssum = wave_sum(pr[0] + pr[1] + pr[2]);
                    float o = 0.f;
                    for (int s = 0; s < 129; ++s) { const int kp = q + (s - 64) * r; if (kp < 0 || kp >= SEQ) continue;
                        const float pk = __shfl(s < 64 ? pr[0] : (s < 128 ? pr[1] : pr[2]), s & 63);
                        o += pk * bf2f(AV[((size_t)b * SEQ + kp) * AW + h * AD + lane]); }
                    op[p] = o / ssum; lse[p] = m + log2f(ssum); }
                const float M = fmaxf(fmaxf(lse[0], lse[1]), lse[2]);
                const float w0 = exp2f(lse[0] - M), w1 = exp2f(lse[1] - M), w2 = exp2f(lse[2] - M);
                const float res = (w0 * op[0] + w1 * op[1] + w2 * op[2]) / (w0 + w1 + w2);
                ATT[rowq * AW + h * AD + lane] = (bf16)f2bf(res);
            }
        }
    }
    SEAM(2);

    if (IN(3)) {
        const bf16* GR = RB + E_GR; const float* gnw = args.in[8];
        for (int item = gw; item < T_ * 8; item += NGW) { const int row = item >> 3, part = item & 7;
            if (part < 4) {
                const v2u v = ((const v2u*)(ATT + (size_t)row * AW + part * 256))[lane];
                ((v2u*)(Y + (size_t)row * DM + part * 256))[lane] = v;
            } else { const int h = part - 4; const size_t o = (size_t)row * GVW + h * 256;
                const v2u a = ((const v2u*)(OF + o))[lane], c = ((const v2u*)(OB + o))[lane], g = ((const v2u*)(GR + o))[lane];
                float v[4] = {bflo(a.x) + bflo(c.x), bfhi(a.x) + bfhi(c.x), bflo(a.y) + bflo(c.y), bfhi(a.y) + bfhi(c.y)};
                const float gr[4] = {bflo(g.x), bfhi(g.x), bflo(g.y), bfhi(g.y)};
                const float ss = wave_sum((v[0] * v[0] + v[1] * v[1]) + (v[2] * v[2] + v[3] * v[3]));
                const float rstd = rsqrtf(ss * (1.0f / 256.0f) + NORM_EPS);
                const f32x4 w = ((const f32x4*)(gnw + h * 256))[lane];
                float y[4];
#pragma unroll
                for (int i = 0; i < 4; ++i) y[i] = v[i] * rstd * w[i] * (gr[i] / (1.0f + __expf(-gr[i])));
                v2u ov; ov.x = pk2(y[0], y[1]); ov.y = pk2(y[2], y[3]);
                ((v2u*)(Y + (size_t)row * DM + 1024 + h * 256))[lane] = ov; }
        }
    }
    SEAM(3);

    if (IN(4)) {
        pg8::Gemm g{Y, Wt_out, T_, DM, DM}; pg8::StaticOrder S; S.init(T_, DM, G, bx); pg8::EpiRes<true> E{x, out, X1B, SSQ1};
        pg8::gemm_phase<pg8::EpiRes<true>, pg8::StaticOrder, false, true>(lds, g, S, E);
    }
    SEAM(4);

    if (IN(5)) {
        pg8::Gemm g{X1B, Wt_gu, T_, 2 * FF, DM}; pg8::StaticOrder S; S.init(T_, 2 * FF, G, bx); pg8::EpiSwiglu E{HB, SSQ1};
        pg8::gemm_phase<pg8::EpiSwiglu, pg8::StaticOrder, true, true>(lds, g, S, E);
    }
    SEAM(5);

    if (IN(6)) {
        pg8::Gemm g{HB, Wt_dn, T_, DM, FF}; pg8::StaticOrder S; S.init(T_, DM, G, bx); pg8::EpiRes<false> E{out, out, nullptr, nullptr};
        pg8::gemm_phase<pg8::EpiRes<false>, pg8::StaticOrder, false, true>(lds, g, S, E);
    }
    SEAM(6);

    if (IN(7)) {
        const float* fw = args.in[14];
        for (int m = gw; m < T_; m += NGW) {
            f32x4* xr = (f32x4*)(out + (size_t)m * DM) + lane; f32x4 v[8]; float s = 0.f;
#pragma unroll
            for (int j = 0; j < 8; ++j) { v[j] = xr[64 * j]; s += (v[j][0] * v[j][0] + v[j][1] * v[j][1]) + (v[j][2] * v[j][2] + v[j][3] * v[j][3]); }
            const float rstd = rsqrtf(wave_sum(s) * (1.f / DM) + NORM_EPS);
#pragma unroll
            for (int j = 0; j < 8; ++j) { const f32x4 w = ((const f32x4*)fw)[lane + 64 * j]; xr[64 * j] = v[j] * rstd * w; }
        }
    }
#undef IN
#undef SEAM
}

extern "C" void kernel_launch(void* const* d_in, const int* in_sizes, int n_in, void* d_out, int out_size, void* d_ws, size_t ws_size, hipStream_t stream) {
    static int grid = 0;
    if (grid == 0) {
        if (n_in != 15 || out_size != T_ * DM || ws_size < WS_END) { fprintf(stderr, "kernel_launch: unexpected shapes (n_in %d out %d ws %zu)\n", n_in, out_size, ws_size); grid = -1; return; }
        int dev = 0, cus = 0, per_cu = 0;
        if (hipGetDevice(&dev) != hipSuccess || hipDeviceGetAttribute(&cus, hipDeviceAttributeMultiprocessorCount, dev) != hipSuccess) { grid = -1; return; }
        if (hipFuncSetAttribute((const void*)fwd, hipFuncAttributeMaxDynamicSharedMemorySize, LDS_BYTES) != hipSuccess) { fprintf(stderr, "kernel_launch: hipFuncSetAttribute failed\n"); grid = -1; return; }
        if (hipOccupancyMaxActiveBlocksPerMultiprocessor(&per_cu, (const void*)fwd, NWAVES * 64, LDS_BYTES) != hipSuccess || per_cu < 1) { fprintf(stderr, "kernel_launch: occupancy query reports %d\n", per_cu); per_cu = 1; }
        (void)hipGetLastError();
        grid = cus;
    }
    if (grid < 0) return;
    Args a{};
    for (int i = 0; i < 15; ++i) a.in[i] = (const float*)d_in[i];
    a.out = (float*)d_out; a.ws = (unsigned char*)d_ws;
#if MK_LAUNCHES == 1
    a.ph_lo = 0; a.ph_hi = NPHASE;
    void* kargs[] = {&a};
    hipError_t e = hipLaunchCooperativeKernel((const void*)fwd, dim3(grid), dim3(NWAVES * 64), kargs, LDS_BYTES, stream);
    if (e != hipSuccess) fprintf(stderr, "kernel_launch: cooperative launch failed: %s (grid %d)\n", hipGetErrorString(e), grid);
#else
    for (int p = 0; p < NPHASE; ++p) { a.ph_lo = p; a.ph_hi = p + 1; hipLaunchKernelGGL(fwd, dim3(grid), dim3(NWAVES * 64), LDS_BYTES, stream, a); }
#endif
}
```

```cpp
#include <hip/hip_runtime.h>
#include <hip/hip_cooperative_groups.h>
#include <cstdio>
#include <cstdint>
namespace cg = cooperative_groups;

namespace pg8 {
#define PG8_LAS __attribute__((address_space(3)))
typedef unsigned short bf16_t;
typedef short bf16x8 __attribute__((ext_vector_type(8)));
typedef float f32x4 __attribute__((ext_vector_type(4)));
typedef unsigned u32x4 __attribute__((ext_vector_type(4)));
constexpr int BM = 256, BK = 64, HALF = 128, HTB = HALF * BK * 2  , STAGE_BYTES = 8 * HTB, NXCD = 8, WGM = 8;

__host__ __device__ __forceinline__ int lds_byte(int r, int c) { const int st = (r >> 4) * 2 + (c >> 5), rr = r & 15, cc = c & 31, ob = rr * 64 + cc * 2; return st * 1024 + (ob ^ (((ob >> 9) & 1) << 5)); }
__host__ __device__ __forceinline__ void stage_rc(int b, int& R, int& C) { const int st = b / 1024, sb = b % 1024, swz = sb ^ (((sb >> 9) & 1) << 5); R = (st >> 1) * 16 + swz / 64; C = (st & 1) * 32 + (swz % 64) / 2; }
__host__ __device__ __forceinline__ int perm32(int rho) { const int n = rho >> 4, i = rho & 15; return 8 * (i >> 2) + 4 * n + (i & 3); }

struct Unit { int pm, pn; };
struct Gemm { const bf16_t* A; const bf16_t* Bt; int M, N, K; };

struct StaticOrder {
    int nM, nN, nwg, G, c;
    __host__ __device__ void init(int M, int N, int G_, int c_) { nM = M / BM; nN = N / BM; nwg = nM * nN; G = G_; c = c_; }
    __host__ __device__ bool next(int i, Unit& u) const {
        const long L = (long)i * G + c; if (L >= nwg) return false;
        int wgid = (int)L; { const int q = nwg / NXCD, r = nwg % NXCD, xcd = wgid % NXCD, off = wgid / NXCD; wgid = (xcd < r ? xcd * (q + 1) : r * (q + 1) + (xcd - r) * q) + off; }
        const int nig = WGM * nN, gid = wgid / nig, fm = gid * WGM, gsz = (nM - fm) < WGM ? (nM - fm) : WGM;
        u.pm = fm + ((wgid % nig) % gsz); u.pn = (wgid % nig) / gsz; return true;
    }
    __device__ __forceinline__ void a_ready(const Unit&) const {}
    __device__ __forceinline__ void done(const Unit&) const {}
};

__device__ __forceinline__ unsigned cvt_pk_bf16(float lo, float hi) { unsigned r; asm volatile("v_cvt_pk_bf16_f32 %0, %1, %2" : "=v"(r) : "v"(lo), "v"(hi)); return r; }
template <class Epi, class Sched, bool ALIGN_EPI = false, bool SP2 = false>
__device__ __forceinline__ void gemm_phase(PG8_LAS unsigned char* lds, const Gemm g, const Sched& S, const Epi& E) {
    const int tid = threadIdx.x, wid = __builtin_amdgcn_readfirstlane(tid >> 6), lane = tid & 63, wr = wid >> 2, wc = wid & 3, fr = lane & 15, fq = lane >> 4;
    const int K = g.K, nt = K / BK;
    unsigned voffA[2], voffB[2];
#pragma unroll
    for (int i = 0; i < 2; ++i) { int R, C; stage_rc(tid * 16 + i * 8192, R, C); const int Rb = Epi::PERM ? ((R & ~31) + perm32(R & 31)) : R;
        voffA[i] = (unsigned)(R * K + C) * 2u; voffB[i] = (unsigned)(Rb * K + C) * 2u; }
    const size_t kstep = (size_t)(BK * 2);
    const size_t hstep = (size_t)HALF * K * 2;
    const size_t tstep = 2 * hstep;
    const unsigned ldsw = (unsigned)wid * 1024u;
    const int aoff = lds_byte(wr * 64 + fr, fq * 8), boff = lds_byte(wc * 32 + fr, fq * 8);
#define PG8_SA(b, h) (((b) * 2 + (h)) * HTB)
#define PG8_SB(b, h) ((4 + (b) * 2 + (h)) * HTB)
#define PG8_STAGE(bufoff, gbase, voff) do { _Pragma("unroll") for (int _i = 0; _i < 2; ++_i) \
        __builtin_amdgcn_global_load_lds((const unsigned*)((const char*)(gbase) + (voff)[_i]), (PG8_LAS unsigned*)(lds + (bufoff) + ldsw + _i * 8192), 16, 0, 0); } while (0)
#define PG8_LDA(dst, b, h) do { _Pragma("unroll") for (int m = 0; m < 4; ++m) _Pragma("unroll") for (int k = 0; k < 2; ++k) dst[m][k] = *(const PG8_LAS bf16x8*)(lds + PG8_SA(b, h) + aoff + m * 2048 + k * 1024); } while (0)
#define PG8_LDB(dst, b, h) do { _Pragma("unroll") for (int n = 0; n < 2; ++n) _Pragma("unroll") for (int k = 0; k < 2; ++k) dst[n][k] = *(const PG8_LAS bf16x8*)(lds + PG8_SB(b, h) + boff + n * 2048 + k * 1024); } while (0)
#define PG8_MMA(ai, bj, At, Bt) do { __builtin_amdgcn_s_setprio(1); _Pragma("unroll") for (int m = 0; m < 4; ++m) _Pragma("unroll") for (int n = 0; n < 2; ++n) _Pragma("unroll") for (int k = 0; k < 2; ++k) \
        acc[ai][bj][m][n] = __builtin_amdgcn_mfma_f32_16x16x32_bf16(Bt[n][k], At[m][k], acc[ai][bj][m][n], 0, 0, 0); __builtin_amdgcn_s_setprio(0); } while (0)
#define PG8_WAIT_V(n) asm volatile("s_waitcnt vmcnt(" #n ")" ::: "memory")
#define PG8_WAIT_L(n) asm volatile("s_waitcnt lgkmcnt(" #n ")" ::: "memory")
#define PG8_BAR __builtin_amdgcn_s_barrier()
#define PG8_SCHED __builtin_amdgcn_sched_barrier(0)
    Unit cur, nxt; int ui = 0;
    if (!S.next(0, cur)) return;
    f32x4 acc[2][2][4][2];
#pragma unroll
    for (int a = 0; a < 2; ++a)
#pragma unroll
        for (int b = 0; b < 2; ++b)
#pragma unroll
            for (int m = 0; m < 4; ++m)
#pragma unroll
                for (int n = 0; n < 2; ++n) acc[a][b][m][n] = (f32x4){0.f, 0.f, 0.f, 0.f};
    bf16x8 At[4][2], B0[2][2], B1[2][2];
    const char* cA = (const char*)g.A + (size_t)cur.pm * tstep; const char* cB = (const char*)g.Bt + (size_t)cur.pn * tstep;
    S.a_ready(cur);
    if constexpr (SP2) {
        PG8_STAGE(PG8_SB(0, 0), cB, voffB); PG8_STAGE(PG8_SB(0, 1), cB + hstep, voffB); PG8_STAGE(PG8_SA(0, 0), cA, voffA); PG8_STAGE(PG8_SA(0, 1), cA + hstep, voffA);
        if (wr == 1) PG8_BAR;
        PG8_WAIT_V(2); PG8_BAR;
        PG8_STAGE(PG8_SB(1, 0), cB + kstep, voffB); PG8_STAGE(PG8_SA(1, 0), cA + kstep, voffA); PG8_STAGE(PG8_SB(1, 1), cB + hstep + kstep, voffB);
        PG8_WAIT_V(6); PG8_BAR;
    } else {
        PG8_STAGE(PG8_SB(0, 0), cB, voffB); PG8_STAGE(PG8_SA(0, 0), cA, voffA); PG8_STAGE(PG8_SB(0, 1), cB + hstep, voffB); PG8_STAGE(PG8_SA(0, 1), cA + hstep, voffA);
        if (wr == 1) PG8_BAR;
        PG8_WAIT_V(4); PG8_BAR;
        PG8_STAGE(PG8_SB(1, 0), cB + kstep, voffB); PG8_STAGE(PG8_SA(1, 0), cA + kstep, voffA); PG8_STAGE(PG8_SB(1, 1), cB + hstep + kstep, voffB);
        PG8_WAIT_V(6); PG8_BAR;
    }
    for (;;) {
        const bool has_next = S.next(ui + 1, nxt);
        const char* nA = has_next ? (const char*)g.A + (size_t)nxt.pm * tstep : cA; const char* nB = has_next ? (const char*)g.Bt + (size_t)nxt.pn * tstep : cB;
        for (int t = 0; t < nt; t += 2) {
            const bool last = (t == nt - 2);
            const char* a1 = cA + (size_t)(t + 1) * kstep;
            const char* a2 = last ? nA : cA + (size_t)(t + 2) * kstep; const char* b2 = last ? nB : cB + (size_t)(t + 2) * kstep;
            const char* a3 = a2 + kstep; const char* b3 = b2 + kstep;
            if (last && has_next) S.a_ready(nxt);
            if constexpr (SP2) {
            PG8_LDB(B0, 0, 0); PG8_LDB(B1, 0, 1); PG8_SCHED; PG8_LDA(At, 0, 0); PG8_STAGE(PG8_SA(1, 1), a1 + hstep, voffA);
            PG8_WAIT_V(8); PG8_WAIT_L(0); PG8_BAR; PG8_MMA(0, 0, At, B0); PG8_MMA(0, 1, At, B1); PG8_BAR; PG8_SCHED;
            PG8_LDA(At, 0, 1); PG8_STAGE(PG8_SB(0, 0), b2, voffB); PG8_STAGE(PG8_SB(0, 1), b2 + hstep, voffB); PG8_STAGE(PG8_SA(0, 0), a2, voffA);
            PG8_WAIT_V(8); PG8_WAIT_L(0); PG8_BAR; PG8_MMA(1, 0, At, B0); PG8_MMA(1, 1, At, B1); PG8_BAR; PG8_SCHED;
            PG8_LDB(B0, 1, 0); PG8_LDB(B1, 1, 1); PG8_SCHED; PG8_LDA(At, 1, 0); PG8_STAGE(PG8_SA(0, 1), a2 + hstep, voffA);
            PG8_WAIT_V(8); PG8_WAIT_L(0); PG8_BAR; PG8_MMA(0, 0, At, B0); PG8_MMA(0, 1, At, B1); PG8_BAR; PG8_SCHED;
            PG8_LDA(At, 1, 1); PG8_STAGE(PG8_SB(1, 0), b3, voffB); PG8_STAGE(PG8_SB(1, 1), b3 + hstep, voffB); PG8_STAGE(PG8_SA(1, 0), a3, voffA);
            PG8_WAIT_V(8); PG8_WAIT_L(0); PG8_BAR; PG8_MMA(1, 0, At, B0); PG8_MMA(1, 1, At, B1); PG8_BAR; PG8_SCHED;
            } else {
            PG8_LDB(B0, 0, 0); PG8_SCHED; PG8_LDA(At, 0, 0); PG8_STAGE(PG8_SA(1, 1), a1 + hstep, voffA);
            PG8_WAIT_L(8); PG8_BAR; PG8_WAIT_L(0); PG8_MMA(0, 0, At, B0); PG8_BAR; PG8_SCHED;
            PG8_LDB(B1, 0, 1); PG8_STAGE(PG8_SB(0, 0), b2, voffB);
            PG8_BAR; PG8_WAIT_L(0); PG8_MMA(0, 1, At, B1); PG8_BAR;
            PG8_LDA(At, 0, 1); PG8_STAGE(PG8_SA(0, 0), a2, voffA);
            PG8_BAR; PG8_WAIT_L(0); PG8_MMA(1, 0, At, B0); PG8_BAR; PG8_SCHED;
            PG8_STAGE(PG8_SB(0, 1), b2 + hstep, voffB);
            PG8_WAIT_V(6); PG8_BAR; PG8_MMA(1, 1, At, B1); PG8_BAR;
            PG8_LDB(B0, 1, 0); PG8_SCHED; PG8_LDA(At, 1, 0); PG8_STAGE(PG8_SA(0, 1), a2 + hstep, voffA);
            PG8_WAIT_L(8); PG8_BAR; PG8_WAIT_L(0); PG8_MMA(0, 0, At, B0); PG8_BAR; PG8_SCHED;
            PG8_LDB(B1, 1, 1); PG8_STAGE(PG8_SB(1, 0), b3, voffB);
            PG8_BAR; PG8_WAIT_L(0); PG8_MMA(0, 1, At, B1); PG8_BAR;
            PG8_LDA(At, 1, 1); PG8_STAGE(PG8_SA(1, 0), a3, voffA);
            PG8_BAR; PG8_WAIT_L(0); PG8_MMA(1, 0, At, B0); PG8_BAR; PG8_SCHED;
            PG8_STAGE(PG8_SB(1, 1), b3 + hstep, voffB);
            PG8_WAIT_V(6); PG8_BAR; PG8_MMA(1, 1, At, B1); PG8_BAR;
            }
        }
        if constexpr (ALIGN_EPI) { if (wr == 0) PG8_BAR; }
        if constexpr (!Epi::AFTER_DRAIN) { E(acc, cur, wr, wc, fr, fq); S.done(cur); }
        if (!has_next) break;
#pragma unroll
        for (int a = 0; a < 2; ++a)
#pragma unroll
            for (int b = 0; b < 2; ++b)
#pragma unroll
                for (int m = 0; m < 4; ++m)
#pragma unroll
                    for (int n = 0; n < 2; ++n) acc[a][b][m][n] = (f32x4){0.f, 0.f, 0.f, 0.f};
        cur = nxt; cA = nA; cB = nB; ++ui;
        if constexpr (ALIGN_EPI) { if (wr == 1) PG8_BAR; }
    }
    PG8_WAIT_V(0);
    if constexpr (!ALIGN_EPI) { if (wr == 0) PG8_BAR; }
    PG8_BAR;
    if constexpr (Epi::AFTER_DRAIN) { E.fused(acc, cur, wr, wc, fr, fq, lds, wid, lane); S.done(cur); }
#undef PG8_SA
#undef PG8_SB
#undef PG8_STAGE
#undef PG8_LDA
#undef PG8_LDB
#undef PG8_MMA
#undef PG8_WAIT_V
#undef PG8_WAIT_L
#undef PG8_BAR
#undef PG8_SCHED
}
}

constexpr int SEQ = 4096, NB = 2, T_ = NB * SEQ, DM = 2048, INW = 6176, FF = 5632;
constexpr int AH = 16, AD = 64, AW = 1024;
constexpr int GH = 4, GDK = 128, GDV = 256, GKW = 512, GVW = 1024, GRANK = 16;
constexpr float NORM_EPS = 1e-6f;
constexpr float LOG2E = 1.4426950408889634f;
constexpr int NWAVES = 8;
constexpr int NPHASE = 8;
#ifndef MK_LAUNCHES
#define MK_LAUNCHES 1
#endif

constexpr size_t MiB = 1u << 20;
constexpr size_t WS_CTL = 0;
constexpr size_t WS_BIAS2 = 64 * 1024;
constexpr size_t WS_SSQ1 = 128 * 1024;
constexpr size_t WS_WIN = 1 * MiB;
constexpr size_t WS_WOUT = 26 * MiB;
constexpr size_t WS_WGU = 34 * MiB;
constexpr size_t WS_WDN = 78 * MiB;
constexpr size_t WS_XN = 100 * MiB;
constexpr size_t WS_RB = 132 * MiB;
constexpr size_t WS_END = 229 * MiB;
constexpr size_t E_AQ = 0, E_AK = (size_t)T_ * 1024, E_AV = 2 * (size_t)T_ * 1024, E_GQ = 3 * (size_t)T_ * 1024, E_GK = E_GQ + (size_t)T_ * 512,
                 E_GVT = 4 * (size_t)T_ * 1024, E_GR = 5 * (size_t)T_ * 1024, E_GLR = 6 * (size_t)T_ * 1024;

#define GAS __attribute__((address_space(1)))
#define LAS __attribute__((address_space(3)))
typedef unsigned short bf16;
typedef unsigned v4u __attribute__((ext_vector_type(4)));
typedef unsigned v2u __attribute__((ext_vector_type(2)));
typedef float f32x4 __attribute__((ext_vector_type(4)));
#define LDS_WAIT() asm volatile("s_waitcnt lgkmcnt(0)" ::: "memory")
__device__ __forceinline__ unsigned f2bf(float f) { unsigned u = __builtin_bit_cast(unsigned, f); return (u + 0x7fffu + ((u >> 16) & 1u)) >> 16; }
__device__ __forceinline__ unsigned pk2(float lo, float hi) { return f2bf(lo) | (f2bf(hi) << 16); }
__device__ __forceinline__ float bf2f(unsigned b) { return __builtin_bit_cast(float, b << 16); }
__device__ __forceinline__ float bflo(unsigned w) { return __builtin_bit_cast(float, w << 16); }
__device__ __forceinline__ float bfhi(unsigned w) { return __builtin_bit_cast(float, w & 0xffff0000u); }
__device__ __forceinline__ float wave_sum(float v) {
#pragma unroll
    for (int o = 1; o < 64; o <<= 1) v += __shfl_xor(v, o);
    return v;
}
__device__ __forceinline__ float wave_max(float v) {
#pragma unroll
    for (int o = 1; o < 64; o <<= 1) v = fmaxf(v, __shfl_xor(v, o));
    return v;
}

namespace pg8 {
struct EpiProj {
    static constexpr bool PERM = true, AFTER_DRAIN = false;
    bf16_t* rb;
    __device__ __forceinline__ void operator()(const f32x4 (&acc)[2][2][4][2], const Unit& u, int wr, int wc, int fr, int fq) const {
        const int pn = u.pn; bf16_t* base; int ldc, colt;
        if (pn < 12) { base = rb + (size_t)(pn >> 2) * ((size_t)T_ * 1024); ldc = 1024; colt = (pn & 3) * 256; }
        else if (pn < 16) { base = rb + E_GQ + (size_t)((pn - 12) >> 1) * ((size_t)T_ * 512); ldc = 512; colt = ((pn - 12) & 1) * 256; }
        else { base = rb + E_GR; ldc = 1024; colt = (pn - 16) * 256; }
        const int row0 = u.pm * BM + wr * 64 + fr, col0 = colt + wc * 32 + 8 * fq;
#pragma unroll
        for (int ai = 0; ai < 2; ++ai)
#pragma unroll
            for (int m = 0; m < 4; ++m) { bf16_t* rowp = base + (size_t)(row0 + ai * HALF + m * 16) * ldc + col0;
#pragma unroll
                for (int bj = 0; bj < 2; ++bj) { const f32x4 v0 = acc[ai][bj][m][0], v1 = acc[ai][bj][m][1];
                    u32x4 w; w.x = cvt_pk_bf16(v0[0], v0[1]); w.y = cvt_pk_bf16(v0[2], v0[3]); w.z = cvt_pk_bf16(v1[0], v1[1]); w.w = cvt_pk_bf16(v1[2], v1[3]);
                    *(u32x4*)(rowp + bj * HALF) = w; } }
    }
};
struct EpiPlain {
    static constexpr bool PERM = true, AFTER_DRAIN = false;
    bf16_t* O; int ldc;
    __device__ __forceinline__ void operator()(const f32x4 (&acc)[2][2][4][2], const Unit& u, int wr, int wc, int fr, int fq) const {
        const int row0 = u.pm * BM + wr * 64 + fr, col0 = u.pn * BM + wc * 32 + 8 * fq;
#pragma unroll
        for (int ai = 0; ai < 2; ++ai)
#pragma unroll
            for (int m = 0; m < 4; ++m) { bf16_t* rowp = O + (size_t)(row0 + ai * HALF + m * 16) * ldc + col0;
#pragma unroll
                for (int bj = 0; bj < 2; ++bj) { const f32x4 v0 = acc[ai][bj][m][0], v1 = acc[ai][bj][m][1];
                    u32x4 w; w.x = cvt_pk_bf16(v0[0], v0[1]); w.y = cvt_pk_bf16(v0[2], v0[3]); w.z = cvt_pk_bf16(v1[0], v1[1]); w.w = cvt_pk_bf16(v1[2], v1[3]);
                    *(u32x4*)(rowp + bj * HALF) = w; } }
    }
};
template <bool AUX> struct EpiRes {
    static constexpr bool PERM = false, AFTER_DRAIN = true;
    const float* base; float* out; bf16_t* xb; float* ssq;
    __device__ __forceinline__ void fused(f32x4 (&acc)[2][2][4][2], const Unit& u, int wr, int wc, int fr, int fq, PG8_LAS unsigned char* lds, int wid, int lane) const {
        PG8_LAS float* P = (PG8_LAS float*)lds;
        const int col0 = u.pn * BM + wc * 32 + 4 * fq;
#pragma unroll
        for (int ai = 0; ai < 2; ++ai)
#pragma unroll
            for (int m = 0; m < 4; ++m) { const int rl = ai * HALF + wr * 64 + m * 16 + fr; const size_t off = (size_t)(u.pm * BM + rl) * DM + col0; float s = 0.f;
#pragma unroll
                for (int bj = 0; bj < 2; ++bj)
#pragma unroll
                    for (int n = 0; n < 2; ++n) { const f32x4 bs = *(const f32x4*)(base + off + bj * HALF + n * 16); const f32x4 v = bs + acc[ai][bj][m][n];
                        *(f32x4*)(out + off + bj * HALF + n * 16) = v;
                        if (AUX) { s += (v[0] * v[0] + v[1] * v[1]) + (v[2] * v[2] + v[3] * v[3]);
                            typedef unsigned u32x2 __attribute__((ext_vector_type(2))); u32x2 w; w.x = cvt_pk_bf16(v[0], v[1]); w.y = cvt_pk_bf16(v[2], v[3]);
                            *(u32x2*)(xb + off + bj * HALF + n * 16) = w; } }
                if (AUX) { s += __shfl_xor(s, 16); s += __shfl_xor(s, 32); if (fq == 0) P[rl * 4 + wc] = s; }
            }
        if (AUX) {
            asm volatile("s_waitcnt lgkmcnt(0)" ::: "memory"); __builtin_amdgcn_s_barrier(); asm volatile("" ::: "memory");
            const int tid = wid * 64 + lane;
            if (tid < 256) { const float s = (P[tid * 4 + 0] + P[tid * 4 + 1]) + (P[tid * 4 + 2] + P[tid * 4 + 3]); ssq[(size_t)(u.pm * BM + tid) * 8 + u.pn] = s; }
        }
    }
};
struct EpiSwiglu {
    static constexpr bool PERM = true, AFTER_DRAIN = false;
    bf16_t* H; const float* ssq;
    __device__ __forceinline__ void operator()(const f32x4 (&acc)[2][2][4][2], const Unit& u, int wr, int wc, int fr, int fq) const {
        const int row0 = u.pm * BM + wr * 64 + fr, col0 = u.pn * HALF + wc * 32 + 8 * fq;
#pragma unroll
        for (int ai = 0; ai < 2; ++ai)
#pragma unroll
            for (int m = 0; m < 4; ++m) { const int r = row0 + ai * HALF + m * 16;
                const f32x4 s0 = *(const f32x4*)(ssq + (size_t)r * 8), s1 = *(const f32x4*)(ssq + (size_t)r * 8 + 4);
                const float tot = ((s0[0] + s0[1]) + (s0[2] + s0[3])) + ((s1[0] + s1[1]) + (s1[2] + s1[3]));
                const float rstd = rsqrtf(tot * (1.0f / DM) + NORM_EPS);
                float hv[8];
#pragma unroll
                for (int n = 0; n < 2; ++n)
#pragma unroll
                    for (int i = 0; i < 4; ++i) { const float g = acc[ai][0][m][n][i] * rstd, up = acc[ai][1][m][n][i] * rstd; hv[n * 4 + i] = g / (1.0f + __expf(-g)) * up; }
                u32x4 w; w.x = cvt_pk_bf16(hv[0], hv[1]); w.y = cvt_pk_bf16(hv[2], hv[3]); w.z = cvt_pk_bf16(hv[4], hv[5]); w.w = cvt_pk_bf16(hv[6], hv[7]);
                *(u32x4*)(H + (size_t)r * FF + col0) = w; }
    }
};
}

constexpr int RING_BYTES = 131072;
constexpr int LDS_BYTES = 147456;
struct Args { const float* in[15]; float* out; unsigned char* ws; int ph_lo, ph_hi; };

__device__ __forceinline__ void p0_item(const float* __restrict__ W, int K, int N, bf16* WT, int k0, int n0, int drow0, const float* __restrict__ kscale, float nscale, LAS float* scr, int lane) {
#pragma unroll 8
    for (int i = 0; i < 32; ++i) { const int kk = 2 * i + (lane >> 5); float v = W[(size_t)(k0 + kk) * N + n0 + (lane & 31)]; if (kscale) v *= kscale[k0 + kk]; scr[kk * 33 + (lane & 31)] = v * nscale; }
    LDS_WAIT(); asm volatile("" ::: "memory");
    const int c = lane & 7;
#pragma unroll
    for (int j = 0; j < 4; ++j) { const int n = (lane >> 3) + 8 * j; const LAS float* s = scr + (8 * c) * 33 + n;
        v4u o; o.x = pk2(s[0 * 33], s[1 * 33]); o.y = pk2(s[2 * 33], s[3 * 33]); o.z = pk2(s[4 * 33], s[5 * 33]); o.w = pk2(s[6 * 33], s[7 * 33]);
        *(v4u*)(WT + (size_t)(drow0 + n) * K + k0 + 8 * c) = o; }
    LDS_WAIT(); asm volatile("" ::: "memory");
}

__device__ __forceinline__ int t5_bucket(int rel) {
    const int nb = 16, max_exact = 8; int ret = rel > 0 ? nb : 0; const int n = rel < 0 ? -rel : rel;
    if (n < max_exact) return ret + n;
    int large = max_exact + (int)(log((double)n / (double)max_exact) / log(1024.0 / 8.0) * (double)(nb - max_exact));
    if (large > nb - 1) large = nb - 1;
    return ret + large;
}

__global__ void __launch_bounds__(NWAVES * 64, 2) fwd(Args args) {
    extern __shared__ __attribute__((aligned(16))) unsigned char lds_raw[];
    LAS unsigned char* lds = (LAS unsigned char*)lds_raw;
    const int tid = threadIdx.x, lane = tid & 63, wave = __builtin_amdgcn_readfirstlane(tid >> 6);
    const int G = gridDim.x; const int bx = blockIdx.x; const int vcu = (G % 8 == 0) ? (bx % 8) * (G / 8) + bx / 8 : bx;
    const int gw = vcu * NWAVES + wave, NGW = G * NWAVES;
    unsigned char* ws = args.ws;
    const float* x = args.in[0]; float* out = args.out;
    bf16* Wt_in = (bf16*)(ws + WS_WIN); bf16* Wt_out = (bf16*)(ws + WS_WOUT); bf16* Wt_gu = (bf16*)(ws + WS_WGU); bf16* Wt_dn = (bf16*)(ws + WS_WDN);
    bf16* XN = (bf16*)(ws + WS_XN); bf16* RB = (bf16*)(ws + WS_RB);
    float* BIAS2 = (float*)(ws + WS_BIAS2); float* SSQ1 = (float*)(ws + WS_SSQ1);
    float* GLR = (float*)(RB + E_GLR);
    bf16* OF = (bf16*)(ws + WS_XN); bf16* OB = OF + (size_t)T_ * 1024;
    bf16* Y = RB;
    bf16* X1B = (bf16*)(ws + WS_XN);
    bf16* HB = RB;
    bf16* ATT = (bf16*)out;
    const int lo = args.ph_lo, hi = args.ph_hi;
#define IN(k) (lo <= (k) && (k) < hi)
#define SEAM(k) do { if (IN(k) && IN((k) + 1)) { cg::this_grid().sync(); } } while (0)

    if (IN(0)) {
        LAS float* scr = (LAS float*)(lds + wave * 16384);
        constexpr int I_IN = 32 * 193, I_OUT = 32 * 64, I_G = 32 * 176, I_D = 88 * 64, NITEMS = I_IN + I_OUT + 2 * I_G + I_D;
        for (int it = gw; it < NITEMS; it += NGW) {
            int r = it;
            if (r < I_IN) { const int kb = r / 193, nb = r % 193, n0 = nb * 32;
                int drow; float sc = 1.f;
                if (n0 < 1024) { drow = n0; sc = 0.125f * LOG2E; }
                else if (n0 < 3072) drow = n0;
                else if (n0 < 3584) { drow = n0; sc = 0.08838834764831845f; }
                else if (n0 < 4096) drow = n0;
                else if (n0 < 5120) drow = n0 + 1024;
                else if (n0 < 6144) drow = n0 - 1024;
                else drow = n0;
                p0_item(args.in[2], DM, INW, Wt_in, kb * 64, n0, drow, nullptr, sc, scr, lane); continue; }
            r -= I_IN;
            if (r < I_OUT) { const int kb = r / 64, nb = r % 64; p0_item(args.in[9], DM, DM, Wt_out, kb * 64, nb * 32, nb * 32, nullptr, 1.f, scr, lane); continue; }
            r -= I_OUT;
            if (r < I_G) { const int kb = r / 176, nb = r % 176, n0 = nb * 32; p0_item(args.in[11], DM, FF, Wt_gu, kb * 64, n0, (n0 >> 7) * 256 + (n0 & 127), args.in[10], 1.f, scr, lane); continue; }
            r -= I_G;
            if (r < I_G) { const int kb = r / 176, nb = r % 176, n0 = nb * 32; p0_item(args.in[12], DM, FF, Wt_gu, kb * 64, n0, (n0 >> 7) * 256 + 128 + (n0 & 127), args.in[10], 1.f, scr, lane); continue; }
            r -= I_G;
            { const int kb = r / 64, nb = r % 64; p0_item(args.in[13], FF, DM, Wt_dn, kb * 64, nb * 32, nb * 32, nullptr, 1.f, scr, lane); }
        }
        const float* nw = args.in[1];
        for (int m = gw; m < T_; m += NGW) {
            const f32x4* xr = (const f32x4*)(x + (size_t)m * DM) + lane; f32x4 v[8]; float s = 0.f;
#pragma unroll
            for (int j = 0; j < 8; ++j) { v[j] = xr[64 * j]; s += (v[j][0] * v[j][0] + v[j][1] * v[j][1]) + (v[j][2] * v[j][2] + v[j][3] * v[j][3]); }
            const float rstd = rsqrtf(wave_sum(s) * (1.f / DM) + NORM_EPS);
            v2u* o8 = (v2u*)(XN + (size_t)m * DM) + lane;
#pragma unroll
            for (int j = 0; j < 8; ++j) { const f32x4 w = ((const f32x4*)nw)[lane + 64 * j]; v2u o; o.x = pk2(v[j][0] * rstd * w[0], v[j][1] * rstd * w[1]); o.y = pk2(v[j][2] * rstd * w[2], v[j][3] * rstd * w[3]); o8[64 * j] = o; }
        }
        if (bx == 0) {
            const float* tbl = args.in[3];
            for (int idx = tid; idx < 3 * 129; idx += NWAVES * 64) { const int p = idx / 129, s = idx % 129; const int r = (p == 0) ? 1 : (p == 1 ? 4 : 16);
                const int bk = t5_bucket((s - 64) * r);
                for (int h = 0; h < 16; ++h) BIAS2[idx * 16 + h] = tbl[bk * 16 + h] * LOG2E; }
        }
    }
    SEAM(0);

    if (IN(1)) {
        { pg8::Gemm g{XN, Wt_in, T_, 5120, DM}; pg8::StaticOrder S; S.init(T_, 5120, G, bx); pg8::EpiProj E{RB};
          pg8::gemm_phase<pg8::EpiProj, pg8::StaticOrder, true, true>(lds, g, S, E); }
        { pg8::Gemm g{Wt_in + (size_t)5120 * DM, XN, 1024, T_, DM}; pg8::StaticOrder S; S.init(1024, T_, G, (bx + G / 2) % G); pg8::EpiPlain E{RB + E_GVT, T_};
          pg8::gemm_phase<pg8::EpiPlain, pg8::StaticOrder, true, true>(lds, g, S, E); }
        for (int o = vcu * 512 + tid; o < T_ * 32; o += G * 512) { const int t = o >> 5, j = o & 31;
            const v4u* a = (const v4u*)(XN + (size_t)t * DM); const v4u* b = (const v4u*)(Wt_in + (size_t)(6144 + j) * DM); float s = 0.f;
            for (int k = 0; k < DM / 8; ++k) { const v4u av = a[k], bv = b[k];
                s += bflo(av.x) * bflo(bv.x) + bfhi(av.x) * bfhi(bv.x) + bflo(av.y) * bflo(bv.y) + bfhi(av.y) * bfhi(bv.y)
                   + bflo(av.z) * bflo(bv.z) + bfhi(av.z) * bfhi(bv.z) + bflo(av.w) * bflo(bv.w) + bfhi(av.w) * bfhi(bv.w); }
            GLR[o] = s; }
    }
    SEAM(1);

    if (IN(2)) {
        const bf16* AQ = RB + E_AQ; const bf16* AK = RB + E_AK; const bf16* AV = RB + E_AV;
        const bf16* GQ = RB + E_GQ; const bf16* GK = RB + E_GK; const bf16* GVT = RB + E_GVT;
        if (bx < 16) {
            const int dir = bx & 1, h = (bx >> 1) & 3, b = bx >> 3;
            const float* gwt = dir ? args.in[6] : args.in[4]; const float* gbs = dir ? args.in[7] : args.in[5];
            LAS float* a_s = (LAS float*)lds; LAS float* q_s = a_s + 64 * 128; LAS float* k_s = q_s + 64 * 128;
            float S[128];
#pragma unroll
            for (int d = 0; d < 128; ++d) S[d] = 0.f;
            const int d_ = tid & 127, cg_ = tid >> 7;
            float gwr[16];
#pragma unroll
            for (int r = 0; r < 16; ++r) gwr[r] = gwt[r * GKW + h * 128 + d_];
            const float gb = gbs[h * 128 + d_];
            for (int blk = 0; blk < 64; ++blk) {
                __syncthreads();
                for (int cc = 0; cc < 16; ++cc) { const int c = cg_ * 16 + cc; const int t = dir ? (SEQ - 1 - (blk * 64 + c)) : (blk * 64 + c); const size_t row = (size_t)b * SEQ + t;
                    float z = gb;
#pragma unroll
                    for (int r = 0; r < 16; ++r) z += GLR[row * 32 + dir * 16 + r] * gwr[r];
                    const float la = (fminf(z, 0.f) - log1pf(__expf(-fabsf(z)))) * (1.0f / 16.0f);
                    a_s[c * 128 + d_] = __expf(la);
                    q_s[c * 128 + d_] = bf2f(GQ[row * GKW + h * 128 + d_]);
                    k_s[c * 128 + d_] = bf2f(GK[row * GKW + h * 128 + d_]); }
                __syncthreads();
                if (tid < 256) {
                    const int tlo = dir ? (SEQ - 1 - (blk * 64 + 63)) : (blk * 64);
                    const bf16* vrow = GVT + (size_t)(h * 256 + tid) * T_ + (size_t)b * SEQ + tlo;
                    bf16* orow = (dir ? OB : OF);
                    for (int c = 0; c < 64; ++c) { const int ti = dir ? (63 - c) : c; const float vt = bf2f(vrow[ti]); float o = 0.f;
                        const LAS f32x4* a4 = (const LAS f32x4*)(a_s + c * 128); const LAS f32x4* q4 = (const LAS f32x4*)(q_s + c * 128); const LAS f32x4* k4 = (const LAS f32x4*)(k_s + c * 128);
#pragma unroll
                        for (int d4 = 0; d4 < 32; ++d4) { const f32x4 av = a4[d4], qv = q4[d4], kv = k4[d4];
#pragma unroll
                            for (int i = 0; i < 4; ++i) { S[d4 * 4 + i] = av[i] * S[d4 * 4 + i] + kv[i] * vt; o += qv[i] * S[d4 * 4 + i]; } }
                        orow[((size_t)b * SEQ + tlo + ti) * GVW + h * 256 + tid] = (bf16)f2bf(o); }
                }
            }
            __syncthreads();
        }
        if (bx >= 16 || G <= 16) {
            const int nw0 = (G > 16) ? (bx - 16) * NWAVES + wave : gw; const int nws = (G > 16) ? (G - 16) * NWAVES : NGW;
            for (int item = nw0; item < NB * AH * SEQ; item += nws) {
                const int q = item & (SEQ - 1), h = (item >> 12) & 15, b = item >> 16;
                const size_t rowq = (size_t)b * SEQ + q;
                float qv[64];
                { const v4u* qp = (const v4u*)(AQ + rowq * AW + h * AD);
#pragma unroll
                  for (int i = 0; i < 8; ++i) { const v4u w = qp[i]; qv[8 * i + 0] = bflo(w.x); qv[8 * i + 1] = bfhi(w.x); qv[8 * i + 2] = bflo(w.y); qv[8 * i + 3] = bfhi(w.y); qv[8 * i + 4] = bflo(w.z); qv[8 * i + 5] = bfhi(w.z); qv[8 * i + 6] = bflo(w.w); qv[8 * i + 7] = bfhi(w.w); } }
                float op[3], lse[3];
#pragma unroll
                for (int p = 0; p < 3; ++p) { const int r = (p == 0) ? 1 : (p == 1 ? 4 : 16);
                    float lg[3];
#pragma unroll
                    for (int i = 0; i < 3; ++i) { const int s = lane + 64 * i; const int kp = q + (s - 64) * r; const bool valid = (s < 129) && (kp >= 0) && (kp < SEQ);
                        float dot = -INFINITY;
                        if (valid) { const v4u* kr = (const v4u*)(AK + ((size_t)b * SEQ + kp) * AW + h * AD); float a = 0.f;
#pragma unroll
                            for (int j = 0; j < 8; ++j) { const v4u w = kr[j]; a += qv[8 * j + 0] * bflo(w.x) + qv[8 * j + 1] * bfhi(w.x) + qv[8 * j + 2] * bflo(w.y) + qv[8 * j + 3] * bfhi(w.y) + qv[8 * j + 4] * bflo(w.z) + qv[8 * j + 5] * bfhi(w.z) + qv[8 * j + 6] * bflo(w.w) + qv[8 * j + 7] * bfhi(w.w); }
                            dot = a + BIAS2[(p * 129 + s) * 16 + h]; }
                        lg[i] = dot; }
                    const float m = wave_max(fmaxf(fmaxf(lg[0], lg[1]), lg[2]));
                    float pr[3];
#pragma unroll
                    for (int i = 0; i < 3; ++i) pr[i] = exp2f(lg[i] - m);
                    const float ssum = wave_sum(pr[0] + pr[1] + pr[2]);
                    float o = 0.f;
                    for (int s = 0; s < 129; ++s) { const int kp = q + (s - 64) * r; if (kp < 0 || kp >= SEQ) continue;
                        const float pk = __shfl(s < 64 ? pr[0] : (s < 128 ? pr[1] : pr[2]), s & 63);
                        o += pk * bf2f(AV[((size_t)b * SEQ + kp) * AW + h * AD + lane]); }
                    op[p] = o / ssum; lse[p] = m + log2f(ssum); }
                const float M = fmaxf(fmaxf(lse[0], lse[1]), lse[2]);
                const float w0 = exp2f(lse[0] - M), w1 = exp2f(lse[1] - M), w2 = exp2f(lse[2] - M);
                const float res = (w0 * op[0] + w1 * op[1] + w2 * op[2]) / (w0 + w1 + w2);
                ATT[rowq * AW + h * AD + lane] = (bf16)f2bf(res);
            }
        }
    }
    SEAM(2);

    if (IN(3)) {
        const bf16* GR = RB + E_GR; const float* gnw = args.in[8];
        for (int item = gw; item < T_ * 8; item += NGW) { const int row = item >> 3, part = item & 7;
            if (part < 4) {
                const v2u v = ((const v2u*)(ATT + (size_t)row * AW + part * 256))[lane];
                ((v2u*)(Y + (size_t)row * DM + part * 256))[lane] = v;
            } else { const int h = part - 4; const size_t o = (size_t)row * GVW + h * 256;
                const v2u a = ((const v2u*)(OF + o))[lane], c = ((const v2u*)(OB + o))[lane], g = ((const v2u*)(GR + o))[lane];
                float v[4] = {bflo(a.x) + bflo(c.x), bfhi(a.x) + bfhi(c.x), bflo(a.y) + bflo(c.y), bfhi(a.y) + bfhi(c.y)};
                const float gr[4] = {bflo(g.x), bfhi(g.x), bflo(g.y), bfhi(g.y)};
                const float ss = wave_sum((v[0] * v[0] + v[1] * v[1]) + (v[2] * v[2] + v[3] * v[3]));
                const float rstd = rsqrtf(ss * (1.0f / 256.0f) + NORM_EPS);
                const f32x4 w = ((const f32x4*)(gnw + h * 256))[lane];
                float y[4];
#pragma unroll
                for (int i = 0; i < 4; ++i) y[i] = v[i] * rstd * w[i] * (gr[i] / (1.0f + __expf(-gr[i])));
                v2u ov; ov.x = pk2(y[0], y[1]); ov.y = pk2(y[2], y[3]);
                ((v2u*)(Y + (size_t)row * DM + 1024 + h * 256))[lane] = ov; }
        }
    }
    SEAM(3);

    if (IN(4)) {
        pg8::Gemm g{Y, Wt_out, T_, DM, DM}; pg8::StaticOrder S; S.init(T_, DM, G, bx); pg8::EpiRes<true> E{x, out, X1B, SSQ1};
        pg8::gemm_phase<pg8::EpiRes<true>, pg8::StaticOrder, false, true>(lds, g, S, E);
    }
    SEAM(4);

    if (IN(5)) {
        pg8::Gemm g{X1B, Wt_gu, T_, 2 * FF, DM}; pg8::StaticOrder S; S.init(T_, 2 * FF, G, bx); pg8::EpiSwiglu E{HB, SSQ1};
        pg8::gemm_phase<pg8::EpiSwiglu, pg8::StaticOrder, true, true>(lds, g, S, E);
    }
    SEAM(5);

    if (IN(6)) {
        pg8::Gemm g{HB, Wt_dn, T_, DM, FF}; pg8::StaticOrder S; S.init(T_, DM, G, bx); pg8::EpiRes<false> E{out, out, nullptr, nullptr};
        pg8::gemm_phase<pg8::EpiRes<false>, pg8::StaticOrder, false, true>(lds, g, S, E);
    }
    SEAM(6);

    if (IN(7)) {
        const float* fw = args.in[14];
        for (int m = gw; m < T_; m += NGW) {
            f32x4* xr = (f32x4*)(out + (size_t)m * DM) + lane; f32x4 v[8]; float s = 0.f;
#pragma unroll
            for (int j = 0; j < 8; ++j) { v[j] = xr[64 * j]; s += (v[j][0] * v[j][0] + v[j][1] * v[j][1]) + (v[j][2] * v[j][2] + v[j][3] * v[j][3]); }
            const float rstd = rsqrtf(wave_sum(s) * (1.f / DM) + NORM_EPS);
#pragma unroll
            for (int j = 0; j < 8; ++j) { const f32x4 w = ((const f32x4*)fw)[lane + 64 * j]; xr[64 * j] = v[j] * rstd * w; }
        }
    }
#undef IN
#undef SEAM
}

extern "C" void kernel_launch(void* const* d_in, const int* in_sizes, int n_in, void* d_out, int out_size, void* d_ws, size_t ws_size, hipStream_t stream) {
    static int grid = 0;
    if (grid == 0) {
        if (n_in != 15 || out_size != T_ * DM || ws_size < WS_END) { fprintf(stderr, "kernel_launch: unexpected shapes (n_in %d out %d ws %zu)\n", n_in, out_size, ws_size); grid = -1; return; }
        int dev = 0, cus = 0, per_cu = 0;
        if (hipGetDevice(&dev) != hipSuccess || hipDeviceGetAttribute(&cus, hipDeviceAttributeMultiprocessorCount, dev) != hipSuccess) { grid = -1; return; }
        if (hipFuncSetAttribute((const void*)fwd, hipFuncAttributeMaxDynamicSharedMemorySize, LDS_BYTES) != hipSuccess) { fprintf(stderr, "kernel_launch: hipFuncSetAttribute failed\n"); grid = -1; return; }
        if (hipOccupancyMaxActiveBlocksPerMultiprocessor(&per_cu, (const void*)fwd, NWAVES * 64, LDS_BYTES) != hipSuccess || per_cu < 1) { fprintf(stderr, "kernel_launch: occupancy query reports %d\n", per_cu); per_cu = 1; }
        (void)hipGetLastError();
        grid = cus;
    }
    if (grid < 0) return;
    Args a{};
    for (int i = 0; i < 15; ++i) a.in[i] = (const float*)d_in[i];
    a.out = (float*)d_out; a.ws = (unsigned char*)d_ws;
#if MK_LAUNCHES == 1
    a.ph_lo = 0; a.ph_hi = NPHASE;
    void* kargs[] = {&a};
    hipError_t e = hipLaunchCooperativeKernel((const void*)fwd, dim3(grid), dim3(NWAVES * 64), kargs, LDS_BYTES, stream);
    if (e != hipSuccess) fprintf(stderr, "kernel_launch: cooperative launch failed: %s (grid %d)\n", hipGetErrorString(e), grid);
#else
    for (int p = 0; p < NPHASE; ++p) { a.ph_lo = p; a.ph_hi = p + 1; hipLaunchKernelGGL(fwd, dim3(grid), dim3(NWAVES * 64), LDS_BYTES, stream, a); }
#endif
}
```

```cpp
#include <hip/hip_runtime.h>
#include <hip/hip_cooperative_groups.h>
#include <cstdio>
#include <cstdint>
namespace cg = cooperative_groups;

namespace pg8 {
#define PG8_LAS __attribute__((address_space(3)))
typedef unsigned short bf16_t;
typedef short bf16x8 __attribute__((ext_vector_type(8)));
typedef float f32x4 __attribute__((ext_vector_type(4)));
typedef unsigned u32x4 __attribute__((ext_vector_type(4)));
constexpr int BM = 256, BK = 64, HALF = 128, HTB = HALF * BK * 2  , STAGE_BYTES = 8 * HTB, NXCD = 8, WGM = 8;

__host__ __device__ __forceinline__ int lds_byte(int r, int c) { const int st = (r >> 4) * 2 + (c >> 5), rr = r & 15, cc = c & 31, ob = rr * 64 + cc * 2; return st * 1024 + (ob ^ (((ob >> 9) & 1) << 5)); }
__host__ __device__ __forceinline__ void stage_rc(int b, int& R, int& C) { const int st = b / 1024, sb = b % 1024, swz = sb ^ (((sb >> 9) & 1) << 5); R = (st >> 1) * 16 + swz / 64; C = (st & 1) * 32 + (swz % 64) / 2; }
__host__ __device__ __forceinline__ int perm32(int rho) { const int n = rho >> 4, i = rho & 15; return 8 * (i >> 2) + 4 * n + (i & 3); }

struct Unit { int pm, pn; };
struct Gemm { const bf16_t* A; const bf16_t* Bt; int M, N, K; };

struct StaticOrder {
    int nM, nN, nwg, G, c;
    __host__ __device__ void init(int M, int N, int G_, int c_) { nM = M / BM; nN = N / BM; nwg = nM * nN; G = G_; c = c_; }
    __host__ __device__ bool next(int i, Unit& u) const {
        const long L = (long)i * G + c; if (L >= nwg) return false;
        int wgid = (int)L; { const int q = nwg / NXCD, r = nwg % NXCD, xcd = wgid % NXCD, off = wgid / NXCD; wgid = (xcd < r ? xcd * (q + 1) : r * (q + 1) + (xcd - r) * q) + off; }
        const int nig = WGM * nN, gid = wgid / nig, fm = gid * WGM, gsz = (nM - fm) < WGM ? (nM - fm) : WGM;
        u.pm = fm + ((wgid % nig) % gsz); u.pn = (wgid % nig) / gsz; return true;
    }
    __device__ __forceinline__ void a_ready(const Unit&) const {}
    __device__ __forceinline__ void done(const Unit&) const {}
};

__device__ __forceinline__ unsigned cvt_pk_bf16(float lo, float hi) { unsigned r; asm volatile("v_cvt_pk_bf16_f32 %0, %1, %2" : "=v"(r) : "v"(lo), "v"(hi)); return r; }
template <class Epi, class Sched, bool ALIGN_EPI = false, bool SP2 = false>
__device__ __forceinline__ void gemm_phase(PG8_LAS unsigned char* lds, const Gemm g, const Sched& S, const Epi& E) {
    const int tid = threadIdx.x, wid = __builtin_amdgcn_readfirstlane(tid >> 6), lane = tid & 63, wr = wid >> 2, wc = wid & 3, fr = lane & 15, fq = lane >> 4;
    const int K = g.K, nt = K / BK;
    unsigned voffA[2], voffB[2];
#pragma unroll
    for (int i = 0; i < 2; ++i) { int R, C; stage_rc(tid * 16 + i * 8192, R, C); const int Rb = Epi::PERM ? ((R & ~31) + perm32(R & 31)) : R;
        voffA[i] = (unsigned)(R * K + C) * 2u; voffB[i] = (unsigned)(Rb * K + C) * 2u; }
    const size_t kstep = (size_t)(BK * 2);
    const size_t hstep = (size_t)HALF * K * 2;
    const size_t tstep = 2 * hstep;
    const unsigned ldsw = (unsigned)wid * 1024u;
    const int aoff = lds_byte(wr * 64 + fr, fq * 8), boff = lds_byte(wc * 32 + fr, fq * 8);
#define PG8_SA(b, h) (((b) * 2 + (h)) * HTB)
#define PG8_SB(b, h) ((4 + (b) * 2 + (h)) * HTB)
#define PG8_STAGE(bufoff, gbase, voff) do { _Pragma("unroll") for (int _i = 0; _i < 2; ++_i) \
        __builtin_amdgcn_global_load_lds((const unsigned*)((const char*)(gbase) + (voff)[_i]), (PG8_LAS unsigned*)(lds + (bufoff) + ldsw + _i * 8192), 16, 0, 0); } while (0)
#define PG8_LDA(dst, b, h) do { _Pragma("unroll") for (int m = 0; m < 4; ++m) _Pragma("unroll") for (int k = 0; k < 2; ++k) dst[m][k] = *(const PG8_LAS bf16x8*)(lds + PG8_SA(b, h) + aoff + m * 2048 + k * 1024); } while (0)
#define PG8_LDB(dst, b, h) do { _Pragma("unroll") for (int n = 0; n < 2; ++n) _Pragma("unroll") for (int k = 0; k < 2; ++k) dst[n][k] = *(const PG8_LAS bf16x8*)(lds + PG8_SB(b, h) + boff + n * 2048 + k * 1024); } while (0)
#define PG8_MMA(ai, bj, At, Bt) do { __builtin_amdgcn_s_setprio(1); _Pragma("unroll") for (int m = 0; m < 4; ++m) _Pragma("unroll") for (int n = 0; n < 2; ++n) _Pragma("unroll") for (int k = 0; k < 2; ++k) \
        acc[ai][bj][m][n] = __builtin_amdgcn_mfma_f32_16x16x32_bf16(Bt[n][k], At[m][k], acc[ai][bj][m][n], 0, 0, 0); __builtin_amdgcn_s_setprio(0); } while (0)
#define PG8_WAIT_V(n) asm volatile("s_waitcnt vmcnt(" #n ")" ::: "memory")
#define PG8_WAIT_L(n) asm volatile("s_waitcnt lgkmcnt(" #n ")" ::: "memory")
#define PG8_BAR __builtin_amdgcn_s_barrier()
#define PG8_SCHED __builtin_amdgcn_sched_barrier(0)
    Unit cur, nxt; int ui = 0;
    if (!S.next(0, cur)) return;
    f32x4 acc[2][2][4][2];
#pragma unroll
    for (int a = 0; a < 2; ++a)
#pragma unroll
        for (int b = 0; b < 2; ++b)
#pragma unroll
            for (int m = 0; m < 4; ++m)
#pragma unroll
                for (int n = 0; n < 2; ++n) acc[a][b][m][n] = (f32x4){0.f, 0.f, 0.f, 0.f};
    bf16x8 At[4][2], B0[2][2], B1[2][2];
    const char* cA = (const char*)g.A + (size_t)cur.pm * tstep; const char* cB = (const char*)g.Bt + (size_t)cur.pn * tstep;
    S.a_ready(cur);
    if constexpr (SP2) {
        PG8_STAGE(PG8_SB(0, 0), cB, voffB); PG8_STAGE(PG8_SB(0, 1), cB + hstep, voffB); PG8_STAGE(PG8_SA(0, 0), cA, voffA); PG8_STAGE(PG8_SA(0, 1), cA + hstep, voffA);
        if (wr == 1) PG8_BAR;
        PG8_WAIT_V(2); PG8_BAR;
        PG8_STAGE(PG8_SB(1, 0), cB + kstep, voffB); PG8_STAGE(PG8_SA(1, 0), cA + kstep, voffA); PG8_STAGE(PG8_SB(1, 1), cB + hstep + kstep, voffB);
        PG8_WAIT_V(6); PG8_BAR;
    } else {
        PG8_STAGE(PG8_SB(0, 0), cB, voffB); PG8_STAGE(PG8_SA(0, 0), cA, voffA); PG8_STAGE(PG8_SB(0, 1), cB + hstep, voffB); PG8_STAGE(PG8_SA(0, 1), cA + hstep, voffA);
        if (wr == 1) PG8_BAR;
        PG8_WAIT_V(4); PG8_BAR;
        PG8_STAGE(PG8_SB(1, 0), cB + kstep, voffB); PG8_STAGE(PG8_SA(1, 0), cA + kstep, voffA); PG8_STAGE(PG8_SB(1, 1), cB + hstep + kstep, voffB);
        PG8_WAIT_V(6); PG8_BAR;
    }
    for (;;) {
        const bool has_next = S.next(ui + 1, nxt);
        const char* nA = has_next ? (const char*)g.A + (size_t)nxt.pm * tstep : cA; const char* nB = has_next ? (const char*)g.Bt + (size_t)nxt.pn * tstep : cB;
        for (int t = 0; t < nt; t += 2) {
            const bool last = (t == nt - 2);
            const char* a1 = cA + (size_t)(t + 1) * kstep;
            const char* a2 = last ? nA : cA + (size_t)(t + 2) * kstep; const char* b2 = last ? nB : cB + (size_t)(t + 2) * kstep;
            const char* a3 = a2 + kstep; const char* b3 = b2 + kstep;
            if (last && has_next) S.a_ready(nxt);
            if constexpr (SP2) {
            PG8_LDB(B0, 0, 0); PG8_LDB(B1, 0, 1); PG8_SCHED; PG8_LDA(At, 0, 0); PG8_STAGE(PG8_SA(1, 1), a1 + hstep, voffA);
            PG8_WAIT_V(8); PG8_WAIT_L(0); PG8_BAR; PG8_MMA(0, 0, At, B0); PG8_MMA(0, 1, At, B1); PG8_BAR; PG8_SCHED;
            PG8_LDA(At, 0, 1); PG8_STAGE(PG8_SB(0, 0), b2, voffB); PG8_STAGE(PG8_SB(0, 1), b2 + hstep, voffB); PG8_STAGE(PG8_SA(0, 0), a2, voffA);
            PG8_WAIT_V(8); PG8_WAIT_L(0); PG8_BAR; PG8_MMA(1, 0, At, B0); PG8_MMA(1, 1, At, B1); PG8_BAR; PG8_SCHED;
            PG8_LDB(B0, 1, 0); PG8_LDB(B1, 1, 1); PG8_SCHED; PG8_LDA(At, 1, 0); PG8_STAGE(PG8_SA(0, 1), a2 + hstep, voffA);
            PG8_WAIT_V(8); PG8_WAIT_L(0); PG8_BAR; PG8_MMA(0, 0, At, B0); PG8_MMA(0, 1, At, B1); PG8_BAR; PG8_SCHED;
            PG8_LDA(At, 1, 1); PG8_STAGE(PG8_SB(1, 0), b3, voffB); PG8_STAGE(PG8_SB(1, 1), b3 + hstep, voffB); PG8_STAGE(PG8_SA(1, 0), a3, voffA);
            PG8_WAIT_V(8); PG8_WAIT_L(0); PG8_BAR; PG8_MMA(1, 0, At, B0); PG8_MMA(1, 1, At, B1); PG8_BAR; PG8_SCHED;
            } else {
            PG8_LDB(B0, 0, 0); PG8_SCHED; PG8_LDA(At, 0, 0); PG8_STAGE(PG8_SA(1, 1), a1 + hstep, voffA);
            PG8_WAIT_L(8); PG8_BAR; PG8_WAIT_L(0); PG8_MMA(0, 0, At, B0); PG8_BAR; PG8_SCHED;
            PG8_LDB(B1, 0, 1); PG8_STAGE(PG8_SB(0, 0), b2, voffB);
            PG8_BAR; PG8_WAIT_L(0); PG8_MMA(0, 1, At, B1); PG8_BAR;
            PG8_LDA(At, 0, 1); PG8_STAGE(PG8_SA(0, 0), a2, voffA);
            PG8_BAR; PG8_WAIT_L(0); PG8_MMA(1, 0, At, B0); PG8_BAR; PG8_SCHED;
            PG8_STAGE(PG8_SB(0, 1), b2 + hstep, voffB);
            PG8_WAIT_V(6); PG8_BAR; PG8_MMA(1, 1, At, B1); PG8_BAR;
            PG8_LDB(B0, 1, 0); PG8_SCHED; PG8_LDA(At, 1, 0); PG8_STAGE(PG8_SA(0, 1), a2 + hstep, voffA);
            PG8_WAIT_L(8); PG8_BAR; PG8_WAIT_L(0); PG8_MMA(0, 0, At, B0); PG8_BAR; PG8_SCHED;
            PG8_LDB(B1, 1, 1); PG8_STAGE(PG8_SB(1, 0), b3, voffB);
            PG8_BAR; PG8_WAIT_L(0); PG8_MMA(0, 1, At, B1); PG8_BAR;
            PG8_LDA(At, 1, 1); PG8_STAGE(PG8_SA(1, 0), a3, voffA);
            PG8_BAR; PG8_WAIT_L(0); PG8_MMA(1, 0, At, B0); PG8_BAR; PG8_SCHED;
            PG8_STAGE(PG8_SB(1, 1), b3 + hstep, voffB);
            PG8_WAIT_V(6); PG8_BAR; PG8_MMA(1, 1, At, B1); PG8_BAR;
            }
        }
        if constexpr (ALIGN_EPI) { if (wr == 0) PG8_BAR; }
        if constexpr (!Epi::AFTER_DRAIN) { E(acc, cur, wr, wc, fr, fq); S.done(cur); }
        if (!has_next) break;
#pragma unroll
        for (int a = 0; a < 2; ++a)
#pragma unroll
            for (int b = 0; b < 2; ++b)
#pragma unroll
                for (int m = 0; m < 4; ++m)
#pragma unroll
                    for (int n = 0; n < 2; ++n) acc[a][b][m][n] = (f32x4){0.f, 0.f, 0.f, 0.f};
        cur = nxt; cA = nA; cB = nB; ++ui;
        if constexpr (ALIGN_EPI) { if (wr == 1) PG8_BAR; }
    }
    PG8_WAIT_V(0);
    if constexpr (!ALIGN_EPI) { if (wr == 0) PG8_BAR; }
    PG8_BAR;
    if constexpr (Epi::AFTER_DRAIN) { E.fused(acc, cur, wr, wc, fr, fq, lds, wid, lane); S.done(cur); }
#undef PG8_SA
#undef PG8_SB
#undef PG8_STAGE
#undef PG8_LDA
#undef PG8_LDB
#undef PG8_MMA
#undef PG8_WAIT_V
#undef PG8_WAIT_L
#undef PG8_BAR
#undef PG8_SCHED
}
}

constexpr int SEQ = 4096, NB = 2, T_ = NB * SEQ, DM = 2048, INW = 6176, FF = 5632;
constexpr int AH = 16, AD = 64, AW = 1024;
constexpr int GH = 4, GDK = 128, GDV = 256, GKW = 512, GVW = 1024, GRANK = 16;
constexpr float NORM_EPS = 1e-6f;
constexpr float LOG2E = 1.4426950408889634f;
constexpr int NWAVES = 8;
constexpr int NPHASE = 9;
#ifndef MK_LAUNCHES
#define MK_LAUNCHES 1
#endif

constexpr size_t MiB = 1u << 20;
constexpr size_t WS_CTL = 0;
constexpr size_t WS_BIAS2 = 64 * 1024;
constexpr size_t WS_SSQ1 = 128 * 1024;
constexpr size_t WS_WIN = 1 * MiB;
constexpr size_t WS_WOUT = 26 * MiB;
constexpr size_t WS_WGU = 34 * MiB;
constexpr size_t WS_WDN = 78 * MiB;
constexpr size_t WS_XN = 100 * MiB;
constexpr size_t WS_RB = 132 * MiB;
constexpr size_t WS_END = 229 * MiB;
constexpr size_t E_AQ = 0, E_AK = (size_t)T_ * 1024, E_AV = 2 * (size_t)T_ * 1024, E_GQ = 3 * (size_t)T_ * 1024, E_GK = E_GQ + (size_t)T_ * 512,
                 E_GVT = 4 * (size_t)T_ * 1024, E_GR = 5 * (size_t)T_ * 1024, E_GLR = 6 * (size_t)T_ * 1024;

#define GAS __attribute__((address_space(1)))
#define LAS __attribute__((address_space(3)))
typedef unsigned short bf16;
typedef unsigned v4u __attribute__((ext_vector_type(4)));
typedef unsigned v2u __attribute__((ext_vector_type(2)));
typedef float f32x4 __attribute__((ext_vector_type(4)));
#define LDS_WAIT() asm volatile("s_waitcnt lgkmcnt(0)" ::: "memory")
__device__ __forceinline__ unsigned f2bf(float f) { unsigned u = __builtin_bit_cast(unsigned, f); return (u + 0x7fffu + ((u >> 16) & 1u)) >> 16; }
__device__ __forceinline__ unsigned pk2(float lo, float hi) { return f2bf(lo) | (f2bf(hi) << 16); }
__device__ __forceinline__ float bf2f(unsigned b) { return __builtin_bit_cast(float, b << 16); }
__device__ __forceinline__ float bflo(unsigned w) { return __builtin_bit_cast(float, w << 16); }
__device__ __forceinline__ float bfhi(unsigned w) { return __builtin_bit_cast(float, w & 0xffff0000u); }
__device__ __forceinline__ float wave_sum(float v) {
#pragma unroll
    for (int o = 1; o < 64; o <<= 1) v += __shfl_xor(v, o);
    return v;
}
__device__ __forceinline__ float wave_max(float v) {
#pragma unroll
    for (int o = 1; o < 64; o <<= 1) v = fmaxf(v, __shfl_xor(v, o));
    return v;
}

namespace pg8 {
struct EpiProj {
    static constexpr bool PERM = true, AFTER_DRAIN = false;
    bf16_t* rb;
    __device__ __forceinline__ void operator()(const f32x4 (&acc)[2][2][4][2], const Unit& u, int wr, int wc, int fr, int fq) const {
        const int pn = u.pn; bf16_t* base; int ldc, colt;
        if (pn < 12) { base = rb + (size_t)(pn >> 2) * ((size_t)T_ * 1024); ldc = 1024; colt = (pn & 3) * 256; }
        else if (pn < 16) { base = rb + E_GQ + (size_t)((pn - 12) >> 1) * ((size_t)T_ * 512); ldc = 512; colt = ((pn - 12) & 1) * 256; }
        else { base = rb + E_GR; ldc = 1024; colt = (pn - 16) * 256; }
        const int row0 = u.pm * BM + wr * 64 + fr, col0 = colt + wc * 32 + 8 * fq;
#pragma unroll
        for (int ai = 0; ai < 2; ++ai)
#pragma unroll
            for (int m = 0; m < 4; ++m) { bf16_t* rowp = base + (size_t)(row0 + ai * HALF + m * 16) * ldc + col0;
#pragma unroll
                for (int bj = 0; bj < 2; ++bj) { const f32x4 v0 = acc[ai][bj][m][0], v1 = acc[ai][bj][m][1];
                    u32x4 w; w.x = cvt_pk_bf16(v0[0], v0[1]); w.y = cvt_pk_bf16(v0[2], v0[3]); w.z = cvt_pk_bf16(v1[0], v1[1]); w.w = cvt_pk_bf16(v1[2], v1[3]);
                    *(u32x4*)(rowp + bj * HALF) = w; } }
    }
};
struct EpiPlain {
    static constexpr bool PERM = true, AFTER_DRAIN = false;
    bf16_t* O; int ldc;
    __device__ __forceinline__ void operator()(const f32x4 (&acc)[2][2][4][2], const Unit& u, int wr, int wc, int fr, int fq) const {
        const int row0 = u.pm * BM + wr * 64 + fr, col0 = u.pn * BM + wc * 32 + 8 * fq;
#pragma unroll
        for (int ai = 0; ai < 2; ++ai)
#pragma unroll
            for (int m = 0; m < 4; ++m) { bf16_t* rowp = O + (size_t)(row0 + ai * HALF + m * 16) * ldc + col0;
#pragma unroll
                for (int bj = 0; bj < 2; ++bj) { const f32x4 v0 = acc[ai][bj][m][0], v1 = acc[ai][bj][m][1];
                    u32x4 w; w.x = cvt_pk_bf16(v0[0], v0[1]); w.y = cvt_pk_bf16(v0[2], v0[3]); w.z = cvt_pk_bf16(v1[0], v1[1]); w.w = cvt_pk_bf16(v1[2], v1[3]);
                    *(u32x4*)(rowp + bj * HALF) = w; } }
    }
};
template <bool AUX> struct EpiRes {
    static constexpr bool PERM = false, AFTER_DRAIN = true;
    const float* base; float* out; bf16_t* xb; float* ssq;
    __device__ __forceinline__ void fused(f32x4 (&acc)[2][2][4][2], const Unit& u, int wr, int wc, int fr, int fq, PG8_LAS unsigned char* lds, int wid, int lane) const {
        PG8_LAS float* P = (PG8_LAS float*)lds;
        const int col0 = u.pn * BM + wc * 32 + 4 * fq;
#pragma unroll
        for (int ai = 0; ai < 2; ++ai)
#pragma unroll
            for (int m = 0; m < 4; ++m) { const int rl = ai * HALF + wr * 64 + m * 16 + fr; const size_t off = (size_t)(u.pm * BM + rl) * DM + col0; float s = 0.f;
#pragma unroll
                for (int bj = 0; bj < 2; ++bj)
#pragma unroll
                    for (int n = 0; n < 2; ++n) { const f32x4 bs = *(const f32x4*)(base + off + bj * HALF + n * 16); const f32x4 v = bs + acc[ai][bj][m][n];
                        *(f32x4*)(out + off + bj * HALF + n * 16) = v;
                        if (AUX) { s += (v[0] * v[0] + v[1] * v[1]) + (v[2] * v[2] + v[3] * v[3]);
                            typedef unsigned u32x2 __attribute__((ext_vector_type(2))); u32x2 w; w.x = cvt_pk_bf16(v[0], v[1]); w.y = cvt_pk_bf16(v[2], v[3]);
                            *(u32x2*)(xb + off + bj * HALF + n * 16) = w; } }
                if (AUX) { s += __shfl_xor(s, 16); s += __shfl_xor(s, 32); if (fq == 0) P[rl * 4 + wc] = s; }
            }
        if (AUX) {
            asm volatile("s_waitcnt lgkmcnt(0)" ::: "memory"); __builtin_amdgcn_s_barrier(); asm volatile("" ::: "memory");
            const int tid = wid * 64 + lane;
            if (tid < 256) { const float s = (P[tid * 4 + 0] + P[tid * 4 + 1]) + (P[tid * 4 + 2] + P[tid * 4 + 3]); ssq[(size_t)(u.pm * BM + tid) * 8 + u.pn] = s; }
        }
    }
};
struct EpiSwiglu {
    static constexpr bool PERM = true, AFTER_DRAIN = false;
    bf16_t* H; const float* ssq;
    __device__ __forceinline__ void operator()(const f32x4 (&acc)[2][2][4][2], const Unit& u, int wr, int wc, int fr, int fq) const {
        const int row0 = u.pm * BM + wr * 64 + fr, col0 = u.pn * HALF + wc * 32 + 8 * fq;
#pragma unroll
        for (int ai = 0; ai < 2; ++ai)
#pragma unroll
            for (int m = 0; m < 4; ++m) { const int r = row0 + ai * HALF + m * 16;
                const f32x4 s0 = *(const f32x4*)(ssq + (size_t)r * 8), s1 = *(const f32x4*)(ssq + (size_t)r * 8 + 4);
                const float tot = ((s0[0] + s0[1]) + (s0[2] + s0[3])) + ((s1[0] + s1[1]) + (s1[2] + s1[3]));
                const float rstd = rsqrtf(tot * (1.0f / DM) + NORM_EPS);
                float hv[8];
#pragma unroll
                for (int n = 0; n < 2; ++n)
#pragma unroll
                    for (int i = 0; i < 4; ++i) { const float g = acc[ai][0][m][n][i] * rstd, up = acc[ai][1][m][n][i] * rstd; hv[n * 4 + i] = g / (1.0f + __expf(-g)) * up; }
                u32x4 w; w.x = cvt_pk_bf16(hv[0], hv[1]); w.y = cvt_pk_bf16(hv[2], hv[3]); w.z = cvt_pk_bf16(hv[4], hv[5]); w.w = cvt_pk_bf16(hv[6], hv[7]);
                *(u32x4*)(H + (size_t)r * FF + col0) = w; }
    }
};
}

constexpr int RING_BYTES = 131072;
constexpr int LDS_BYTES = 147456;
struct Args { const float* in[15]; float* out; unsigned char* ws; int ph_lo, ph_hi; };
typedef short bf16x8 __attribute__((ext_vector_type(8)));
typedef float f32x16 __attribute__((ext_vector_type(16)));
__device__ __forceinline__ int crow(int r, int hi) { return (r & 3) + 8 * (r >> 2) + 4 * hi; }
typedef float f32x2_t __attribute__((ext_vector_type(2))); typedef __bf16 bf16x2_t __attribute__((ext_vector_type(2)));
__device__ __forceinline__ unsigned cvtpk(float lo, float hi) { f32x2_t v = {lo, hi}; bf16x2_t b = __builtin_convertvector(v, bf16x2_t); return __builtin_bit_cast(unsigned, b); }
template <int S> __device__ __forceinline__ bf16x8 pack8(const f32x16& a) {
    v4u w; w.x = cvtpk(a[8 * S + 0], a[8 * S + 1]); w.y = cvtpk(a[8 * S + 2], a[8 * S + 3]); w.z = cvtpk(a[8 * S + 4], a[8 * S + 5]); w.w = cvtpk(a[8 * S + 6], a[8 * S + 7]);
    return __builtin_bit_cast(bf16x8, w);
}
__device__ __forceinline__ bf16x8 join8(v2u lo, v2u hi) { v4u w; w.x = lo.x; w.y = lo.y; w.z = hi.x; w.w = hi.y; return __builtin_bit_cast(bf16x8, w); }
#define MFMA32(a, b, c) __builtin_amdgcn_mfma_f32_32x32x16_bf16((a), (b), (c), 0, 0, 0)

__device__ __forceinline__ void p0_item(const float* __restrict__ W, int K, int N, bf16* WT, int k0, int n0, int drow0, const float* __restrict__ kscale, float nscale, LAS float* scr, int lane) {
#pragma unroll 8
    for (int i = 0; i < 32; ++i) { const int kk = 2 * i + (lane >> 5); float v = W[(size_t)(k0 + kk) * N + n0 + (lane & 31)]; if (kscale) v *= kscale[k0 + kk]; scr[kk * 33 + (lane & 31)] = v * nscale; }
    LDS_WAIT(); asm volatile("" ::: "memory");
    const int c = lane & 7;
#pragma unroll
    for (int j = 0; j < 4; ++j) { const int n = (lane >> 3) + 8 * j; const LAS float* s = scr + (8 * c) * 33 + n;
        v4u o; o.x = pk2(s[0 * 33], s[1 * 33]); o.y = pk2(s[2 * 33], s[3 * 33]); o.z = pk2(s[4 * 33], s[5 * 33]); o.w = pk2(s[6 * 33], s[7 * 33]);
        *(v4u*)(WT + (size_t)(drow0 + n) * K + k0 + 8 * c) = o; }
    LDS_WAIT(); asm volatile("" ::: "memory");
}

__device__ __forceinline__ int t5_bucket(int rel) {
    const int nb = 16, max_exact = 8; int ret = rel > 0 ? nb : 0; const int n = rel < 0 ? -rel : rel;
    if (n < max_exact) return ret + n;
    int large = max_exact + (int)(log((double)n / (double)max_exact) / log(1024.0 / 8.0) * (double)(nb - max_exact));
    if (large > nb - 1) large = nb - 1;
    return ret + large;
}
__device__ __forceinline__ float logsig16(float z) { return (fminf(z, 0.f) - log1pf(__expf(-fabsf(z)))) * (1.0f / 16.0f); }

struct GlaBufs { const bf16* GQ; const bf16* GK; const bf16* GVT; const float* GLR; bf16* QINF; bf16* QINB; bf16* KETF; bf16* KETB; float* DECF; float* DECB; bf16* OI; bf16* OSF; bf16* OSB;
                 const float* gwF; const float* gbF; const float* gwB; const float* gbB; };
constexpr int GP = 136;
__device__ __forceinline__ f32x16 gla_xtile(const LAS bf16* Ks, const LAS bf16* Qs, int jt, int ct, int l31, int hi) {
    f32x16 acc = {};
    const LAS bf16* kp = Ks + (32 * jt + l31) * GP + 8 * hi; const LAS bf16* qp = Qs + (32 * ct + l31) * GP + 8 * hi;
#pragma unroll
    for (int d0 = 0; d0 < 8; ++d0) { const bf16x8 a = *(const LAS bf16x8*)(kp + 16 * d0); const bf16x8 b = *(const LAS bf16x8*)(qp + 16 * d0); acc = MFMA32(a, b, acc); }
    return acc;
}
__device__ __forceinline__ void gla_unit(int unit, const GlaBufs& B, LAS unsigned char* lds, int tid, int lane, int wave) {
    const int n = unit & 63, h = (unit >> 6) & 3, b = unit >> 8;
    const size_t row0 = (size_t)b * SEQ + 64 * n;
    LAS bf16* QF = (LAS bf16*)lds; LAS bf16* KF = QF + 64 * GP; LAS bf16* QB = KF + 64 * GP; LAS bf16* KB = QB + 64 * GP;
    LAS float* PS = (LAS float*)(lds + 69632);
    LAS float* LR = (LAS float*)(lds + 73728);
    __syncthreads();
    ((LAS f32x4*)LR)[tid] = ((const f32x4*)(B.GLR + row0 * 32))[tid];
    const int d = tid & 127, cgrp = tid >> 7, col = h * 128 + d;
    float gwf[16], gwb[16];
#pragma unroll
    for (int r = 0; r < 16; ++r) { gwf[r] = B.gwF[r * GKW + col]; gwb[r] = B.gwB[r * GKW + col]; }
    const float gbf = B.gbF[col], gbb = B.gbB[col];
    __syncthreads();
    float laf[16], lab[16];
#pragma unroll
    for (int cc = 0; cc < 16; ++cc) { const int c = cgrp * 16 + cc; float zf = gbf, zb = gbb;
#pragma unroll
        for (int r4 = 0; r4 < 4; ++r4) { const f32x4 a = *(const LAS f32x4*)(LR + c * 32 + 4 * r4), e = *(const LAS f32x4*)(LR + c * 32 + 16 + 4 * r4);
#pragma unroll
            for (int i = 0; i < 4; ++i) { zf += a[i] * gwf[4 * r4 + i]; zb += e[i] * gwb[4 * r4 + i]; } }
        laf[cc] = logsig16(zf); lab[cc] = logsig16(zb); }
#pragma unroll
    for (int cc = 1; cc < 16; ++cc) laf[cc] += laf[cc - 1];
#pragma unroll
    for (int cc = 14; cc >= 0; --cc) lab[cc] += lab[cc + 1];
    PS[cgrp * 128 + d] = laf[15]; PS[(4 + cgrp) * 128 + d] = lab[0];
    __syncthreads();
    float offf = 0.f, offb = 0.f, totf = 0.f, totb = 0.f;
#pragma unroll
    for (int g = 0; g < 4; ++g) { const float pf = PS[g * 128 + d], pb = PS[(4 + g) * 128 + d]; totf += pf; totb += pb; if (g < cgrp) offf += pf; if (g > cgrp) offb += pb; }
    float kef[16], keb[16];
#pragma unroll
    for (int cc = 0; cc < 16; ++cc) { const int c = cgrp * 16 + cc; const size_t row = row0 + c;
        const float Gf = laf[cc] + offf, Gb = lab[cc] + offb;
        const float q = bf2f(B.GQ[row * GKW + col]), k = bf2f(B.GK[row * GKW + col]);
        const float qf = q * __expf(Gf), kf = k * __expf(-Gf), qb = q * __expf(Gb), kb = k * __expf(-Gb);
        kef[cc] = k * __expf(totf - Gf); keb[cc] = k * __expf(totb - Gb);
        const bf16 qfh = (bf16)f2bf(qf), qbh = (bf16)f2bf(qb);
        QF[c * GP + d] = qfh; KF[c * GP + d] = (bf16)f2bf(kf); QB[c * GP + d] = qbh; KB[c * GP + d] = (bf16)f2bf(kb);
        B.QINF[row * GKW + col] = qfh; B.QINB[row * GKW + col] = qbh; }
    { v4u w0, w1; bf16* dst = B.KETF + (size_t)col * T_ + row0 + cgrp * 16;
      w0.x = pk2(kef[0], kef[1]); w0.y = pk2(kef[2], kef[3]); w0.z = pk2(kef[4], kef[5]); w0.w = pk2(kef[6], kef[7]);
      w1.x = pk2(kef[8], kef[9]); w1.y = pk2(kef[10], kef[11]); w1.z = pk2(kef[12], kef[13]); w1.w = pk2(kef[14], kef[15]);
      ((v4u*)dst)[0] = w0; ((v4u*)dst)[1] = w1;
      dst = B.KETB + (size_t)col * T_ + row0 + cgrp * 16;
      w0.x = pk2(keb[0], keb[1]); w0.y = pk2(keb[2], keb[3]); w0.z = pk2(keb[4], keb[5]); w0.w = pk2(keb[6], keb[7]);
      w1.x = pk2(keb[8], keb[9]); w1.y = pk2(keb[10], keb[11]); w1.z = pk2(keb[12], keb[13]); w1.w = pk2(keb[14], keb[15]);
      ((v4u*)dst)[0] = w0; ((v4u*)dst)[1] = w1; }
    if (cgrp == 0) { B.DECF[(size_t)(b * 64 + n) * GKW + col] = __expf(totf); B.DECB[(size_t)(b * 64 + n) * GKW + col] = __expf(totb); }
    __syncthreads();
    const int l31 = lane & 31, hi = lane >> 5;
    bf16x8 vt[2][2];
    { const bf16* vbase = B.GVT + (size_t)(h * 256 + 32 * wave + l31) * T_ + row0 + 4 * hi;
#pragma unroll
      for (int jt = 0; jt < 2; ++jt)
#pragma unroll
          for (int s = 0; s < 2; ++s) { const bf16* p = vbase + 32 * jt + 16 * s; vt[jt][s] = join8(*(const v2u*)p, *(const v2u*)(p + 8)); } }
    f32x16 o0 = {}, o1 = {};
    {
        f32x16 X = gla_xtile(KF, QF, 0, 0, l31, hi);
#pragma unroll
        for (int r = 0; r < 16; ++r) if (crow(r, hi) > l31) X[r] = 0.f;
        o0 = MFMA32(vt[0][0], pack8<0>(X), o0); o0 = MFMA32(vt[0][1], pack8<1>(X), o0);
        X = gla_xtile(KF, QF, 0, 1, l31, hi);
        o1 = MFMA32(vt[0][0], pack8<0>(X), o1); o1 = MFMA32(vt[0][1], pack8<1>(X), o1);
        X = gla_xtile(KF, QF, 1, 1, l31, hi);
#pragma unroll
        for (int r = 0; r < 16; ++r) if (crow(r, hi) > l31) X[r] = 0.f;
        o1 = MFMA32(vt[1][0], pack8<0>(X), o1); o1 = MFMA32(vt[1][1], pack8<1>(X), o1);
    }
    {
        f32x16 X = gla_xtile(KB, QB, 0, 0, l31, hi);
#pragma unroll
        for (int r = 0; r < 16; ++r) if (crow(r, hi) < l31) X[r] = 0.f;
        o0 = MFMA32(vt[0][0], pack8<0>(X), o0); o0 = MFMA32(vt[0][1], pack8<1>(X), o0);
        X = gla_xtile(KB, QB, 1, 0, l31, hi);
        o0 = MFMA32(vt[1][0], pack8<0>(X), o0); o0 = MFMA32(vt[1][1], pack8<1>(X), o0);
        X = gla_xtile(KB, QB, 1, 1, l31, hi);
#pragma unroll
        for (int r = 0; r < 16; ++r) if (crow(r, hi) < l31) X[r] = 0.f;
        o1 = MFMA32(vt[1][0], pack8<0>(X), o1); o1 = MFMA32(vt[1][1], pack8<1>(X), o1);
    }
    { bf16* ob = B.OI + (row0 + l31) * GVW + h * 256 + 32 * wave + 4 * hi;
#pragma unroll
      for (int g = 0; g < 4; ++g) { v2u w; w.x = cvtpk(o0[4 * g], o0[4 * g + 1]); w.y = cvtpk(o0[4 * g + 2], o0[4 * g + 3]); *(v2u*)(ob + 8 * g) = w;
          v2u w1; w1.x = cvtpk(o1[4 * g], o1[4 * g + 1]); w1.y = cvtpk(o1[4 * g + 2], o1[4 * g + 3]); *(v2u*)(ob + (size_t)32 * GVW + 8 * g) = w1; } }
}

constexpr int SC_Q = 0, SC_K = 17408, SC_V = 35840, SC_D = 72704, SC_STAGE = 73216;
__device__ __forceinline__ void gla_scan(int item, const GlaBufs& B, LAS unsigned char* lds, int tid, int lane, int wave) {
    const int dir = item & 1, h = (item >> 1) & 3, b = item >> 3;
    const bf16* QIN = dir ? B.QINB : B.QINF; const bf16* KET = dir ? B.KETB : B.KETF; const float* DEC = dir ? B.DECB : B.DECF;
    const int l31 = lane & 31, hi = lane >> 5;
    v4u rq[2], rk[2], rv[4]; f32x4 rd = {};
    const int qc0 = tid >> 4, qch = tid & 15;
    const int kd0 = tid >> 3, kch = tid & 7;
#define SC_LOAD(nn) do { const size_t r0_ = (size_t)b * SEQ + 64 * (nn); \
        rq[0] = *(const v4u*)(QIN + (r0_ + qc0) * GKW + h * 128 + qch * 8); rq[1] = *(const v4u*)(QIN + (r0_ + qc0 + 32) * GKW + h * 128 + qch * 8); \
        rk[0] = *(const v4u*)(KET + (size_t)(h * 128 + kd0) * T_ + r0_ + kch * 8); rk[1] = *(const v4u*)(KET + (size_t)(h * 128 + kd0 + 64) * T_ + r0_ + kch * 8); \
        _Pragma("unroll") for (int i_ = 0; i_ < 4; ++i_) rv[i_] = *(const v4u*)(B.GVT + (size_t)(h * 256 + kd0 + 64 * i_) * T_ + r0_ + kch * 8); \
        if (tid < 32) rd = *(const f32x4*)(DEC + (size_t)(b * 64 + (nn)) * GKW + h * 128 + tid * 4); } while (0)
#define SC_WRITE(st) do { LAS unsigned char* s_ = lds + (st) * SC_STAGE; \
        *(LAS v4u*)(s_ + SC_Q + qc0 * 272 + qch * 16) = rq[0]; *(LAS v4u*)(s_ + SC_Q + (qc0 + 32) * 272 + qch * 16) = rq[1]; \
        *(LAS v4u*)(s_ + SC_K + kd0 * 144 + kch * 16) = rk[0]; *(LAS v4u*)(s_ + SC_K + (kd0 + 64) * 144 + kch * 16) = rk[1]; \
        _Pragma("unroll") for (int i_ = 0; i_ < 4; ++i_) *(LAS v4u*)(s_ + SC_V + (kd0 + 64 * i_) * 144 + kch * 16) = rv[i_]; \
        if (tid < 32) *(LAS f32x4*)(s_ + SC_D + tid * 16) = rd; } while (0)
    __syncthreads();
    SC_LOAD(dir ? 63 : 0); SC_WRITE(0);
    __syncthreads();
    f32x16 S0 = {}, S1 = {}, S2 = {}, S3 = {};
    int cur = 0;
    for (int step = 0; step < 64; ++step) {
        const int n = dir ? 63 - step : step;
        if (step + 1 < 64) SC_LOAD(dir ? 62 - step : step + 1);
        const LAS unsigned char* st = lds + cur * SC_STAGE;
        f32x16 i0 = {}, i1 = {};
        const LAS unsigned char* qb0 = st + SC_Q + l31 * 272 + 8 * hi; const LAS unsigned char* qb1 = qb0 + 32 * 272;
#define SC_INTER(Sx, dt) do { \
            { const bf16x8 a = pack8<0>(Sx); const bf16x8 b0 = join8(*(const LAS v2u*)(qb0 + (32 * (dt)) * 2), *(const LAS v2u*)(qb0 + (32 * (dt) + 8) * 2)); \
              const bf16x8 b1 = join8(*(const LAS v2u*)(qb1 + (32 * (dt)) * 2), *(const LAS v2u*)(qb1 + (32 * (dt) + 8) * 2)); i0 = MFMA32(a, b0, i0); i1 = MFMA32(a, b1, i1); } \
            { const bf16x8 a = pack8<1>(Sx); const bf16x8 b0 = join8(*(const LAS v2u*)(qb0 + (32 * (dt) + 16) * 2), *(const LAS v2u*)(qb0 + (32 * (dt) + 24) * 2)); \
              const bf16x8 b1 = join8(*(const LAS v2u*)(qb1 + (32 * (dt) + 16) * 2), *(const LAS v2u*)(qb1 + (32 * (dt) + 24) * 2)); i0 = MFMA32(a, b0, i0); i1 = MFMA32(a, b1, i1); } } while (0)
        SC_INTER(S0, 0); SC_INTER(S1, 1); SC_INTER(S2, 2); SC_INTER(S3, 3);
        {
            const size_t e0 = ((size_t)b * SEQ + 64 * n + l31) * GVW + h * 256 + 32 * wave + 4 * hi;
#pragma unroll
            for (int g = 0; g < 4; ++g) {
                bf16* od = dir ? B.OSB : B.OSF;
                { v2u w; w.x = cvtpk(i0[4 * g], i0[4 * g + 1]); w.y = cvtpk(i0[4 * g + 2], i0[4 * g + 3]); *(v2u*)(od + e0 + 8 * g) = w;
                  v2u w1; w1.x = cvtpk(i1[4 * g], i1[4 * g + 1]); w1.y = cvtpk(i1[4 * g + 2], i1[4 * g + 3]); *(v2u*)(od + e0 + (size_t)32 * GVW + 8 * g) = w1; } }
        }
        const LAS unsigned char* kb_ = st + SC_K + l31 * 144 + 16 * hi; const LAS unsigned char* vb_ = st + SC_V + (32 * wave + l31) * 144 + 16 * hi;
        bf16x8 vf[4];
#pragma unroll
        for (int s = 0; s < 4; ++s) vf[s] = *(const LAS bf16x8*)(vb_ + 32 * s);
#define SC_UPD(Sx, dt) do { \
            _Pragma("unroll") for (int g = 0; g < 4; ++g) { const f32x4 dv = *(const LAS f32x4*)(st + SC_D + (32 * (dt) + 8 * g + 4 * hi) * 4); \
                Sx[4 * g] *= dv[0]; Sx[4 * g + 1] *= dv[1]; Sx[4 * g + 2] *= dv[2]; Sx[4 * g + 3] *= dv[3]; } \
            _Pragma("unroll") for (int s = 0; s < 4; ++s) { const bf16x8 a = *(const LAS bf16x8*)(kb_ + (32 * (dt)) * 144 + 32 * s); Sx = MFMA32(a, vf[s], Sx); } } while (0)
        SC_UPD(S0, 0); SC_UPD(S1, 1); SC_UPD(S2, 2); SC_UPD(S3, 3);
        if (step + 1 < 64) SC_WRITE(cur ^ 1);
        __syncthreads();
        cur ^= 1;
    }
#undef SC_LOAD
#undef SC_WRITE
#undef SC_INTER
#undef SC_UPD
}
__global__ void __launch_bounds__(NWAVES * 64, 2) fwd(Args args) {
    extern __shared__ __attribute__((aligned(16))) unsigned char lds_raw[];
    LAS unsigned char* lds = (LAS unsigned char*)lds_raw;
    const int tid = threadIdx.x, lane = tid & 63, wave = __builtin_amdgcn_readfirstlane(tid >> 6);
    const int G = gridDim.x; const int bx = blockIdx.x; const int vcu = (G % 8 == 0) ? (bx % 8) * (G / 8) + bx / 8 : bx;
    const int gw = vcu * NWAVES + wave, NGW = G * NWAVES;
    unsigned char* ws = args.ws;
    const float* x = args.in[0]; float* out = args.out;
    bf16* Wt_in = (bf16*)(ws + WS_WIN); bf16* Wt_out = (bf16*)(ws + WS_WOUT); bf16* Wt_gu = (bf16*)(ws + WS_WGU); bf16* Wt_dn = (bf16*)(ws + WS_WDN);
    bf16* XN = (bf16*)(ws + WS_XN); bf16* RB = (bf16*)(ws + WS_RB);
    float* BIAS2 = (float*)(ws + WS_BIAS2); float* SSQ1 = (float*)(ws + WS_SSQ1);
    float* GLR = (float*)(RB + E_GLR);
    GlaBufs GB;
    GB.GQ = RB + E_GQ; GB.GK = RB + E_GK; GB.GVT = RB + E_GVT; GB.GLR = GLR;
    GB.OI = (bf16*)(ws + WS_XN); GB.QINF = GB.OI + (size_t)T_ * 1024; GB.QINB = GB.QINF + (size_t)T_ * 512;
    GB.KETF = (bf16*)(ws + WS_WIN); GB.KETB = GB.KETF + (size_t)T_ * 512;
    GB.DECF = (float*)(ws + WS_WIN + 16 * MiB); GB.DECB = GB.DECF + 128 * 512;
    GB.OSF = RB + E_GQ; GB.OSB = (bf16*)out + (size_t)T_ * 1024;
    GB.gwF = args.in[4]; GB.gbF = args.in[5]; GB.gwB = args.in[6]; GB.gbB = args.in[7];
    bf16* Y = RB;
    bf16* X1B = (bf16*)(ws + WS_XN);
    bf16* HB = RB;
    bf16* ATT = (bf16*)out;
    const int lo = args.ph_lo, hi = args.ph_hi;
#define IN(k) (lo <= (k) && (k) < hi)
#define SEAM(k) do { if (IN(k) && IN((k) + 1)) { cg::this_grid().sync(); } } while (0)

    if (IN(0)) {
        LAS float* scr = (LAS float*)(lds + wave * 16384);
        constexpr int I_IN = 32 * 193, I_OUT = 32 * 64, I_G = 32 * 176, I_D = 88 * 64, NITEMS = I_IN + I_OUT + 2 * I_G + I_D;
        for (int it = gw; it < NITEMS; it += NGW) {
            int r = it;
            if (r < I_IN) { const int kb = r / 193, nb = r % 193, n0 = nb * 32;
                int drow; float sc = 1.f;
                if (n0 < 1024) { drow = n0; sc = 0.125f * LOG2E; }
                else if (n0 < 3072) drow = n0;
                else if (n0 < 3584) { drow = n0; sc = 0.08838834764831845f; }
                else if (n0 < 4096) drow = n0;
                else if (n0 < 5120) drow = n0 + 1024;
                else if (n0 < 6144) drow = n0 - 1024;
                else drow = n0;
                p0_item(args.in[2], DM, INW, Wt_in, kb * 64, n0, drow, nullptr, sc, scr, lane); continue; }
            r -= I_IN;
            if (r < I_OUT) { const int kb = r / 64, nb = r % 64; p0_item(args.in[9], DM, DM, Wt_out, kb * 64, nb * 32, nb * 32, nullptr, 1.f, scr, lane); continue; }
            r -= I_OUT;
            if (r < I_G) { const int kb = r / 176, nb = r % 176, n0 = nb * 32; p0_item(args.in[11], DM, FF, Wt_gu, kb * 64, n0, (n0 >> 7) * 256 + (n0 & 127), args.in[10], 1.f, scr, lane); continue; }
            r -= I_G;
            if (r < I_G) { const int kb = r / 176, nb = r % 176, n0 = nb * 32; p0_item(args.in[12], DM, FF, Wt_gu, kb * 64, n0, (n0 >> 7) * 256 + 128 + (n0 & 127), args.in[10], 1.f, scr, lane); continue; }
            r -= I_G;
            { const int kb = r / 64, nb = r % 64; p0_item(args.in[13], FF, DM, Wt_dn, kb * 64, nb * 32, nb * 32, nullptr, 1.f, scr, lane); }
        }
        const float* nw = args.in[1];
        for (int m = gw; m < T_; m += NGW) {
            const f32x4* xr = (const f32x4*)(x + (size_t)m * DM) + lane; f32x4 v[8]; float s = 0.f;
#pragma unroll
            for (int j = 0; j < 8; ++j) { v[j] = xr[64 * j]; s += (v[j][0] * v[j][0] + v[j][1] * v[j][1]) + (v[j][2] * v[j][2] + v[j][3] * v[j][3]); }
            const float rstd = rsqrtf(wave_sum(s) * (1.f / DM) + NORM_EPS);
            v2u* o8 = (v2u*)(XN + (size_t)m * DM) + lane;
#pragma unroll
            for (int j = 0; j < 8; ++j) { const f32x4 w = ((const f32x4*)nw)[lane + 64 * j]; v2u o; o.x = pk2(v[j][0] * rstd * w[0], v[j][1] * rstd * w[1]); o.y = pk2(v[j][2] * rstd * w[2], v[j][3] * rstd * w[3]); o8[64 * j] = o; }
        }
        if (bx == 0) {
            const float* tbl = args.in[3];
            for (int idx = tid; idx < 3 * 129; idx += NWAVES * 64) { const int p = idx / 129, s = idx % 129; const int r = (p == 0) ? 1 : (p == 1 ? 4 : 16);
                const int bk = t5_bucket((s - 64) * r);
                for (int h = 0; h < 16; ++h) BIAS2[idx * 16 + h] = tbl[bk * 16 + h] * LOG2E; }
        }
    }
    SEAM(0);

    if (IN(1)) {
        { pg8::Gemm g{XN, Wt_in, T_, 5120, DM}; pg8::StaticOrder S; S.init(T_, 5120, G, bx); pg8::EpiProj E{RB};
          pg8::gemm_phase<pg8::EpiProj, pg8::StaticOrder, true, true>(lds, g, S, E); }
        { pg8::Gemm g{Wt_in + (size_t)5120 * DM, XN, 1024, T_, DM}; pg8::StaticOrder S; S.init(1024, T_, G, (bx + G / 2) % G); pg8::EpiPlain E{RB + E_GVT, T_};
          pg8::gemm_phase<pg8::EpiPlain, pg8::StaticOrder, true, true>(lds, g, S, E); }
        for (int o = vcu * 512 + tid; o < T_ * 32; o += G * 512) { const int t = o >> 5, j = o & 31;
            const v4u* a = (const v4u*)(XN + (size_t)t * DM); const v4u* b = (const v4u*)(Wt_in + (size_t)(6144 + j) * DM); float s = 0.f;
            for (int k = 0; k < DM / 8; ++k) { const v4u av = a[k], bv = b[k];
                s += bflo(av.x) * bflo(bv.x) + bfhi(av.x) * bfhi(bv.x) + bflo(av.y) * bflo(bv.y) + bfhi(av.y) * bfhi(bv.y)
                   + bflo(av.z) * bflo(bv.z) + bfhi(av.z) * bfhi(bv.z) + bflo(av.w) * bflo(bv.w) + bfhi(av.w) * bfhi(bv.w); }
            GLR[o] = s; }
    }
    SEAM(1);

    if (IN(2)) {
        const bf16* AQ = RB + E_AQ; const bf16* AK = RB + E_AK; const bf16* AV = RB + E_AV;
        for (int u = bx; u < NB * GH * 64; u += G) gla_unit(u, GB, lds, tid, lane, wave);
        {
            const int nw0 = gw; const int nws = NGW;
            for (int item = nw0; item < NB * AH * SEQ; item += nws) {
                const int q = item & (SEQ - 1), h = (item >> 12) & 15, b = item >> 16;
                const size_t rowq = (size_t)b * SEQ + q;
                float qv[64];
                { const v4u* qp = (const v4u*)(AQ + rowq * AW + h * AD);
#pragma unroll
                  for (int i = 0; i < 8; ++i) { const v4u w = qp[i]; qv[8 * i + 0] = bflo(w.x); qv[8 * i + 1] = bfhi(w.x); qv[8 * i + 2] = bflo(w.y); qv[8 * i + 3] = bfhi(w.y); qv[8 * i + 4] = bflo(w.z); qv[8 * i + 5] = bfhi(w.z); qv[8 * i + 6] = bflo(w.w); qv[8 * i + 7] = bfhi(w.w); } }
                float op[3], lse[3];
#pragma unroll
                for (int p = 0; p < 3; ++p) { const int r = (p == 0) ? 1 : (p == 1 ? 4 : 16);
                    float lg[3];
#pragma unroll
                    for (int i = 0; i < 3; ++i) { const int s = lane + 64 * i; const int kp = q + (s - 64) * r; const bool valid = (s < 129) && (kp >= 0) && (kp < SEQ);
                        float dot = -INFINITY;
                        if (valid) { const v4u* kr = (const v4u*)(AK + ((size_t)b * SEQ + kp) * AW + h * AD); float a = 0.f;
#pragma unroll
                            for (int j = 0; j < 8; ++j) { const v4u w = kr[j]; a += qv[8 * j + 0] * bflo(w.x) + qv[8 * j + 1] * bfhi(w.x) + qv[8 * j + 2] * bflo(w.y) + qv[8 * j + 3] * bfhi(w.y) + qv[8 * j + 4] * bflo(w.z) + qv[8 * j + 5] * bfhi(w.z) + qv[8 * j + 6] * bflo(w.w) + qv[8 * j + 7] * bfhi(w.w); }
                            dot = a + BIAS2[(p * 129 + s) * 16 + h]; }
                        lg[i] = dot; }
                    const float m = wave_max(fmaxf(fmaxf(lg[0], lg[1]), lg[2]));
                    float pr[3];
#pragma unroll
                    for (int i = 0; i < 3; ++i) pr[i] = exp2f(lg[i] - m);
                    const float ssum = wave_sum(pr[0] + pr[1] + pr[2]);
                    float o = 0.f;
                    for (int s = 0; s < 129; ++s) { const int kp = q + (s - 64) * r; if (kp < 0 || kp >= SEQ) continue;
                        const float pk = __shfl(s < 64 ? pr[0] : (s < 128 ? pr[1] : pr[2]), s & 63);
                        o += pk * bf2f(AV[((size_t)b * SEQ + kp) * AW + h * AD + lane]); }
                    op[p] = o / ssum; lse[p] = m + log2f(ssum); }
                const float M = fmaxf(fmaxf(lse[0], lse[1]), lse[2]);
                const float w0 = exp2f(lse[0] - M), w1 = exp2f(lse[1] - M), w2 = exp2f(lse[2] - M);
                const float res = (w0 * op[0] + w1 * op[1] + w2 * op[2]) / (w0 + w1 + w2);
                ATT[rowq * AW + h * AD + lane] = (bf16)f2bf(res);
            }
        }
    }
    SEAM(2);

    if (IN(3)) {
        for (int it = bx; it < 16; it += G) gla_scan(it, GB, lds, tid, lane, wave);
    }
    SEAM(3);

    if (IN(4)) {
        const bf16* GR = RB + E_GR; const float* gnw = args.in[8];
        for (int item = gw; item < T_ * 8; item += NGW) { const int row = item >> 3, part = item & 7;
            if (part < 4) {
                const v2u v = ((const v2u*)(ATT + (size_t)row * AW + part * 256))[lane];
                ((v2u*)(Y + (size_t)row * DM + part * 256))[lane] = v;
            } else { const int h = part - 4; const size_t o = (size_t)row * GVW + h * 256;
                const v2u a = ((const v2u*)(GB.OI + o))[lane], c = ((const v2u*)(GB.OSF + o))[lane], e = ((const v2u*)(GB.OSB + o))[lane], g = ((const v2u*)(GR + o))[lane];
                float v[4] = {bflo(a.x) + bflo(c.x) + bflo(e.x), bfhi(a.x) + bfhi(c.x) + bfhi(e.x), bflo(a.y) + bflo(c.y) + bflo(e.y), bfhi(a.y) + bfhi(c.y) + bfhi(e.y)};
                const float gr[4] = {bflo(g.x), bfhi(g.x), bflo(g.y), bfhi(g.y)};
                const float ss = wave_sum((v[0] * v[0] + v[1] * v[1]) + (v[2] * v[2] + v[3] * v[3]));
                const float rstd = rsqrtf(ss * (1.0f / 256.0f) + NORM_EPS);
                const f32x4 w = ((const f32x4*)(gnw + h * 256))[lane];
                float y[4];
#pragma unroll
                for (int i = 0; i < 4; ++i) y[i] = v[i] * rstd * w[i] * (gr[i] / (1.0f + __expf(-gr[i])));
                v2u ov; ov.x = pk2(y[0], y[1]); ov.y = pk2(y[2], y[3]);
                ((v2u*)(Y + (size_t)row * DM + 1024 + h * 256))[lane] = ov; }
        }
    }
    SEAM(4);

    if (IN(5)) {
        pg8::Gemm g{Y, Wt_out, T_, DM, DM}; pg8::StaticOrder S; S.init(T_, DM, G, bx); pg8::EpiRes<true> E{x, out, X1B, SSQ1};
        pg8::gemm_phase<pg8::EpiRes<true>, pg8::StaticOrder, false, true>(lds, g, S, E);
    }
    SEAM(5);

    if (IN(6)) {
        pg8::Gemm g{X1B, Wt_gu, T_, 2 * FF, DM}; pg8::StaticOrder S; S.init(T_, 2 * FF, G, bx); pg8::EpiSwiglu E{HB, SSQ1};
        pg8::gemm_phase<pg8::EpiSwiglu, pg8::StaticOrder, true, true>(lds, g, S, E);
    }
    SEAM(6);

    if (IN(7)) {
        pg8::Gemm g{HB, Wt_dn, T_, DM, FF}; pg8::StaticOrder S; S.init(T_, DM, G, bx); pg8::EpiRes<false> E{out, out, nullptr, nullptr};
        pg8::gemm_phase<pg8::EpiRes<false>, pg8::StaticOrder, false, true>(lds, g, S, E);
    }
    SEAM(7);

    if (IN(8)) {
        const float* fw = args.in[14];
        for (int m = gw; m < T_; m += NGW) {
            f32x4* xr = (f32x4*)(out + (size_t)m * DM) + lane; f32x4 v[8]; float s = 0.f;
#pragma unroll
            for (int j = 0; j < 8; ++j) { v[j] = xr[64 * j]; s += (v[j][0] * v[j][0] + v[j][1] * v[j][1]) + (v[j][2] * v[j][2] + v[j][3] * v[j][3]); }
            const float rstd = rsqrtf(wave_sum(s) * (1.f / DM) + NORM_EPS);
#pragma unroll
            for (int j = 0; j < 8; ++j) { const f32x4 w = ((const f32x4*)fw)[lane + 64 * j]; xr[64 * j] = v[j] * rstd * w; }
        }
    }
#undef IN
#undef SEAM
}

extern "C" void kernel_launch(void* const* d_in, const int* in_sizes, int n_in, void* d_out, int out_size, void* d_ws, size_t ws_size, hipStream_t stream) {
    static int grid = 0;
    if (grid == 0) {
        if (n_in != 15 || out_size != T_ * DM || ws_size < WS_END) { fprintf(stderr, "kernel_launch: unexpected shapes (n_in %d out %d ws %zu)\n", n_in, out_size, ws_size); grid = -1; return; }
        int dev = 0, cus = 0, per_cu = 0;
        if (hipGetDevice(&dev) != hipSuccess || hipDeviceGetAttribute(&cus, hipDeviceAttributeMultiprocessorCount, dev) != hipSuccess) { grid = -1; return; }
        if (hipFuncSetAttribute((const void*)fwd, hipFuncAttributeMaxDynamicSharedMemorySize, LDS_BYTES) != hipSuccess) { fprintf(stderr, "kernel_launch: hipFuncSetAttribute failed\n"); grid = -1; return; }
        if (hipOccupancyMaxActiveBlocksPerMultiprocessor(&per_cu, (const void*)fwd, NWAVES * 64, LDS_BYTES) != hipSuccess || per_cu < 1) { fprintf(stderr, "kernel_launch: occupancy query reports %d\n", per_cu); per_cu = 1; }
        (void)hipGetLastError();
        grid = cus;
    }
    if (grid < 0) return;
    Args a{};
    for (int i = 0; i < 15; ++i) a.in[i] = (const float*)d_in[i];
    a.out = (float*)d_out; a.ws = (unsigned char*)d_ws;
#if MK_LAUNCHES == 1
    a.ph_lo = 0; a.ph_hi = NPHASE;
    void* kargs[] = {&a};
    hipError_t e = hipLaunchCooperativeKernel((const void*)fwd, dim3(grid), dim3(NWAVES * 64), kargs, LDS_BYTES, stream);
    if (e != hipSuccess) fprintf(stderr, "kernel_launch: cooperative launch failed: %s (grid %d)\n", hipGetErrorString(e), grid);
#else
    for (int p = 0; p < NPHASE; ++p) { a.ph_lo = p; a.ph_hi = p + 1; hipLaunchKernelGGL(fwd, dim3(grid), dim3(NWAVES * 64), LDS_BYTES, stream, a); }
#endif
}
```

```cpp
#include <hip/hip_runtime.h>
#include <hip/hip_cooperative_groups.h>
#include <cstdio>
#include <cstdint>
namespace cg = cooperative_groups;

namespace pg8 {
#define PG8_LAS __attribute__((address_space(3)))
typedef unsigned short bf16_t;
typedef short bf16x8 __attribute__((ext_vector_type(8)));
typedef float f32x4 __attribute__((ext_vector_type(4)));
typedef unsigned u32x4 __attribute__((ext_vector_type(4)));
constexpr int BM = 256, BK = 64, HALF = 128, HTB = HALF * BK * 2  , STAGE_BYTES = 8 * HTB, NXCD = 8, WGM = 8;

__host__ __device__ __forceinline__ int lds_byte(int r, int c) { const int st = (r >> 4) * 2 + (c >> 5), rr = r & 15, cc = c & 31, ob = rr * 64 + cc * 2; return st * 1024 + (ob ^ (((ob >> 9) & 1) << 5)); }
__host__ __device__ __forceinline__ void stage_rc(int b, int& R, int& C) { const int st = b / 1024, sb = b % 1024, swz = sb ^ (((sb >> 9) & 1) << 5); R = (st >> 1) * 16 + swz / 64; C = (st & 1) * 32 + (swz % 64) / 2; }
__host__ __device__ __forceinline__ int perm32(int rho) { const int n = rho >> 4, i = rho & 15; return 8 * (i >> 2) + 4 * n + (i & 3); }

struct Unit { int pm, pn; };
struct Gemm { const bf16_t* A; const bf16_t* Bt; int M, N, K; };

struct StaticOrder {
    int nM, nN, nwg, G, c;
    __host__ __device__ void init(int M, int N, int G_, int c_) { nM = M / BM; nN = N / BM; nwg = nM * nN; G = G_; c = c_; }
    __host__ __device__ bool next(int i, Unit& u) const {
        const long L = (long)i * G + c; if (L >= nwg) return false;
        int wgid = (int)L; { const int q = nwg / NXCD, r = nwg % NXCD, xcd = wgid % NXCD, off = wgid / NXCD; wgid = (xcd < r ? xcd * (q + 1) : r * (q + 1) + (xcd - r) * q) + off; }
        const int nig = WGM * nN, gid = wgid / nig, fm = gid * WGM, gsz = (nM - fm) < WGM ? (nM - fm) : WGM;
        u.pm = fm + ((wgid % nig) % gsz); u.pn = (wgid % nig) / gsz; return true;
    }
    __device__ __forceinline__ void a_ready(const Unit&) const {}
    __device__ __forceinline__ void done(const Unit&) const {}
};

__device__ __forceinline__ unsigned cvt_pk_bf16(float lo, float hi) { unsigned r; asm volatile("v_cvt_pk_bf16_f32 %0, %1, %2" : "=v"(r) : "v"(lo), "v"(hi)); return r; }
template <class Epi, class Sched, bool ALIGN_EPI = false, bool SP2 = false>
__device__ __forceinline__ void gemm_phase(PG8_LAS unsigned char* lds, const Gemm g, const Sched& S, const Epi& E) {
    const int tid = threadIdx.x, wid = __builtin_amdgcn_readfirstlane(tid >> 6), lane = tid & 63, wr = wid >> 2, wc = wid & 3, fr = lane & 15, fq = lane >> 4;
    const int K = g.K, nt = K / BK;
    unsigned voffA[2], voffB[2];
#pragma unroll
    for (int i = 0; i < 2; ++i) { int R, C; stage_rc(tid * 16 + i * 8192, R, C); const int Rb = Epi::PERM ? ((R & ~31) + perm32(R & 31)) : R;
        voffA[i] = (unsigned)(R * K + C) * 2u; voffB[i] = (unsigned)(Rb * K + C) * 2u; }
    const size_t kstep = (size_t)(BK * 2);
    const size_t hstep = (size_t)HALF * K * 2;
    const size_t tstep = 2 * hstep;
    const unsigned ldsw = (unsigned)wid * 1024u;
    const int aoff = lds_byte(wr * 64 + fr, fq * 8), boff = lds_byte(wc * 32 + fr, fq * 8);
#define PG8_SA(b, h) (((b) * 2 + (h)) * HTB)
#define PG8_SB(b, h) ((4 + (b) * 2 + (h)) * HTB)
#define PG8_STAGE(bufoff, gbase, voff) do { _Pragma("unroll") for (int _i = 0; _i < 2; ++_i) \
        __builtin_amdgcn_global_load_lds((const unsigned*)((const char*)(gbase) + (voff)[_i]), (PG8_LAS unsigned*)(lds + (bufoff) + ldsw + _i * 8192), 16, 0, 0); } while (0)
#define PG8_LDA(dst, b, h) do { _Pragma("unroll") for (int m = 0; m < 4; ++m) _Pragma("unroll") for (int k = 0; k < 2; ++k) dst[m][k] = *(const PG8_LAS bf16x8*)(lds + PG8_SA(b, h) + aoff + m * 2048 + k * 1024); } while (0)
#define PG8_LDB(dst, b, h) do { _Pragma("unroll") for (int n = 0; n < 2; ++n) _Pragma("unroll") for (int k = 0; k < 2; ++k) dst[n][k] = *(const PG8_LAS bf16x8*)(lds + PG8_SB(b, h) + boff + n * 2048 + k * 1024); } while (0)
#define PG8_MMA(ai, bj, At, Bt) do { __builtin_amdgcn_s_setprio(1); _Pragma("unroll") for (int m = 0; m < 4; ++m) _Pragma("unroll") for (int n = 0; n < 2; ++n) _Pragma("unroll") for (int k = 0; k < 2; ++k) \
        acc[ai][bj][m][n] = __builtin_amdgcn_mfma_f32_16x16x32_bf16(Bt[n][k], At[m][k], acc[ai][bj][m][n], 0, 0, 0); __builtin_amdgcn_s_setprio(0); } while (0)
#define PG8_WAIT_V(n) asm volatile("s_waitcnt vmcnt(" #n ")" ::: "memory")
#define PG8_WAIT_L(n) asm volatile("s_waitcnt lgkmcnt(" #n ")" ::: "memory")
#define PG8_BAR __builtin_amdgcn_s_barrier()
#define PG8_SCHED __builtin_amdgcn_sched_barrier(0)
    Unit cur, nxt; int ui = 0;
    if (!S.next(0, cur)) return;
    f32x4 acc[2][2][4][2];
#pragma unroll
    for (int a = 0; a < 2; ++a)
#pragma unroll
        for (int b = 0; b < 2; ++b)
#pragma unroll
            for (int m = 0; m < 4; ++m)
#pragma unroll
                for (int n = 0; n < 2; ++n) acc[a][b][m][n] = (f32x4){0.f, 0.f, 0.f, 0.f};
    bf16x8 At[4][2], B0[2][2], B1[2][2];
    const char* cA = (const char*)g.A + (size_t)cur.pm * tstep; const char* cB = (const char*)g.Bt + (size_t)cur.pn * tstep;
    S.a_ready(cur);
    if constexpr (SP2) {
        PG8_STAGE(PG8_SB(0, 0), cB, voffB); PG8_STAGE(PG8_SB(0, 1), cB + hstep, voffB); PG8_STAGE(PG8_SA(0, 0), cA, voffA); PG8_STAGE(PG8_SA(0, 1), cA + hstep, voffA);
        if (wr == 1) PG8_BAR;
        PG8_WAIT_V(2); PG8_BAR;
        PG8_STAGE(PG8_SB(1, 0), cB + kstep, voffB); PG8_STAGE(PG8_SA(1, 0), cA + kstep, voffA); PG8_STAGE(PG8_SB(1, 1), cB + hstep + kstep, voffB);
        PG8_WAIT_V(6); PG8_BAR;
    } else {
        PG8_STAGE(PG8_SB(0, 0), cB, voffB); PG8_STAGE(PG8_SA(0, 0), cA, voffA); PG8_STAGE(PG8_SB(0, 1), cB + hstep, voffB); PG8_STAGE(PG8_SA(0, 1), cA + hstep, voffA);
        if (wr == 1) PG8_BAR;
        PG8_WAIT_V(4); PG8_BAR;
        PG8_STAGE(PG8_SB(1, 0), cB + kstep, voffB); PG8_STAGE(PG8_SA(1, 0), cA + kstep, voffA); PG8_STAGE(PG8_SB(1, 1), cB + hstep + kstep, voffB);
        PG8_WAIT_V(6); PG8_BAR;
    }
    for (;;) {
        const bool has_next = S.next(ui + 1, nxt);
        const char* nA = has_next ? (const char*)g.A + (size_t)nxt.pm * tstep : cA; const char* nB = has_next ? (const char*)g.Bt + (size_t)nxt.pn * tstep : cB;
        for (int t = 0; t < nt; t += 2) {
            const bool last = (t == nt - 2);
            const char* a1 = cA + (size_t)(t + 1) * kstep;
            const char* a2 = last ? nA : cA + (size_t)(t + 2) * kstep; const char* b2 = last ? nB : cB + (size_t)(t + 2) * kstep;
            const char* a3 = a2 + kstep; const char* b3 = b2 + kstep;
            if (last && has_next) S.a_ready(nxt);
            if constexpr (SP2) {
            PG8_LDB(B0, 0, 0); PG8_LDB(B1, 0, 1); PG8_SCHED; PG8_LDA(At, 0, 0); PG8_STAGE(PG8_SA(1, 1), a1 + hstep, voffA);
            PG8_WAIT_V(8); PG8_WAIT_L(0); PG8_BAR; PG8_MMA(0, 0, At, B0); PG8_MMA(0, 1, At, B1); PG8_BAR; PG8_SCHED;
            PG8_LDA(At, 0, 1); PG8_STAGE(PG8_SB(0, 0), b2, voffB); PG8_STAGE(PG8_SB(0, 1), b2 + hstep, voffB); PG8_STAGE(PG8_SA(0, 0), a2, voffA);
            PG8_WAIT_V(8); PG8_WAIT_L(0); PG8_BAR; PG8_MMA(1, 0, At, B0); PG8_MMA(1, 1, At, B1); PG8_BAR; PG8_SCHED;
            PG8_LDB(B0, 1, 0); PG8_LDB(B1, 1, 1); PG8_SCHED; PG8_LDA(At, 1, 0); PG8_STAGE(PG8_SA(0, 1), a2 + hstep, voffA);
            PG8_WAIT_V(8); PG8_WAIT_L(0); PG8_BAR; PG8_MMA(0, 0, At, B0); PG8_MMA(0, 1, At, B1); PG8_BAR; PG8_SCHED;
            PG8_LDA(At, 1, 1); PG8_STAGE(PG8_SB(1, 0), b3, voffB); PG8_STAGE(PG8_SB(1, 1), b3 + hstep, voffB); PG8_STAGE(PG8_SA(1, 0), a3, voffA);
            PG8_WAIT_V(8); PG8_WAIT_L(0); PG8_BAR; PG8_MMA(1, 0, At, B0); PG8_MMA(1, 1, At, B1); PG8_BAR; PG8_SCHED;
            } else {
            PG8_LDB(B0, 0, 0); PG8_SCHED; PG8_LDA(At, 0, 0); PG8_STAGE(PG8_SA(1, 1), a1 + hstep, voffA);
            PG8_WAIT_L(8); PG8_BAR; PG8_WAIT_L(0); PG8_MMA(0, 0, At, B0); PG8_BAR; PG8_SCHED;
            PG8_LDB(B1, 0, 1); PG8_STAGE(PG8_SB(0, 0), b2, voffB);
            PG8_BAR; PG8_WAIT_L(0); PG8_MMA(0, 1, At, B1); PG8_BAR;
            PG8_LDA(At, 0, 1); PG8_STAGE(PG8_SA(0, 0), a2, voffA);
            PG8_BAR; PG8_WAIT_L(0); PG8_MMA(1, 0, At, B0); PG8_BAR; PG8_SCHED;
            PG8_STAGE(PG8_SB(0, 1), b2 + hstep, voffB);
            PG8_WAIT_V(6); PG8_BAR; PG8_MMA(1, 1, At, B1); PG8_BAR;
            PG8_LDB(B0, 1, 0); PG8_SCHED; PG8_LDA(At, 1, 0); PG8_STAGE(PG8_SA(0, 1), a2 + hstep, voffA);
            PG8_WAIT_L(8); PG8_BAR; PG8_WAIT_L(0); PG8_MMA(0, 0, At, B0); PG8_BAR; PG8_SCHED;
            PG8_LDB(B1, 1, 1); PG8_STAGE(PG8_SB(1, 0), b3, voffB);
            PG8_BAR; PG8_WAIT_L(0); PG8_MMA(0, 1, At, B1); PG8_BAR;
            PG8_LDA(At, 1, 1); PG8_STAGE(PG8_SA(1, 0), a3, voffA);
            PG8_BAR; PG8_WAIT_L(0); PG8_MMA(1, 0, At, B0); PG8_BAR; PG8_SCHED;
            PG8_STAGE(PG8_SB(1, 1), b3 + hstep, voffB);
            PG8_WAIT_V(6); PG8_BAR; PG8_MMA(1, 1, At, B1); PG8_BAR;
            }
        }
        if constexpr (ALIGN_EPI) { if (wr == 0) PG8_BAR; }
        if constexpr (!Epi::AFTER_DRAIN) { E(acc, cur, wr, wc, fr, fq); S.done(cur); }
        if (!has_next) break;
#pragma unroll
        for (int a = 0; a < 2; ++a)
#pragma unroll
            for (int b = 0; b < 2; ++b)
#pragma unroll
                for (int m = 0; m < 4; ++m)
#pragma unroll
                    for (int n = 0; n < 2; ++n) acc[a][b][m][n] = (f32x4){0.f, 0.f, 0.f, 0.f};
        cur = nxt; cA = nA; cB = nB; ++ui;
        if constexpr (ALIGN_EPI) { if (wr == 1) PG8_BAR; }
    }
    PG8_WAIT_V(0);
    if constexpr (!ALIGN_EPI) { if (wr == 0) PG8_BAR; }
    PG8_BAR;
    if constexpr (Epi::AFTER_DRAIN) { E.fused(acc, cur, wr, wc, fr, fq, lds, wid, lane); S.done(cur); }
#undef PG8_SA
#undef PG8_SB
#undef PG8_STAGE
#undef PG8_LDA
#undef PG8_LDB
#undef PG8_MMA
#undef PG8_WAIT_V
#undef PG8_WAIT_L
#undef PG8_BAR
#undef PG8_SCHED
}
}

constexpr int SEQ = 4096, NB = 2, T_ = NB * SEQ, DM = 2048, INW = 6176, FF = 5632;
constexpr int AH = 16, AD = 64, AW = 1024;
constexpr int GH = 4, GDK = 128, GDV = 256, GKW = 512, GVW = 1024, GRANK = 16;
constexpr float NORM_EPS = 1e-6f;
constexpr float LOG2E = 1.4426950408889634f;
constexpr int NWAVES = 8;
constexpr int NPHASE = 9;
#ifndef MK_LAUNCHES
#define MK_LAUNCHES 1
#endif

constexpr size_t MiB = 1u << 20;
constexpr size_t WS_CTL = 0;
constexpr size_t WS_BIAS2 = 64 * 1024;
constexpr size_t WS_SSQ1 = 128 * 1024;
constexpr size_t WS_WIN = 1 * MiB;
constexpr size_t WS_WOUT = 26 * MiB;
constexpr size_t WS_WGU = 34 * MiB;
constexpr size_t WS_WDN = 78 * MiB;
constexpr size_t WS_XN = 100 * MiB;
constexpr size_t WS_RB = 132 * MiB;
constexpr size_t WS_END = 229 * MiB;
constexpr size_t E_AQ = 0, E_AK = (size_t)T_ * 1024, E_AV = 2 * (size_t)T_ * 1024, E_GQ = 3 * (size_t)T_ * 1024, E_GK = E_GQ + (size_t)T_ * 512,
                 E_GVT = 4 * (size_t)T_ * 1024, E_GR = 5 * (size_t)T_ * 1024, E_GLR = 6 * (size_t)T_ * 1024;

#define GAS __attribute__((address_space(1)))
#define LAS __attribute__((address_space(3)))
typedef unsigned short bf16;
typedef unsigned v4u __attribute__((ext_vector_type(4)));
typedef unsigned v2u __attribute__((ext_vector_type(2)));
typedef float f32x4 __attribute__((ext_vector_type(4)));
#define LDS_WAIT() asm volatile("s_waitcnt lgkmcnt(0)" ::: "memory")
__device__ __forceinline__ unsigned f2bf(float f) { unsigned u = __builtin_bit_cast(unsigned, f); return (u + 0x7fffu + ((u >> 16) & 1u)) >> 16; }
__device__ __forceinline__ unsigned pk2(float lo, float hi) { return f2bf(lo) | (f2bf(hi) << 16); }
__device__ __forceinline__ float bf2f(unsigned b) { return __builtin_bit_cast(float, b << 16); }
__device__ __forceinline__ float bflo(unsigned w) { return __builtin_bit_cast(float, w << 16); }
__device__ __forceinline__ float bfhi(unsigned w) { return __builtin_bit_cast(float, w & 0xffff0000u); }
__device__ __forceinline__ float wave_sum(float v) {
#pragma unroll
    for (int o = 1; o < 64; o <<= 1) v += __shfl_xor(v, o);
    return v;
}
__device__ __forceinline__ float wave_max(float v) {
#pragma unroll
    for (int o = 1; o < 64; o <<= 1) v = fmaxf(v, __shfl_xor(v, o));
    return v;
}

namespace pg8 {
struct EpiProj {
    static constexpr bool PERM = true, AFTER_DRAIN = false;
    bf16_t* rb;
    __device__ __forceinline__ void operator()(const f32x4 (&acc)[2][2][4][2], const Unit& u, int wr, int wc, int fr, int fq) const {
        const int pn = u.pn; bf16_t* base; int ldc, colt;
        if (pn < 12) { base = rb + (size_t)(pn >> 2) * ((size_t)T_ * 1024); ldc = 1024; colt = (pn & 3) * 256; }
        else if (pn < 16) { base = rb + E_GQ + (size_t)((pn - 12) >> 1) * ((size_t)T_ * 512); ldc = 512; colt = ((pn - 12) & 1) * 256; }
        else { base = rb + E_GR; ldc = 1024; colt = (pn - 16) * 256; }
        const int row0 = u.pm * BM + wr * 64 + fr, col0 = colt + wc * 32 + 8 * fq;
#pragma unroll
        for (int ai = 0; ai < 2; ++ai)
#pragma unroll
            for (int m = 0; m < 4; ++m) { bf16_t* rowp = base + (size_t)(row0 + ai * HALF + m * 16) * ldc + col0;
#pragma unroll
                for (int bj = 0; bj < 2; ++bj) { const f32x4 v0 = acc[ai][bj][m][0], v1 = acc[ai][bj][m][1];
                    u32x4 w; w.x = cvt_pk_bf16(v0[0], v0[1]); w.y = cvt_pk_bf16(v0[2], v0[3]); w.z = cvt_pk_bf16(v1[0], v1[1]); w.w = cvt_pk_bf16(v1[2], v1[3]);
                    *(u32x4*)(rowp + bj * HALF) = w; } }
    }
};
struct EpiPlain {
    static constexpr bool PERM = true, AFTER_DRAIN = false;
    bf16_t* O; int ldc;
    __device__ __forceinline__ void operator()(const f32x4 (&acc)[2][2][4][2], const Unit& u, int wr, int wc, int fr, int fq) const {
        const int row0 = u.pm * BM + wr * 64 + fr, col0 = u.pn * BM + wc * 32 + 8 * fq;
#pragma unroll
        for (int ai = 0; ai < 2; ++ai)
#pragma unroll
            for (int m = 0; m < 4; ++m) { bf16_t* rowp = O + (size_t)(row0 + ai * HALF + m * 16) * ldc + col0;
#pragma unroll
                for (int bj = 0; bj < 2; ++bj) { const f32x4 v0 = acc[ai][bj][m][0], v1 = acc[ai][bj][m][1];
                    u32x4 w; w.x = cvt_pk_bf16(v0[0], v0[1]); w.y = cvt_pk_bf16(v0[2], v0[3]); w.z = cvt_pk_bf16(v1[0], v1[1]); w.w = cvt_pk_bf16(v1[2], v1[3]);
                    *(u32x4*)(rowp + bj * HALF) = w; } }
    }
};
template <bool AUX> struct EpiRes {
    static constexpr bool PERM = false, AFTER_DRAIN = true;
    const float* base; float* out; bf16_t* xb; float* ssq;
    __device__ __forceinline__ void fused(f32x4 (&acc)[2][2][4][2], const Unit& u, int wr, int wc, int fr, int fq, PG8_LAS unsigned char* lds, int wid, int lane) const {
        PG8_LAS float* P = (PG8_LAS float*)lds;
        const int col0 = u.pn * BM + wc * 32 + 4 * fq;
#pragma unroll
        for (int ai = 0; ai < 2; ++ai)
#pragma unroll
            for (int m = 0; m < 4; ++m) { const int rl = ai * HALF + wr * 64 + m * 16 + fr; const size_t off = (size_t)(u.pm * BM + rl) * DM + col0; float s = 0.f;
#pragma unroll
                for (int bj = 0; bj < 2; ++bj)
#pragma unroll
                    for (int n = 0; n < 2; ++n) { const f32x4 bs = *(const f32x4*)(base + off + bj * HALF + n * 16); const f32x4 v = bs + acc[ai][bj][m][n];
                        *(f32x4*)(out + off + bj * HALF + n * 16) = v;
                        if (AUX) { s += (v[0] * v[0] + v[1] * v[1]) + (v[2] * v[2] + v[3] * v[3]);
                            typedef unsigned u32x2 __attribute__((ext_vector_type(2))); u32x2 w; w.x = cvt_pk_bf16(v[0], v[1]); w.y = cvt_pk_bf16(v[2], v[3]);
                            *(u32x2*)(xb + off + bj * HALF + n * 16) = w; } }
                if (AUX) { s += __shfl_xor(s, 16); s += __shfl_xor(s, 32); if (fq == 0) P[rl * 4 + wc] = s; }
            }
        if (AUX) {
            asm volatile("s_waitcnt lgkmcnt(0)" ::: "memory"); __builtin_amdgcn_s_barrier(); asm volatile("" ::: "memory");
            const int tid = wid * 64 + lane;
            if (tid < 256) { const float s = (P[tid * 4 + 0] + P[tid * 4 + 1]) + (P[tid * 4 + 2] + P[tid * 4 + 3]); ssq[(size_t)(u.pm * BM + tid) * 8 + u.pn] = s; }
        }
    }
};
struct EpiSwiglu {
    static constexpr bool PERM = true, AFTER_DRAIN = false;
    bf16_t* H; const float* ssq;
    __device__ __forceinline__ void operator()(const f32x4 (&acc)[2][2][4][2], const Unit& u, int wr, int wc, int fr, int fq) const {
        const int row0 = u.pm * BM + wr * 64 + fr, col0 = u.pn * HALF + wc * 32 + 8 * fq;
#pragma unroll
        for (int ai = 0; ai < 2; ++ai)
#pragma unroll
            for (int m = 0; m < 4; ++m) { const int r = row0 + ai * HALF + m * 16;
                const f32x4 s0 = *(const f32x4*)(ssq + (size_t)r * 8), s1 = *(const f32x4*)(ssq + (size_t)r * 8 + 4);
                const float tot = ((s0[0] + s0[1]) + (s0[2] + s0[3])) + ((s1[0] + s1[1]) + (s1[2] + s1[3]));
                const float rstd = rsqrtf(tot * (1.0f / DM) + NORM_EPS);
                float hv[8];
#pragma unroll
                for (int n = 0; n < 2; ++n)
#pragma unroll
                    for (int i = 0; i < 4; ++i) { const float g = acc[ai][0][m][n][i] * rstd, up = acc[ai][1][m][n][i] * rstd; hv[n * 4 + i] = g / (1.0f + __expf(-g)) * up; }
                u32x4 w; w.x = cvt_pk_bf16(hv[0], hv[1]); w.y = cvt_pk_bf16(hv[2], hv[3]); w.z = cvt_pk_bf16(hv[4], hv[5]); w.w = cvt_pk_bf16(hv[6], hv[7]);
                *(u32x4*)(H + (size_t)r * FF + col0) = w; }
    }
};
}

constexpr int RING_BYTES = 131072;
constexpr int LDS_BYTES = 147456;
struct Args { const float* in[15]; float* out; unsigned char* ws; int ph_lo, ph_hi; };
typedef short bf16x8 __attribute__((ext_vector_type(8)));
typedef float f32x16 __attribute__((ext_vector_type(16)));
__device__ __forceinline__ int crow(int r, int hi) { return (r & 3) + 8 * (r >> 2) + 4 * hi; }
typedef float f32x2_t __attribute__((ext_vector_type(2))); typedef __bf16 bf16x2_t __attribute__((ext_vector_type(2)));
__device__ __forceinline__ unsigned cvtpk(float lo, float hi) { f32x2_t v = {lo, hi}; bf16x2_t b = __builtin_convertvector(v, bf16x2_t); return __builtin_bit_cast(unsigned, b); }
template <int S> __device__ __forceinline__ bf16x8 pack8(const f32x16& a) {
    v4u w; w.x = cvtpk(a[8 * S + 0], a[8 * S + 1]); w.y = cvtpk(a[8 * S + 2], a[8 * S + 3]); w.z = cvtpk(a[8 * S + 4], a[8 * S + 5]); w.w = cvtpk(a[8 * S + 6], a[8 * S + 7]);
    return __builtin_bit_cast(bf16x8, w);
}
__device__ __forceinline__ bf16x8 join8(v2u lo, v2u hi) { v4u w; w.x = lo.x; w.y = lo.y; w.z = hi.x; w.w = hi.y; return __builtin_bit_cast(bf16x8, w); }
#define MFMA32(a, b, c) __builtin_amdgcn_mfma_f32_32x32x16_bf16((a), (b), (c), 0, 0, 0)

__device__ __forceinline__ void p0_item(const float* __restrict__ W, int K, int N, bf16* WT, int k0, int n0, int drow0, const float* __restrict__ kscale, float nscale, LAS float* scr, int lane) {
#pragma unroll 8
    for (int i = 0; i < 32; ++i) { const int kk = 2 * i + (lane >> 5); float v = W[(size_t)(k0 + kk) * N + n0 + (lane & 31)]; if (kscale) v *= kscale[k0 + kk]; scr[kk * 33 + (lane & 31)] = v * nscale; }
    LDS_WAIT(); asm volatile("" ::: "memory");
    const int c = lane & 7;
#pragma unroll
    for (int j = 0; j < 4; ++j) { const int n = (lane >> 3) + 8 * j; const LAS float* s = scr + (8 * c) * 33 + n;
        v4u o; o.x = pk2(s[0 * 33], s[1 * 33]); o.y = pk2(s[2 * 33], s[3 * 33]); o.z = pk2(s[4 * 33], s[5 * 33]); o.w = pk2(s[6 * 33], s[7 * 33]);
        *(v4u*)(WT + (size_t)(drow0 + n) * K + k0 + 8 * c) = o; }
    LDS_WAIT(); asm volatile("" ::: "memory");
}

__device__ __forceinline__ int t5_bucket(int rel) {
    const int nb = 16, max_exact = 8; int ret = rel > 0 ? nb : 0; const int n = rel < 0 ? -rel : rel;
    if (n < max_exact) return ret + n;
    int large = max_exact + (int)(log((double)n / (double)max_exact) / log(1024.0 / 8.0) * (double)(nb - max_exact));
    if (large > nb - 1) large = nb - 1;
    return ret + large;
}
__device__ __forceinline__ float logsig16(float z) { return (fminf(z, 0.f) - log1pf(__expf(-fabsf(z)))) * (1.0f / 16.0f); }

struct GlaBufs { const bf16* GQ; const bf16* GK; const bf16* GVT; const float* GLR; bf16* QINF; bf16* QINB; bf16* KETF; bf16* KETB; float* DECF; float* DECB; bf16* OI; bf16* OSF;
                 const float* gwF; const float* gbF; const float* gwB; const float* gbB; };
constexpr int GP = 136;
__device__ __forceinline__ f32x16 gla_xtile(const LAS bf16* Ks, const LAS bf16* Qs, int jt, int ct, int l31, int hi) {
    f32x16 acc = {};
    const LAS bf16* kp = Ks + (32 * jt + l31) * GP + 8 * hi; const LAS bf16* qp = Qs + (32 * ct + l31) * GP + 8 * hi;
#pragma unroll
    for (int d0 = 0; d0 < 8; ++d0) { const bf16x8 a = *(const LAS bf16x8*)(kp + 16 * d0); const bf16x8 b = *(const LAS bf16x8*)(qp + 16 * d0); acc = MFMA32(a, b, acc); }
    return acc;
}
__device__ __forceinline__ void gla_unit(int unit, const GlaBufs& B, LAS unsigned char* lds, int tid, int lane, int wave) {
    const int n = unit & 63, h = (unit >> 6) & 3, b = unit >> 8;
    const size_t row0 = (size_t)b * SEQ + 64 * n;
    LAS bf16* QF = (LAS bf16*)lds; LAS bf16* KF = QF + 64 * GP; LAS bf16* QB = KF + 64 * GP; LAS bf16* KB = QB + 64 * GP;
    LAS float* PS = (LAS float*)(lds + 69632);
    LAS float* LR = (LAS float*)(lds + 73728);
    __syncthreads();
    ((LAS f32x4*)LR)[tid] = ((const f32x4*)(B.GLR + row0 * 32))[tid];
    const int d = tid & 127, cgrp = tid >> 7, col = h * 128 + d;
    float gwf[16], gwb[16];
#pragma unroll
    for (int r = 0; r < 16; ++r) { gwf[r] = B.gwF[r * GKW + col]; gwb[r] = B.gwB[r * GKW + col]; }
    const float gbf = B.gbF[col], gbb = B.gbB[col];
    __syncthreads();
    float laf[16], lab[16];
#pragma unroll
    for (int cc = 0; cc < 16; ++cc) { const int c = cgrp * 16 + cc; float zf = gbf, zb = gbb;
#pragma unroll
        for (int r4 = 0; r4 < 4; ++r4) { const f32x4 a = *(const LAS f32x4*)(LR + c * 32 + 4 * r4), e = *(const LAS f32x4*)(LR + c * 32 + 16 + 4 * r4);
#pragma unroll
            for (int i = 0; i < 4; ++i) { zf += a[i] * gwf[4 * r4 + i]; zb += e[i] * gwb[4 * r4 + i]; } }
        laf[cc] = logsig16(zf); lab[cc] = logsig16(zb); }
#pragma unroll
    for (int cc = 1; cc < 16; ++cc) laf[cc] += laf[cc - 1];
#pragma unroll
    for (int cc = 14; cc >= 0; --cc) lab[cc] += lab[cc + 1];
    PS[cgrp * 128 + d] = laf[15]; PS[(4 + cgrp) * 128 + d] = lab[0];
    __syncthreads();
    float offf = 0.f, offb = 0.f, totf = 0.f, totb = 0.f;
#pragma unroll
    for (int g = 0; g < 4; ++g) { const float pf = PS[g * 128 + d], pb = PS[(4 + g) * 128 + d]; totf += pf; totb += pb; if (g < cgrp) offf += pf; if (g > cgrp) offb += pb; }
    float kef[16], keb[16];
#pragma unroll
    for (int cc = 0; cc < 16; ++cc) { const int c = cgrp * 16 + cc; const size_t row = row0 + c;
        const float Gf = laf[cc] + offf, Gb = lab[cc] + offb;
        const float q = bf2f(B.GQ[row * GKW + col]), k = bf2f(B.GK[row * GKW + col]);
        const float qf = q * __expf(Gf), kf = k * __expf(-Gf), qb = q * __expf(Gb), kb = k * __expf(-Gb);
        kef[cc] = k * __expf(totf - Gf); keb[cc] = k * __expf(totb - Gb);
        const bf16 qfh = (bf16)f2bf(qf), qbh = (bf16)f2bf(qb);
        QF[c * GP + d] = qfh; KF[c * GP + d] = (bf16)f2bf(kf); QB[c * GP + d] = qbh; KB[c * GP + d] = (bf16)f2bf(kb);
        B.QINF[row * GKW + col] = qfh; B.QINB[row * GKW + col] = qbh; }
    { v4u w0, w1; bf16* dst = B.KETF + (size_t)col * T_ + row0 + cgrp * 16;
      w0.x = pk2(kef[0], kef[1]); w0.y = pk2(kef[2], kef[3]); w0.z = pk2(kef[4], kef[5]); w0.w = pk2(kef[6], kef[7]);
      w1.x = pk2(kef[8], kef[9]); w1.y = pk2(kef[10], kef[11]); w1.z = pk2(kef[12], kef[13]); w1.w = pk2(kef[14], kef[15]);
      ((v4u*)dst)[0] = w0; ((v4u*)dst)[1] = w1;
      dst = B.KETB + (size_t)col * T_ + row0 + cgrp * 16;
      w0.x = pk2(keb[0], keb[1]); w0.y = pk2(keb[2], keb[3]); w0.z = pk2(keb[4], keb[5]); w0.w = pk2(keb[6], keb[7]);
      w1.x = pk2(keb[8], keb[9]); w1.y = pk2(keb[10], keb[11]); w1.z = pk2(keb[12], keb[13]); w1.w = pk2(keb[14], keb[15]);
      ((v4u*)dst)[0] = w0; ((v4u*)dst)[1] = w1; }
    if (cgrp == 0) { B.DECF[(size_t)(b * 64 + n) * GKW + col] = __expf(totf); B.DECB[(size_t)(b * 64 + n) * GKW + col] = __expf(totb); }
    __syncthreads();
    const int l31 = lane & 31, hi = lane >> 5;
    bf16x8 vt[2][2];
    { const bf16* vbase = B.GVT + (size_t)(h * 256 + 32 * wave + l31) * T_ + row0 + 4 * hi;
#pragma unroll
      for (int jt = 0; jt < 2; ++jt)
#pragma unroll
          for (int s = 0; s < 2; ++s) { const bf16* p = vbase + 32 * jt + 16 * s; vt[jt][s] = join8(*(const v2u*)p, *(const v2u*)(p + 8)); } }
    f32x16 o0 = {}, o1 = {};
    {
        f32x16 X = gla_xtile(KF, QF, 0, 0, l31, hi);
#pragma unroll
        for (int r = 0; r < 16; ++r) if (crow(r, hi) > l31) X[r] = 0.f;
        o0 = MFMA32(vt[0][0], pack8<0>(X), o0); o0 = MFMA32(vt[0][1], pack8<1>(X), o0);
        X = gla_xtile(KF, QF, 0, 1, l31, hi);
        o1 = MFMA32(vt[0][0], pack8<0>(X), o1); o1 = MFMA32(vt[0][1], pack8<1>(X), o1);
        X = gla_xtile(KF, QF, 1, 1, l31, hi);
#pragma unroll
        for (int r = 0; r < 16; ++r) if (crow(r, hi) > l31) X[r] = 0.f;
        o1 = MFMA32(vt[1][0], pack8<0>(X), o1); o1 = MFMA32(vt[1][1], pack8<1>(X), o1);
    }
    {
        f32x16 X = gla_xtile(KB, QB, 0, 0, l31, hi);
#pragma unroll
        for (int r = 0; r < 16; ++r) if (crow(r, hi) < l31) X[r] = 0.f;
        o0 = MFMA32(vt[0][0], pack8<0>(X), o0); o0 = MFMA32(vt[0][1], pack8<1>(X), o0);
        X = gla_xtile(KB, QB, 1, 0, l31, hi);
        o0 = MFMA32(vt[1][0], pack8<0>(X), o0); o0 = MFMA32(vt[1][1], pack8<1>(X), o0);
        X = gla_xtile(KB, QB, 1, 1, l31, hi);
#pragma unroll
        for (int r = 0; r < 16; ++r) if (crow(r, hi) < l31) X[r] = 0.f;
        o1 = MFMA32(vt[1][0], pack8<0>(X), o1); o1 = MFMA32(vt[1][1], pack8<1>(X), o1);
    }
    { bf16* ob = B.OI + (row0 + l31) * GVW + h * 256 + 32 * wave + 4 * hi;
#pragma unroll
      for (int g = 0; g < 4; ++g) { v2u w; w.x = cvtpk(o0[4 * g], o0[4 * g + 1]); w.y = cvtpk(o0[4 * g + 2], o0[4 * g + 3]); *(v2u*)(ob + 8 * g) = w;
          v2u w1; w1.x = cvtpk(o1[4 * g], o1[4 * g + 1]); w1.y = cvtpk(o1[4 * g + 2], o1[4 * g + 3]); *(v2u*)(ob + (size_t)32 * GVW + 8 * g) = w1; } }
}

constexpr int SC_Q = 0, SC_K = 17408, SC_V = 35840, SC_D = 72704, SC_STAGE = 73216;
__device__ __forceinline__ void gla_scan(int item, const GlaBufs& B, LAS unsigned char* lds, int tid, int lane, int wave) {
    const int dir = item & 1, h = (item >> 1) & 3, b = item >> 3;
    const bf16* QIN = dir ? B.QINB : B.QINF; const bf16* KET = dir ? B.KETB : B.KETF; const float* DEC = dir ? B.DECB : B.DECF;
    const int l31 = lane & 31, hi = lane >> 5;
    v4u rq[2], rk[2], rv[4]; f32x4 rd = {};
    const int qc0 = tid >> 4, qch = tid & 15;
    const int kd0 = tid >> 3, kch = tid & 7;
#define SC_LOAD(nn) do { const size_t r0_ = (size_t)b * SEQ + 64 * (nn); \
        rq[0] = *(const v4u*)(QIN + (r0_ + qc0) * GKW + h * 128 + qch * 8); rq[1] = *(const v4u*)(QIN + (r0_ + qc0 + 32) * GKW + h * 128 + qch * 8); \
        rk[0] = *(const v4u*)(KET + (size_t)(h * 128 + kd0) * T_ + r0_ + kch * 8); rk[1] = *(const v4u*)(KET + (size_t)(h * 128 + kd0 + 64) * T_ + r0_ + kch * 8); \
        _Pragma("unroll") for (int i_ = 0; i_ < 4; ++i_) rv[i_] = *(const v4u*)(B.GVT + (size_t)(h * 256 + kd0 + 64 * i_) * T_ + r0_ + kch * 8); \
        if (tid < 32) rd = *(const f32x4*)(DEC + (size_t)(b * 64 + (nn)) * GKW + h * 128 + tid * 4); } while (0)
#define SC_WRITE(st) do { LAS unsigned char* s_ = lds + (st) * SC_STAGE; \
        *(LAS v4u*)(s_ + SC_Q + qc0 * 272 + qch * 16) = rq[0]; *(LAS v4u*)(s_ + SC_Q + (qc0 + 32) * 272 + qch * 16) = rq[1]; \
        *(LAS v4u*)(s_ + SC_K + kd0 * 144 + kch * 16) = rk[0]; *(LAS v4u*)(s_ + SC_K + (kd0 + 64) * 144 + kch * 16) = rk[1]; \
        _Pragma("unroll") for (int i_ = 0; i_ < 4; ++i_) *(LAS v4u*)(s_ + SC_V + (kd0 + 64 * i_) * 144 + kch * 16) = rv[i_]; \
        if (tid < 32) *(LAS f32x4*)(s_ + SC_D + tid * 16) = rd; } while (0)
    __syncthreads();
    SC_LOAD(dir ? 63 : 0); SC_WRITE(0);
    __syncthreads();
    f32x16 S0 = {}, S1 = {}, S2 = {}, S3 = {};
    int cur = 0;
    for (int step = 0; step < 64; ++step) {
        const int n = dir ? 63 - step : step;
        if (step + 1 < 64) SC_LOAD(dir ? 62 - step : step + 1);
        const LAS unsigned char* st = lds + cur * SC_STAGE;
        f32x16 i0 = {}, i1 = {};
        const LAS unsigned char* qb0 = st + SC_Q + l31 * 272 + 8 * hi; const LAS unsigned char* qb1 = qb0 + 32 * 272;
#define SC_INTER(Sx, dt) do { \
            { const bf16x8 a = pack8<0>(Sx); const bf16x8 b0 = join8(*(const LAS v2u*)(qb0 + (32 * (dt)) * 2), *(const LAS v2u*)(qb0 + (32 * (dt) + 8) * 2)); \
              const bf16x8 b1 = join8(*(const LAS v2u*)(qb1 + (32 * (dt)) * 2), *(const LAS v2u*)(qb1 + (32 * (dt) + 8) * 2)); i0 = MFMA32(a, b0, i0); i1 = MFMA32(a, b1, i1); } \
            { const bf16x8 a = pack8<1>(Sx); const bf16x8 b0 = join8(*(const LAS v2u*)(qb0 + (32 * (dt) + 16) * 2), *(const LAS v2u*)(qb0 + (32 * (dt) + 24) * 2)); \
              const bf16x8 b1 = join8(*(const LAS v2u*)(qb1 + (32 * (dt) + 16) * 2), *(const LAS v2u*)(qb1 + (32 * (dt) + 24) * 2)); i0 = MFMA32(a, b0, i0); i1 = MFMA32(a, b1, i1); } } while (0)
        SC_INTER(S0, 0); SC_INTER(S1, 1); SC_INTER(S2, 2); SC_INTER(S3, 3);
        {
            const size_t e0 = ((size_t)b * SEQ + 64 * n + l31) * GVW + h * 256 + 32 * wave + 4 * hi;
#pragma unroll
            for (int g = 0; g < 4; ++g) {
                if (dir == 0) { v2u w; w.x = cvtpk(i0[4 * g], i0[4 * g + 1]); w.y = cvtpk(i0[4 * g + 2], i0[4 * g + 3]); *(v2u*)(B.OSF + e0 + 8 * g) = w;
                                v2u w1; w1.x = cvtpk(i1[4 * g], i1[4 * g + 1]); w1.y = cvtpk(i1[4 * g + 2], i1[4 * g + 3]); *(v2u*)(B.OSF + e0 + (size_t)32 * GVW + 8 * g) = w1; }
                else { v2u* p0 = (v2u*)(B.OI + e0 + 8 * g); v2u* p1 = (v2u*)(B.OI + e0 + (size_t)32 * GVW + 8 * g); const v2u a0 = *p0, a1 = *p1;
                       v2u w; w.x = cvtpk(i0[4 * g] + bflo(a0.x), i0[4 * g + 1] + bfhi(a0.x)); w.y = cvtpk(i0[4 * g + 2] + bflo(a0.y), i0[4 * g + 3] + bfhi(a0.y)); *p0 = w;
                       v2u w1; w1.x = cvtpk(i1[4 * g] + bflo(a1.x), i1[4 * g + 1] + bfhi(a1.x)); w1.y = cvtpk(i1[4 * g + 2] + bflo(a1.y), i1[4 * g + 3] + bfhi(a1.y)); *p1 = w1; } }
        }
        const LAS unsigned char* kb_ = st + SC_K + l31 * 144 + 16 * hi; const LAS unsigned char* vb_ = st + SC_V + (32 * wave + l31) * 144 + 16 * hi;
        bf16x8 vf[4];
#pragma unroll
        for (int s = 0; s < 4; ++s) vf[s] = *(const LAS bf16x8*)(vb_ + 32 * s);
#define SC_UPD(Sx, dt) do { \
            _Pragma("unroll") for (int g = 0; g < 4; ++g) { const f32x4 dv = *(const LAS f32x4*)(st + SC_D + (32 * (dt) + 8 * g + 4 * hi) * 4); \
                Sx[4 * g] *= dv[0]; Sx[4 * g + 1] *= dv[1]; Sx[4 * g + 2] *= dv[2]; Sx[4 * g + 3] *= dv[3]; } \
            _Pragma("unroll") for (int s = 0; s < 4; ++s) { const bf16x8 a = *(const LAS bf16x8*)(kb_ + (32 * (dt)) * 144 + 32 * s); Sx = MFMA32(a, vf[s], Sx); } } while (0)
        SC_UPD(S0, 0); SC_UPD(S1, 1); SC_UPD(S2, 2); SC_UPD(S3, 3);
        if (step + 1 < 64) SC_WRITE(cur ^ 1);
        __syncthreads();
        cur ^= 1;
    }
#undef SC_LOAD
#undef SC_WRITE
#undef SC_INTER
#undef SC_UPD
}

struct AttnBufs { const bf16* AQ; const bf16* AK; const bf16* AV; const float* BIAS2; bf16* OP; float* LSE; };
constexpr int AT_VP = 784;
constexpr int AT_BT = 64 * AT_VP;
__device__ __forceinline__ void attn_unit(int u, const AttnBufs& A, LAS unsigned char* lds, int tid, int lane, int wave) {
    const int bh = u / 48, w48 = u % 48, p = w48 >> 4, idx = w48 & 15;
    const int b = bh >> 4, h = bh & 15;
    const int r = (p == 0) ? 1 : (p == 1 ? 4 : 16), L = SEQ / r;
    const int j = (p == 0) ? 0 : (p == 1 ? (idx >> 2) : idx), kb = (p == 0) ? idx : (p == 1 ? (idx & 3) : 0);
    const int l31 = lane & 31, hi = lane >> 5;
    const size_t tb = (size_t)b * SEQ;
    __syncthreads();
    for (int e = tid; e < 4 * 196; e += NWAVES * 64) { const int c = e / 196, i = e % 196, dl = i + c - 95;
        float v = -INFINITY; if (dl >= -64 && dl <= 64) v = A.BIAS2[(p * 129 + dl + 64) * 16 + h];
        ((LAS float*)(lds + AT_BT))[e] = v; }
    {
        const int wbase = kb * 256 - 64;
#pragma unroll
        for (int grp = 0; grp < 3; ++grp) { const int kk0 = 2 * (64 * grp + lane); const int sp0 = wbase + kk0, sp1 = sp0 + 1;
            v4u a = {0u, 0u, 0u, 0u}, c2 = {0u, 0u, 0u, 0u};
            if (sp0 >= 0 && sp0 < L) a = *(const v4u*)(A.AV + (tb + (size_t)sp0 * r + j) * AW + h * AD + 8 * wave);
            if (sp1 >= 0 && sp1 < L) c2 = *(const v4u*)(A.AV + (tb + (size_t)sp1 * r + j) * AW + h * AD + 8 * wave);
            const int w16 = kk0 & 15, slot = (kk0 & ~15) | (w16 & 3) | (((w16 >> 3) & 1) << 2) | (((w16 >> 2) & 1) << 3);
            LAS unsigned char* dst = lds + (8 * wave) * AT_VP + slot * 2;
            *(LAS unsigned*)(dst + 0 * AT_VP) = (a.x & 0xffffu) | (c2.x << 16);
            *(LAS unsigned*)(dst + 1 * AT_VP) = (a.x >> 16) | (c2.x & 0xffff0000u);
            *(LAS unsigned*)(dst + 2 * AT_VP) = (a.y & 0xffffu) | (c2.y << 16);
            *(LAS unsigned*)(dst + 3 * AT_VP) = (a.y >> 16) | (c2.y & 0xffff0000u);
            *(LAS unsigned*)(dst + 4 * AT_VP) = (a.z & 0xffffu) | (c2.z << 16);
            *(LAS unsigned*)(dst + 5 * AT_VP) = (a.z >> 16) | (c2.z & 0xffff0000u);
            *(LAS unsigned*)(dst + 6 * AT_VP) = (a.w & 0xffffu) | (c2.w << 16);
            *(LAS unsigned*)(dst + 7 * AT_VP) = (a.w >> 16) | (c2.w & 0xffff0000u); }
    }
    __syncthreads();
    const int i0 = kb * 256 + 32 * wave;
    const size_t tq = tb + (size_t)(i0 + l31) * r + j;
    bf16x8 qf[4];
#pragma unroll
    for (int d0 = 0; d0 < 4; ++d0) qf[d0] = *(const bf16x8*)(A.AQ + tq * AW + h * AD + 16 * d0 + 8 * hi);
    f32x16 S[5];
    const int cshift = 3 - (l31 & 3);
    const LAS unsigned char* btl = lds + AT_BT + cshift * AT_VP + (4 * hi + 28 - 4 * (l31 >> 2)) * 4;
    float m = -INFINITY;
#pragma unroll
    for (int t = 0; t < 5; ++t) { const int sb = i0 - 64 + 32 * t;
        if (sb >= 0 && sb < L) {
            const bf16* kp = A.AK + (tb + (size_t)(sb + l31) * r + j) * AW + h * AD + 8 * hi;
            f32x16 acc = {};
#pragma unroll
            for (int d0 = 0; d0 < 4; ++d0) { const bf16x8 kf = *(const bf16x8*)(kp + 16 * d0); acc = MFMA32(kf, qf[d0], acc); }
#pragma unroll
            for (int g = 0; g < 4; ++g) { const f32x4 bv = *(const LAS f32x4*)(btl + (32 * t + 8 * g) * 4);
#pragma unroll
                for (int i = 0; i < 4; ++i) { acc[4 * g + i] += bv[i]; m = fmaxf(m, acc[4 * g + i]); } }
            S[t] = acc;
        } else {
#pragma unroll
            for (int i = 0; i < 16; ++i) S[t][i] = -INFINITY;
        } }
    m = fmaxf(m, __shfl_xor(m, 32));
    float ssum = 0.f;
#pragma unroll
    for (int t = 0; t < 5; ++t)
#pragma unroll
        for (int i = 0; i < 16; ++i) { const float e = exp2f(S[t][i] - m); S[t][i] = e; ssum += e; }
    ssum += __shfl_xor(ssum, 32);
    f32x16 o0 = {}, o1 = {};
    const LAS unsigned char* vb = lds + l31 * AT_VP + (32 * wave) * 2 + 16 * hi;
#pragma unroll
    for (int t = 0; t < 5; ++t) { const int sb = i0 - 64 + 32 * t;
        if (sb >= 0 && sb < L) {
            const bf16x8 p0 = pack8<0>(S[t]), p1 = pack8<1>(S[t]);
            const bf16x8 v00 = *(const LAS bf16x8*)(vb + (32 * t) * 2), v01 = *(const LAS bf16x8*)(vb + (32 * t + 16) * 2);
            const bf16x8 v10 = *(const LAS bf16x8*)(vb + 32 * AT_VP + (32 * t) * 2), v11 = *(const LAS bf16x8*)(vb + 32 * AT_VP + (32 * t + 16) * 2);
            o0 = MFMA32(v00, p0, o0); o0 = MFMA32(v01, p1, o0);
            o1 = MFMA32(v10, p0, o1); o1 = MFMA32(v11, p1, o1);
        } }
    const float inv = 1.0f / ssum;
    { bf16* ob = A.OP + (size_t)p * ((size_t)T_ * AW) + tq * AW + h * AD + 4 * hi;
#pragma unroll
      for (int g = 0; g < 4; ++g) { v2u w; w.x = cvtpk(o0[4 * g] * inv, o0[4 * g + 1] * inv); w.y = cvtpk(o0[4 * g + 2] * inv, o0[4 * g + 3] * inv); *(v2u*)(ob + 8 * g) = w;
          v2u w1; w1.x = cvtpk(o1[4 * g] * inv, o1[4 * g + 1] * inv); w1.y = cvtpk(o1[4 * g + 2] * inv, o1[4 * g + 3] * inv); *(v2u*)(ob + 32 + 8 * g) = w1; } }
    if (hi == 0) A.LSE[(size_t)p * ((size_t)T_ * AH) + tq * AH + h] = m + log2f(ssum);
}
__global__ void __launch_bounds__(NWAVES * 64, 2) fwd(Args args) {
    extern __shared__ __attribute__((aligned(16))) unsigned char lds_raw[];
    LAS unsigned char* lds = (LAS unsigned char*)lds_raw;
    const int tid = threadIdx.x, lane = tid & 63, wave = __builtin_amdgcn_readfirstlane(tid >> 6);
    const int G = gridDim.x; const int bx = blockIdx.x; const int vcu = (G % 8 == 0) ? (bx % 8) * (G / 8) + bx / 8 : bx;
    const int gw = vcu * NWAVES + wave, NGW = G * NWAVES;
    unsigned char* ws = args.ws;
    const float* x = args.in[0]; float* out = args.out;
    bf16* Wt_in = (bf16*)(ws + WS_WIN); bf16* Wt_out = (bf16*)(ws + WS_WOUT); bf16* Wt_gu = (bf16*)(ws + WS_WGU); bf16* Wt_dn = (bf16*)(ws + WS_WDN);
    bf16* XN = (bf16*)(ws + WS_XN); bf16* RB = (bf16*)(ws + WS_RB);
    float* BIAS2 = (float*)(ws + WS_BIAS2); float* SSQ1 = (float*)(ws + WS_SSQ1);
    float* GLR = (float*)(RB + E_GLR);
    GlaBufs GB;
    GB.GQ = RB + E_GQ; GB.GK = RB + E_GK; GB.GVT = RB + E_GVT; GB.GLR = GLR;
    GB.OI = (bf16*)(ws + WS_XN); GB.QINF = GB.OI + (size_t)T_ * 1024; GB.QINB = GB.QINF + (size_t)T_ * 512;
    GB.KETF = (bf16*)(ws + WS_WIN); GB.KETB = GB.KETF + (size_t)T_ * 512;
    GB.DECF = (float*)(ws + WS_WIN + 16 * MiB); GB.DECB = GB.DECF + 128 * 512;
    GB.OSF = RB + E_GQ;
    GB.gwF = args.in[4]; GB.gbF = args.in[5]; GB.gwB = args.in[6]; GB.gbB = args.in[7];
    bf16* Y = RB;
    bf16* X1B = (bf16*)(ws + WS_XN);
    bf16* HB = RB;
    AttnBufs AB; AB.AQ = RB + E_AQ; AB.AK = RB + E_AK; AB.AV = RB + E_AV; AB.BIAS2 = BIAS2;
    AB.OP = (bf16*)out; AB.LSE = (float*)((unsigned char*)out + 48 * MiB);
    const int lo = args.ph_lo, hi = args.ph_hi;
#define IN(k) (lo <= (k) && (k) < hi)
#define SEAM(k) do { if (IN(k) && IN((k) + 1)) { cg::this_grid().sync(); } } while (0)

    if (IN(0)) {
        LAS float* scr = (LAS float*)(lds + wave * 16384);
        constexpr int I_IN = 32 * 193, I_OUT = 32 * 64, I_G = 32 * 176, I_D = 88 * 64, NITEMS = I_IN + I_OUT + 2 * I_G + I_D;
        for (int it = gw; it < NITEMS; it += NGW) {
            int r = it;
            if (r < I_IN) { const int kb = r / 193, nb = r % 193, n0 = nb * 32;
                int drow; float sc = 1.f;
                if (n0 < 1024) { drow = n0; sc = 0.125f * LOG2E; }
                else if (n0 < 3072) drow = n0;
                else if (n0 < 3584) { drow = n0; sc = 0.08838834764831845f; }
                else if (n0 < 4096) drow = n0;
                else if (n0 < 5120) drow = n0 + 1024;
                else if (n0 < 6144) drow = n0 - 1024;
                else drow = n0;
                p0_item(args.in[2], DM, INW, Wt_in, kb * 64, n0, drow, nullptr, sc, scr, lane); continue; }
            r -= I_IN;
            if (r < I_OUT) { const int kb = r / 64, nb = r % 64; p0_item(args.in[9], DM, DM, Wt_out, kb * 64, nb * 32, nb * 32, nullptr, 1.f, scr, lane); continue; }
            r -= I_OUT;
            if (r < I_G) { const int kb = r / 176, nb = r % 176, n0 = nb * 32; p0_item(args.in[11], DM, FF, Wt_gu, kb * 64, n0, (n0 >> 7) * 256 + (n0 & 127), args.in[10], 1.f, scr, lane); continue; }
            r -= I_G;
            if (r < I_G) { const int kb = r / 176, nb = r % 176, n0 = nb * 32; p0_item(args.in[12], DM, FF, Wt_gu, kb * 64, n0, (n0 >> 7) * 256 + 128 + (n0 & 127), args.in[10], 1.f, scr, lane); continue; }
            r -= I_G;
            { const int kb = r / 64, nb = r % 64; p0_item(args.in[13], FF, DM, Wt_dn, kb * 64, nb * 32, nb * 32, nullptr, 1.f, scr, lane); }
        }
        const float* nw = args.in[1];
        for (int m = gw; m < T_; m += NGW) {
            const f32x4* xr = (const f32x4*)(x + (size_t)m * DM) + lane; f32x4 v[8]; float s = 0.f;
#pragma unroll
            for (int j = 0; j < 8; ++j) { v[j] = xr[64 * j]; s += (v[j][0] * v[j][0] + v[j][1] * v[j][1]) + (v[j][2] * v[j][2] + v[j][3] * v[j][3]); }
            const float rstd = rsqrtf(wave_sum(s) * (1.f / DM) + NORM_EPS);
            v2u* o8 = (v2u*)(XN + (size_t)m * DM) + lane;
#pragma unroll
            for (int j = 0; j < 8; ++j) { const f32x4 w = ((const f32x4*)nw)[lane + 64 * j]; v2u o; o.x = pk2(v[j][0] * rstd * w[0], v[j][1] * rstd * w[1]); o.y = pk2(v[j][2] * rstd * w[2], v[j][3] * rstd * w[3]); o8[64 * j] = o; }
        }
        if (bx == 0) {
            const float* tbl = args.in[3];
            for (int idx = tid; idx < 3 * 129; idx += NWAVES * 64) { const int p = idx / 129, s = idx % 129; const int r = (p == 0) ? 1 : (p == 1 ? 4 : 16);
                const int bk = t5_bucket((s - 64) * r);
                for (int h = 0; h < 16; ++h) BIAS2[idx * 16 + h] = tbl[bk * 16 + h] * LOG2E; }
        }
    }
    SEAM(0);

    if (IN(1)) {
        { pg8::Gemm g{XN, Wt_in, T_, 5120, DM}; pg8::StaticOrder S; S.init(T_, 5120, G, bx); pg8::EpiProj E{RB};
          pg8::gemm_phase<pg8::EpiProj, pg8::StaticOrder, true, true>(lds, g, S, E); }
        { pg8::Gemm g{Wt_in + (size_t)5120 * DM, XN, 1024, T_, DM}; pg8::StaticOrder S; S.init(1024, T_, G, (bx + G / 2) % G); pg8::EpiPlain E{RB + E_GVT, T_};
          pg8::gemm_phase<pg8::EpiPlain, pg8::StaticOrder, true, true>(lds, g, S, E); }
        for (int o = vcu * 512 + tid; o < T_ * 32; o += G * 512) { const int t = o >> 5, j = o & 31;
            const v4u* a = (const v4u*)(XN + (size_t)t * DM); const v4u* b = (const v4u*)(Wt_in + (size_t)(6144 + j) * DM); float s = 0.f;
            for (int k = 0; k < DM / 8; ++k) { const v4u av = a[k], bv = b[k];
                s += bflo(av.x) * bflo(bv.x) + bfhi(av.x) * bfhi(bv.x) + bflo(av.y) * bflo(bv.y) + bfhi(av.y) * bfhi(bv.y)
                   + bflo(av.z) * bflo(bv.z) + bfhi(av.z) * bfhi(bv.z) + bflo(av.w) * bflo(bv.w) + bfhi(av.w) * bfhi(bv.w); }
            GLR[o] = s; }
    }
    SEAM(1);

    if (IN(2)) {
        for (int it = bx; it < 512 + 1536; it += G) { if (it < 512) gla_unit(it, GB, lds, tid, lane, wave); else attn_unit(it - 512, AB, lds, tid, lane, wave); }
    }
    SEAM(2);

    if (IN(3)) {
        for (int it = bx; it < 16; it += G) gla_scan(it, GB, lds, tid, lane, wave);
    }
    SEAM(3);

    if (IN(4)) {
        const bf16* GR = RB + E_GR; const float* gnw = args.in[8];
        for (int item = gw; item < T_ * 8; item += NGW) { const int row = item >> 3, part = item & 7;
            if (part < 4) {
                const int hh = 4 * part + (lane >> 4); const size_t eo = (size_t)row * AW + part * 256 + lane * 4;
                const float l0 = AB.LSE[(size_t)row * AH + hh], l1 = AB.LSE[(size_t)T_ * AH + (size_t)row * AH + hh], l2 = AB.LSE[(size_t)2 * T_ * AH + (size_t)row * AH + hh];
                const float M = fmaxf(fmaxf(l0, l1), l2); const float w0 = exp2f(l0 - M), w1 = exp2f(l1 - M), w2 = exp2f(l2 - M); const float iw = 1.0f / (w0 + w1 + w2);
                const v2u a0 = *(const v2u*)(AB.OP + eo), a1 = *(const v2u*)(AB.OP + (size_t)T_ * AW + eo), a2 = *(const v2u*)(AB.OP + (size_t)2 * T_ * AW + eo);
                const float y0 = (w0 * bflo(a0.x) + w1 * bflo(a1.x) + w2 * bflo(a2.x)) * iw, y1 = (w0 * bfhi(a0.x) + w1 * bfhi(a1.x) + w2 * bfhi(a2.x)) * iw;
                const float y2 = (w0 * bflo(a0.y) + w1 * bflo(a1.y) + w2 * bflo(a2.y)) * iw, y3 = (w0 * bfhi(a0.y) + w1 * bfhi(a1.y) + w2 * bfhi(a2.y)) * iw;
                v2u ov; ov.x = pk2(y0, y1); ov.y = pk2(y2, y3);
                *(v2u*)(Y + (size_t)row * DM + part * 256 + lane * 4) = ov;
            } else { const int h = part - 4; const size_t o = (size_t)row * GVW + h * 256;
                const v2u a = ((const v2u*)(GB.OI + o))[lane], c = ((const v2u*)(GB.OSF + o))[lane], g = ((const v2u*)(GR + o))[lane];
                float v[4] = {bflo(a.x) + bflo(c.x), bfhi(a.x) + bfhi(c.x), bflo(a.y) + bflo(c.y), bfhi(a.y) + bfhi(c.y)};
                const float gr[4] = {bflo(g.x), bfhi(g.x), bflo(g.y), bfhi(g.y)};
                const float ss = wave_sum((v[0] * v[0] + v[1] * v[1]) + (v[2] * v[2] + v[3] * v[3]));
                const float rstd = rsqrtf(ss * (1.0f / 256.0f) + NORM_EPS);
                const f32x4 w = ((const f32x4*)(gnw + h * 256))[lane];
                float y[4];
#pragma unroll
                for (int i = 0; i < 4; ++i) y[i] = v[i] * rstd * w[i] * (gr[i] / (1.0f + __expf(-gr[i])));
                v2u ov; ov.x = pk2(y[0], y[1]); ov.y = pk2(y[2], y[3]);
                ((v2u*)(Y + (size_t)row * DM + 1024 + h * 256))[lane] = ov; }
        }
    }
    SEAM(4);

    if (IN(5)) {
        pg8::Gemm g{Y, Wt_out, T_, DM, DM}; pg8::StaticOrder S; S.init(T_, DM, G, bx); pg8::EpiRes<true> E{x, out, X1B, SSQ1};
        pg8::gemm_phase<pg8::EpiRes<true>, pg8::StaticOrder, false, true>(lds, g, S, E);
    }
    SEAM(5);

    if (IN(6)) {
        pg8::Gemm g{X1B, Wt_gu, T_, 2 * FF, DM}; pg8::StaticOrder S; S.init(T_, 2 * FF, G, bx); pg8::EpiSwiglu E{HB, SSQ1};
        pg8::gemm_phase<pg8::EpiSwiglu, pg8::StaticOrder, true, true>(lds, g, S, E);
    }
    SEAM(6);

    if (IN(7)) {
        pg8::Gemm g{HB, Wt_dn, T_, DM, FF}; pg8::StaticOrder S; S.init(T_, DM, G, bx); pg8::EpiRes<false> E{out, out, nullptr, nullptr};
        pg8::gemm_phase<pg8::EpiRes<false>, pg8::StaticOrder, false, true>(lds, g, S, E);
    }
    SEAM(7);

    if (IN(8)) {
        const float* fw = args.in[14];
        for (int m = gw; m < T_; m += NGW) {
            f32x4* xr = (f32x4*)(out + (size_t)m * DM) + lane; f32x4 v[8]; float s = 0.f;
#pragma unroll
            for (int j = 0; j < 8; ++j) { v[j] = xr[64 * j]; s += (v[j][0] * v[j][0] + v[j][1] * v[j][1]) + (v[j][2] * v[j][2] + v[j][3] * v[j][3]); }
            const float rstd = rsqrtf(wave_sum(s) * (1.f / DM) + NORM_EPS);
#pragma unroll
            for (int j = 0; j < 8; ++j) { const f32x4 w = ((const f32x4*)fw)[lane + 64 * j]; xr[64 * j] = v[j] * rstd * w; }
        }
    }
#undef IN
#undef SEAM
}

extern "C" void kernel_launch(void* const* d_in, const int* in_sizes, int n_in, void* d_out, int out_size, void* d_ws, size_t ws_size, hipStream_t stream) {
    static int grid = 0;
    if (grid == 0) {
        if (n_in != 15 || out_size != T_ * DM || ws_size < WS_END) { fprintf(stderr, "kernel_launch: unexpected shapes (n_in %d out %d ws %zu)\n", n_in, out_size, ws_size); grid = -1; return; }
        int dev = 0, cus = 0, per_cu = 0;
        if (hipGetDevice(&dev) != hipSuccess || hipDeviceGetAttribute(&cus, hipDeviceAttributeMultiprocessorCount, dev) != hipSuccess) { grid = -1; return; }
        if (hipFuncSetAttribute((const void*)fwd, hipFuncAttributeMaxDynamicSharedMemorySize, LDS_BYTES) != hipSuccess) { fprintf(stderr, "kernel_launch: hipFuncSetAttribute failed\n"); grid = -1; return; }
        if (hipOccupancyMaxActiveBlocksPerMultiprocessor(&per_cu, (const void*)fwd, NWAVES * 64, LDS_BYTES) != hipSuccess || per_cu < 1) { fprintf(stderr, "kernel_launch: occupancy query reports %d\n", per_cu); per_cu = 1; }
        (void)hipGetLastError();
        grid = cus;
    }
    if (grid < 0) return;
    Args a{};
    for (int i = 0; i < 15; ++i) a.in[i] = (const float*)d_in[i];
    a.out = (float*)d_out; a.ws = (unsigned char*)d_ws;
#if MK_LAUNCHES == 1
    a.ph_lo = 0; a.ph_hi = NPHASE;
    void* kargs[] = {&a};
    hipError_t e = hipLaunchCooperativeKernel((const void*)fwd, dim3(grid), dim3(NWAVES * 64), kargs, LDS_BYTES, stream);
    if (e != hipSuccess) fprintf(stderr, "kernel_launch: cooperative launch failed: %s (grid %d)\n", hipGetErrorString(e), grid);
#else
    for (int p = 0; p < NPHASE; ++p) { a.ph_lo = p; a.ph_hi = p + 1; hipLaunchKernelGGL(fwd, dim3(grid), dim3(NWAVES * 64), LDS_BYTES, stream, a); }
#endif
}
```

```cpp
#include <hip/hip_runtime.h>
#include <hip/hip_cooperative_groups.h>
#include <cstdio>
#include <cstdint>
namespace cg = cooperative_groups;

namespace pg8 {
#define PG8_LAS __attribute__((address_space(3)))
typedef unsigned short bf16_t;
typedef short bf16x8 __attribute__((ext_vector_type(8)));
typedef float f32x4 __attribute__((ext_vector_type(4)));
typedef unsigned u32x4 __attribute__((ext_vector_type(4)));
constexpr int BM = 256, BK = 64, HALF = 128, HTB = HALF * BK * 2  , STAGE_BYTES = 8 * HTB, NXCD = 8, WGM = 8;

__host__ __device__ __forceinline__ int lds_byte(int r, int c) { const int st = (r >> 4) * 2 + (c >> 5), rr = r & 15, cc = c & 31, ob = rr * 64 + cc * 2; return st * 1024 + (ob ^ (((ob >> 9) & 1) << 5)); }
__host__ __device__ __forceinline__ void stage_rc(int b, int& R, int& C) { const int st = b / 1024, sb = b % 1024, swz = sb ^ (((sb >> 9) & 1) << 5); R = (st >> 1) * 16 + swz / 64; C = (st & 1) * 32 + (swz % 64) / 2; }
__host__ __device__ __forceinline__ int perm32(int rho) { const int n = rho >> 4, i = rho & 15; return 8 * (i >> 2) + 4 * n + (i & 3); }

struct Unit { int pm, pn; };
struct Gemm { const bf16_t* A; const bf16_t* Bt; int M, N, K; };

struct StaticOrder {
    int nM, nN, nwg, G, c;
    __host__ __device__ void init(int M, int N, int G_, int c_) { nM = M / BM; nN = N / BM; nwg = nM * nN; G = G_; c = c_; }
    __host__ __device__ bool next(int i, Unit& u) const {
        const long L = (long)i * G + c; if (L >= nwg) return false;
        int wgid = (int)L; { const int q = nwg / NXCD, r = nwg % NXCD, xcd = wgid % NXCD, off = wgid / NXCD; wgid = (xcd < r ? xcd * (q + 1) : r * (q + 1) + (xcd - r) * q) + off; }
        const int nig = WGM * nN, gid = wgid / nig, fm = gid * WGM, gsz = (nM - fm) < WGM ? (nM - fm) : WGM;
        u.pm = fm + ((wgid % nig) % gsz); u.pn = (wgid % nig) / gsz; return true;
    }
    __device__ __forceinline__ void a_ready(const Unit&) const {}
    __device__ __forceinline__ void done(const Unit&) const {}
};

__device__ __forceinline__ unsigned cvt_pk_bf16(float lo, float hi) { unsigned r; asm volatile("v_cvt_pk_bf16_f32 %0, %1, %2" : "=v"(r) : "v"(lo), "v"(hi)); return r; }
template <class Epi, class Sched, bool ALIGN_EPI = false, bool SP2 = false>
__device__ __forceinline__ void gemm_phase(PG8_LAS unsigned char* lds, const Gemm g, const Sched& S, const Epi& E) {
    const int tid = threadIdx.x, wid = __builtin_amdgcn_readfirstlane(tid >> 6), lane = tid & 63, wr = wid >> 2, wc = wid & 3, fr = lane & 15, fq = lane >> 4;
    const int K = g.K, nt = K / BK;
    unsigned voffA[2], voffB[2];
#pragma unroll
    for (int i = 0; i < 2; ++i) { int R, C; stage_rc(tid * 16 + i * 8192, R, C); const int Rb = Epi::PERM ? ((R & ~31) + perm32(R & 31)) : R;
        voffA[i] = (unsigned)(R * K + C) * 2u; voffB[i] = (unsigned)(Rb * K + C) * 2u; }
    const size_t kstep = (size_t)(BK * 2);
    const size_t hstep = (size_t)HALF * K * 2;
    const size_t tstep = 2 * hstep;
    const unsigned ldsw = (unsigned)wid * 1024u;
    const int aoff = lds_byte(wr * 64 + fr, fq * 8), boff = lds_byte(wc * 32 + fr, fq * 8);
#define PG8_SA(b, h) (((b) * 2 + (h)) * HTB)
#define PG8_SB(b, h) ((4 + (b) * 2 + (h)) * HTB)
#define PG8_STAGE(bufoff, gbase, voff) do { _Pragma("unroll") for (int _i = 0; _i < 2; ++_i) \
        __builtin_amdgcn_global_load_lds((const unsigned*)((const char*)(gbase) + (voff)[_i]), (PG8_LAS unsigned*)(lds + (bufoff) + ldsw + _i * 8192), 16, 0, 0); } while (0)
#define PG8_LDA(dst, b, h) do { _Pragma("unroll") for (int m = 0; m < 4; ++m) _Pragma("unroll") for (int k = 0; k < 2; ++k) dst[m][k] = *(const PG8_LAS bf16x8*)(lds + PG8_SA(b, h) + aoff + m * 2048 + k * 1024); } while (0)
#define PG8_LDB(dst, b, h) do { _Pragma("unroll") for (int n = 0; n < 2; ++n) _Pragma("unroll") for (int k = 0; k < 2; ++k) dst[n][k] = *(const PG8_LAS bf16x8*)(lds + PG8_SB(b, h) + boff + n * 2048 + k * 1024); } while (0)
#define PG8_MMA(ai, bj, At, Bt) do { __builtin_amdgcn_s_setprio(1); _Pragma("unroll") for (int m = 0; m < 4; ++m) _Pragma("unroll") for (int n = 0; n < 2; ++n) _Pragma("unroll") for (int k = 0; k < 2; ++k) \
        acc[ai][bj][m][n] = __builtin_amdgcn_mfma_f32_16x16x32_bf16(Bt[n][k], At[m][k], acc[ai][bj][m][n], 0, 0, 0); __builtin_amdgcn_s_setprio(0); } while (0)
#define PG8_WAIT_V(n) asm volatile("s_waitcnt vmcnt(" #n ")" ::: "memory")
#define PG8_WAIT_L(n) asm volatile("s_waitcnt lgkmcnt(" #n ")" ::: "memory")
#define PG8_BAR __builtin_amdgcn_s_barrier()
#define PG8_SCHED __builtin_amdgcn_sched_barrier(0)
    Unit cur, nxt; int ui = 0;
    if (!S.next(0, cur)) return;
    f32x4 acc[2][2][4][2];
#pragma unroll
    for (int a = 0; a < 2; ++a)
#pragma unroll
        for (int b = 0; b < 2; ++b)
#pragma unroll
            for (int m = 0; m < 4; ++m)
#pragma unroll
                for (int n = 0; n < 2; ++n) acc[a][b][m][n] = (f32x4){0.f, 0.f, 0.f, 0.f};
    bf16x8 At[4][2], B0[2][2], B1[2][2];
    const char* cA = (const char*)g.A + (size_t)cur.pm * tstep; const char* cB = (const char*)g.Bt + (size_t)cur.pn * tstep;
    S.a_ready(cur);
    if constexpr (SP2) {
        PG8_STAGE(PG8_SB(0, 0), cB, voffB); PG8_STAGE(PG8_SB(0, 1), cB + hstep, voffB); PG8_STAGE(PG8_SA(0, 0), cA, voffA); PG8_STAGE(PG8_SA(0, 1), cA + hstep, voffA);
        if (wr == 1) PG8_BAR;
        PG8_WAIT_V(2); PG8_BAR;
        PG8_STAGE(PG8_SB(1, 0), cB + kstep, voffB); PG8_STAGE(PG8_SA(1, 0), cA + kstep, voffA); PG8_STAGE(PG8_SB(1, 1), cB + hstep + kstep, voffB);
        PG8_WAIT_V(6); PG8_BAR;
    } else {
        PG8_STAGE(PG8_SB(0, 0), cB, voffB); PG8_STAGE(PG8_SA(0, 0), cA, voffA); PG8_STAGE(PG8_SB(0, 1), cB + hstep, voffB); PG8_STAGE(PG8_SA(0, 1), cA + hstep, voffA);
        if (wr == 1) PG8_BAR;
        PG8_WAIT_V(4); PG8_BAR;
        PG8_STAGE(PG8_SB(1, 0), cB + kstep, voffB); PG8_STAGE(PG8_SA(1, 0), cA + kstep, voffA); PG8_STAGE(PG8_SB(1, 1), cB + hstep + kstep, voffB);
        PG8_WAIT_V(6); PG8_BAR;
    }
    for (;;) {
        const bool has_next = S.next(ui + 1, nxt);
        const char* nA = has_next ? (const char*)g.A + (size_t)nxt.pm * tstep : cA; const char* nB = has_next ? (const char*)g.Bt + (size_t)nxt.pn * tstep : cB;
        for (int t = 0; t < nt; t += 2) {
            const bool last = (t == nt - 2);
            const char* a1 = cA + (size_t)(t + 1) * kstep;
            const char* a2 = last ? nA : cA + (size_t)(t + 2) * kstep; const char* b2 = last ? nB : cB + (size_t)(t + 2) * kstep;
            const char* a3 = a2 + kstep; const char* b3 = b2 + kstep;
            if (last && has_next) S.a_ready(nxt);
            if constexpr (SP2) {
            PG8_LDB(B0, 0, 0); PG8_LDB(B1, 0, 1); PG8_SCHED; PG8_LDA(At, 0, 0); PG8_STAGE(PG8_SA(1, 1), a1 + hstep, voffA);
            PG8_WAIT_V(8); PG8_WAIT_L(0); PG8_BAR; PG8_MMA(0, 0, At, B0); PG8_MMA(0, 1, At, B1); PG8_BAR; PG8_SCHED;
            PG8_LDA(At, 0, 1); PG8_STAGE(PG8_SB(0, 0), b2, voffB); PG8_STAGE(PG8_SB(0, 1), b2 + hstep, voffB); PG8_STAGE(PG8_SA(0, 0), a2, voffA);
            PG8_WAIT_V(8); PG8_WAIT_L(0); PG8_BAR; PG8_MMA(1, 0, At, B0); PG8_MMA(1, 1, At, B1); PG8_BAR; PG8_SCHED;
            PG8_LDB(B0, 1, 0); PG8_LDB(B1, 1, 1); PG8_SCHED; PG8_LDA(At, 1, 0); PG8_STAGE(PG8_SA(0, 1), a2 + hstep, voffA);
            PG8_WAIT_V(8); PG8_WAIT_L(0); PG8_BAR; PG8_MMA(0, 0, At, B0); PG8_MMA(0, 1, At, B1); PG8_BAR; PG8_SCHED;
            PG8_LDA(At, 1, 1); PG8_STAGE(PG8_SB(1, 0), b3, voffB); PG8_STAGE(PG8_SB(1, 1), b3 + hstep, voffB); PG8_STAGE(PG8_SA(1, 0), a3, voffA);
            PG8_WAIT_V(8); PG8_WAIT_L(0); PG8_BAR; PG8_MMA(1, 0, At, B0); PG8_MMA(1, 1, At, B1); PG8_BAR; PG8_SCHED;
            } else {
            PG8_LDB(B0, 0, 0); PG8_SCHED; PG8_LDA(At, 0, 0); PG8_STAGE(PG8_SA(1, 1), a1 + hstep, voffA);
            PG8_WAIT_L(8); PG8_BAR; PG8_WAIT_L(0); PG8_MMA(0, 0, At, B0); PG8_BAR; PG8_SCHED;
            PG8_LDB(B1, 0, 1); PG8_STAGE(PG8_SB(0, 0), b2, voffB);
            PG8_BAR; PG8_WAIT_L(0); PG8_MMA(0, 1, At, B1); PG8_BAR;
            PG8_LDA(At, 0, 1); PG8_STAGE(PG8_SA(0, 0), a2, voffA);
            PG8_BAR; PG8_WAIT_L(0); PG8_MMA(1, 0, At, B0); PG8_BAR; PG8_SCHED;
            PG8_STAGE(PG8_SB(0, 1), b2 + hstep, voffB);
            PG8_WAIT_V(6); PG8_BAR; PG8_MMA(1, 1, At, B1); PG8_BAR;
            PG8_LDB(B0, 1, 0); PG8_SCHED; PG8_LDA(At, 1, 0); PG8_STAGE(PG8_SA(0, 1), a2 + hstep, voffA);
            PG8_WAIT_L(8); PG8_BAR; PG8_WAIT_L(0); PG8_MMA(0, 0, At, B0); PG8_BAR; PG8_SCHED;
            PG8_LDB(B1, 1, 1); PG8_STAGE(PG8_SB(1, 0), b3, voffB);
            PG8_BAR; PG8_WAIT_L(0); PG8_MMA(0, 1, At, B1); PG8_BAR;
            PG8_LDA(At, 1, 1); PG8_STAGE(PG8_SA(1, 0), a3, voffA);
            PG8_BAR; PG8_WAIT_L(0); PG8_MMA(1, 0, At, B0); PG8_BAR; PG8_SCHED;
            PG8_STAGE(PG8_SB(1, 1), b3 + hstep, voffB);
            PG8_WAIT_V(6); PG8_BAR; PG8_MMA(1, 1, At, B1); PG8_BAR;
            }
        }
        if constexpr (ALIGN_EPI) { if (wr == 0) PG8_BAR; }
        if constexpr (!Epi::AFTER_DRAIN) { E(acc, cur, wr, wc, fr, fq); S.done(cur); }
        if (!has_next) break;
#pragma unroll
        for (int a = 0; a < 2; ++a)
#pragma unroll
            for (int b = 0; b < 2; ++b)
#pragma unroll
                for (int m = 0; m < 4; ++m)
#pragma unroll
                    for (int n = 0; n < 2; ++n) acc[a][b][m][n] = (f32x4){0.f, 0.f, 0.f, 0.f};
        cur = nxt; cA = nA; cB = nB; ++ui;
        if constexpr (ALIGN_EPI) { if (wr == 1) PG8_BAR; }
    }
    PG8_WAIT_V(0);
    if constexpr (!ALIGN_EPI) { if (wr == 0) PG8_BAR; }
    PG8_BAR;
    if constexpr (Epi::AFTER_DRAIN) { E.fused(acc, cur, wr, wc, fr, fq, lds, wid, lane); S.done(cur); }
#undef PG8_SA
#undef PG8_SB
#undef PG8_STAGE
#undef PG8_LDA
#undef PG8_LDB
#undef PG8_MMA
#undef PG8_WAIT_V
#undef PG8_WAIT_L
#undef PG8_BAR
#undef PG8_SCHED
}
}

constexpr int SEQ = 4096, NB = 2, T_ = NB * SEQ, DM = 2048, INW = 6176, FF = 5632;
constexpr int AH = 16, AD = 64, AW = 1024;
constexpr int GH = 4, GDK = 128, GDV = 256, GKW = 512, GVW = 1024, GRANK = 16;
constexpr float NORM_EPS = 1e-6f;
constexpr float LOG2E = 1.4426950408889634f;
constexpr int NWAVES = 8;
constexpr int NPHASE = 9;
#ifndef PROBE_PREFIX
#define PROBE_PREFIX 0
#endif
#ifndef MK_LAUNCHES
#define MK_LAUNCHES 1
#endif

constexpr size_t MiB = 1u << 20;
constexpr size_t WS_CTL = 0;
constexpr size_t WS_BIAS2 = 64 * 1024;
constexpr size_t WS_SSQ1 = 128 * 1024;
constexpr size_t WS_WIN = 1 * MiB;
constexpr size_t WS_WOUT = 26 * MiB;
constexpr size_t WS_WGU = 34 * MiB;
constexpr size_t WS_WDN = 78 * MiB;
constexpr size_t WS_XN = 100 * MiB;
constexpr size_t WS_RB = 132 * MiB;
constexpr size_t WS_END = 229 * MiB;
constexpr size_t E_AQ = 0, E_AK = (size_t)T_ * 1024, E_AV = 2 * (size_t)T_ * 1024, E_GQ = 3 * (size_t)T_ * 1024, E_GK = E_GQ + (size_t)T_ * 512,
                 E_GVT = 4 * (size_t)T_ * 1024, E_GR = 5 * (size_t)T_ * 1024, E_GLR = 6 * (size_t)T_ * 1024;

#define GAS __attribute__((address_space(1)))
#define LAS __attribute__((address_space(3)))
typedef unsigned short bf16;
typedef unsigned v4u __attribute__((ext_vector_type(4)));
typedef unsigned v2u __attribute__((ext_vector_type(2)));
typedef float f32x4 __attribute__((ext_vector_type(4)));
#define LDS_WAIT() asm volatile("s_waitcnt lgkmcnt(0)" ::: "memory")
__device__ __forceinline__ unsigned f2bf(float f) { unsigned u = __builtin_bit_cast(unsigned, f); return (u + 0x7fffu + ((u >> 16) & 1u)) >> 16; }
__device__ __forceinline__ unsigned pk2(float lo, float hi) { return f2bf(lo) | (f2bf(hi) << 16); }
__device__ __forceinline__ float bf2f(unsigned b) { return __builtin_bit_cast(float, b << 16); }
__device__ __forceinline__ float bflo(unsigned w) { return __builtin_bit_cast(float, w << 16); }
__device__ __forceinline__ float bfhi(unsigned w) { return __builtin_bit_cast(float, w & 0xffff0000u); }
__device__ __forceinline__ float wave_sum(float v) {
#pragma unroll
    for (int o = 1; o < 64; o <<= 1) v += __shfl_xor(v, o);
    return v;
}
__device__ __forceinline__ float wave_max(float v) {
#pragma unroll
    for (int o = 1; o < 64; o <<= 1) v = fmaxf(v, __shfl_xor(v, o));
    return v;
}

namespace pg8 {
struct EpiProj {
    static constexpr bool PERM = true, AFTER_DRAIN = false;
    bf16_t* rb;
    __device__ __forceinline__ void operator()(const f32x4 (&acc)[2][2][4][2], const Unit& u, int wr, int wc, int fr, int fq) const {
        const int pn = u.pn; bf16_t* base; int ldc, colt;
        if (pn < 12) { base = rb + (size_t)(pn >> 2) * ((size_t)T_ * 1024); ldc = 1024; colt = (pn & 3) * 256; }
        else if (pn < 16) { base = rb + E_GQ + (size_t)((pn - 12) >> 1) * ((size_t)T_ * 512); ldc = 512; colt = ((pn - 12) & 1) * 256; }
        else { base = rb + E_GR; ldc = 1024; colt = (pn - 16) * 256; }
        const int row0 = u.pm * BM + wr * 64 + fr, col0 = colt + wc * 32 + 8 * fq;
#pragma unroll
        for (int ai = 0; ai < 2; ++ai)
#pragma unroll
            for (int m = 0; m < 4; ++m) { bf16_t* rowp = base + (size_t)(row0 + ai * HALF + m * 16) * ldc + col0;
#pragma unroll
                for (int bj = 0; bj < 2; ++bj) { const f32x4 v0 = acc[ai][bj][m][0], v1 = acc[ai][bj][m][1];
                    u32x4 w; w.x = cvt_pk_bf16(v0[0], v0[1]); w.y = cvt_pk_bf16(v0[2], v0[3]); w.z = cvt_pk_bf16(v1[0], v1[1]); w.w = cvt_pk_bf16(v1[2], v1[3]);
                    *(u32x4*)(rowp + bj * HALF) = w; } }
    }
};
struct EpiPlain {
    static constexpr bool PERM = true, AFTER_DRAIN = false;
    bf16_t* O; int ldc;
    __device__ __forceinline__ void operator()(const f32x4 (&acc)[2][2][4][2], const Unit& u, int wr, int wc, int fr, int fq) const {
        const int row0 = u.pm * BM + wr * 64 + fr, col0 = u.pn * BM + wc * 32 + 8 * fq;
#pragma unroll
        for (int ai = 0; ai < 2; ++ai)
#pragma unroll
            for (int m = 0; m < 4; ++m) { bf16_t* rowp = O + (size_t)(row0 + ai * HALF + m * 16) * ldc + col0;
#pragma unroll
                for (int bj = 0; bj < 2; ++bj) { const f32x4 v0 = acc[ai][bj][m][0], v1 = acc[ai][bj][m][1];
                    u32x4 w; w.x = cvt_pk_bf16(v0[0], v0[1]); w.y = cvt_pk_bf16(v0[2], v0[3]); w.z = cvt_pk_bf16(v1[0], v1[1]); w.w = cvt_pk_bf16(v1[2], v1[3]);
                    *(u32x4*)(rowp + bj * HALF) = w; } }
    }
};
template <bool AUX> struct EpiRes {
    static constexpr bool PERM = false, AFTER_DRAIN = true;
    const float* base; float* out; bf16_t* xb; float* ssq;
    __device__ __forceinline__ void fused(f32x4 (&acc)[2][2][4][2], const Unit& u, int wr, int wc, int fr, int fq, PG8_LAS unsigned char* lds, int wid, int lane) const {
        PG8_LAS float* P = (PG8_LAS float*)lds;
        const int col0 = u.pn * BM + wc * 32 + 4 * fq;
#pragma unroll
        for (int ai = 0; ai < 2; ++ai)
#pragma unroll
            for (int m = 0; m < 4; ++m) { const int rl = ai * HALF + wr * 64 + m * 16 + fr; const size_t off = (size_t)(u.pm * BM + rl) * DM + col0; float s = 0.f;
#pragma unroll
                for (int bj = 0; bj < 2; ++bj)
#pragma unroll
                    for (int n = 0; n < 2; ++n) { const f32x4 bs = *(const f32x4*)(base + off + bj * HALF + n * 16); const f32x4 v = bs + acc[ai][bj][m][n];
                        *(f32x4*)(out + off + bj * HALF + n * 16) = v;
                        if (AUX) { s += (v[0] * v[0] + v[1] * v[1]) + (v[2] * v[2] + v[3] * v[3]);
                            typedef unsigned u32x2 __attribute__((ext_vector_type(2))); u32x2 w; w.x = cvt_pk_bf16(v[0], v[1]); w.y = cvt_pk_bf16(v[2], v[3]);
                            *(u32x2*)(xb + off + bj * HALF + n * 16) = w; } }
                if (AUX) { s += __shfl_xor(s, 16); s += __shfl_xor(s, 32); if (fq == 0) P[rl * 4 + wc] = s; }
            }
        if (AUX) {
            asm volatile("s_waitcnt lgkmcnt(0)" ::: "memory"); __builtin_amdgcn_s_barrier(); asm volatile("" ::: "memory");
            const int tid = wid * 64 + lane;
            if (tid < 256) { const float s = (P[tid * 4 + 0] + P[tid * 4 + 1]) + (P[tid * 4 + 2] + P[tid * 4 + 3]); ssq[(size_t)(u.pm * BM + tid) * 8 + u.pn] = s; }
        }
    }
};
struct EpiSwiglu {
    static constexpr bool PERM = true, AFTER_DRAIN = false;
    bf16_t* H; const float* ssq;
    __device__ __forceinline__ void operator()(const f32x4 (&acc)[2][2][4][2], const Unit& u, int wr, int wc, int fr, int fq) const {
        const int row0 = u.pm * BM + wr * 64 + fr, col0 = u.pn * HALF + wc * 32 + 8 * fq;
#pragma unroll
        for (int ai = 0; ai < 2; ++ai)
#pragma unroll
            for (int m = 0; m < 4; ++m) { const int r = row0 + ai * HALF + m * 16;
                const f32x4 s0 = *(const f32x4*)(ssq + (size_t)r * 8), s1 = *(const f32x4*)(ssq + (size_t)r * 8 + 4);
                const float tot = ((s0[0] + s0[1]) + (s0[2] + s0[3])) + ((s1[0] + s1[1]) + (s1[2] + s1[3]));
                const float rstd = rsqrtf(tot * (1.0f / DM) + NORM_EPS);
                float hv[8];
#pragma unroll
                for (int n = 0; n < 2; ++n)
#pragma unroll
                    for (int i = 0; i < 4; ++i) { const float g = acc[ai][0][m][n][i] * rstd, up = acc[ai][1][m][n][i] * rstd; hv[n * 4 + i] = g / (1.0f + __expf(-g)) * up; }
                u32x4 w; w.x = cvt_pk_bf16(hv[0], hv[1]); w.y = cvt_pk_bf16(hv[2], hv[3]); w.z = cvt_pk_bf16(hv[4], hv[5]); w.w = cvt_pk_bf16(hv[6], hv[7]);
                *(u32x4*)(H + (size_t)r * FF + col0) = w; }
    }
};
}

constexpr int RING_BYTES = 131072;
constexpr int LDS_BYTES = 147456;
struct Args { const float* in[15]; float* out; unsigned char* ws; int ph_lo, ph_hi; };
typedef short bf16x8 __attribute__((ext_vector_type(8)));
typedef float f32x16 __attribute__((ext_vector_type(16)));
__device__ __forceinline__ int crow(int r, int hi) { return (r & 3) + 8 * (r >> 2) + 4 * hi; }
typedef float f32x2_t __attribute__((ext_vector_type(2))); typedef __bf16 bf16x2_t __attribute__((ext_vector_type(2)));
__device__ __forceinline__ unsigned cvtpk(float lo, float hi) { f32x2_t v = {lo, hi}; bf16x2_t b = __builtin_convertvector(v, bf16x2_t); return __builtin_bit_cast(unsigned, b); }
template <int S> __device__ __forceinline__ bf16x8 pack8(const f32x16& a) {
    v4u w; w.x = cvtpk(a[8 * S + 0], a[8 * S + 1]); w.y = cvtpk(a[8 * S + 2], a[8 * S + 3]); w.z = cvtpk(a[8 * S + 4], a[8 * S + 5]); w.w = cvtpk(a[8 * S + 6], a[8 * S + 7]);
    return __builtin_bit_cast(bf16x8, w);
}
__device__ __forceinline__ bf16x8 join8(v2u lo, v2u hi) { v4u w; w.x = lo.x; w.y = lo.y; w.z = hi.x; w.w = hi.y; return __builtin_bit_cast(bf16x8, w); }
#define MFMA32(a, b, c) __builtin_amdgcn_mfma_f32_32x32x16_bf16((a), (b), (c), 0, 0, 0)
#define WG_BAR() do { asm volatile("s_waitcnt lgkmcnt(0)" ::: "memory"); __builtin_amdgcn_s_barrier(); asm volatile("" ::: "memory"); } while (0)

__device__ __forceinline__ void p0_item(const float* __restrict__ W, int K, int N, bf16* WT, int k0, int n0, int drow0, const float* __restrict__ kscale, float nscale, LAS float* scr, int lane) {
#pragma unroll 8
    for (int i = 0; i < 32; ++i) { const int kk = 2 * i + (lane >> 5); float v = W[(size_t)(k0 + kk) * N + n0 + (lane & 31)]; if (kscale) v *= kscale[k0 + kk]; scr[kk * 33 + (lane & 31)] = v * nscale; }
    LDS_WAIT(); asm volatile("" ::: "memory");
    const int c = lane & 7;
#pragma unroll
    for (int j = 0; j < 4; ++j) { const int n = (lane >> 3) + 8 * j; const LAS float* s = scr + (8 * c) * 33 + n;
        v4u o; o.x = pk2(s[0 * 33], s[1 * 33]); o.y = pk2(s[2 * 33], s[3 * 33]); o.z = pk2(s[4 * 33], s[5 * 33]); o.w = pk2(s[6 * 33], s[7 * 33]);
        *(v4u*)(WT + (size_t)(drow0 + n) * K + k0 + 8 * c) = o; }
    LDS_WAIT(); asm volatile("" ::: "memory");
}

__device__ __forceinline__ int t5_bucket(int rel) {
    const int nb = 16, max_exact = 8; int ret = rel > 0 ? nb : 0; const int n = rel < 0 ? -rel : rel;
    if (n < max_exact) return ret + n;
    int large = max_exact + (int)(log((double)n / (double)max_exact) / log(1024.0 / 8.0) * (double)(nb - max_exact));
    if (large > nb - 1) large = nb - 1;
    return ret + large;
}
__device__ __forceinline__ float logsig16(float z) { return (fminf(z, 0.f) - log1pf(__expf(-fabsf(z)))) * (1.0f / 16.0f); }

struct GlaBufs { const bf16* GQ; const bf16* GK; const bf16* GVT; const float* GLR; bf16* QINF; bf16* QINB; bf16* KETF; bf16* KETB; float* DECF; float* DECB; bf16* OI; bf16* OSF; bf16* OSB;
                 const float* gwF; const float* gbF; const float* gwB; const float* gbB; };
constexpr int GP = 136;
__device__ __forceinline__ f32x16 gla_xtile(const LAS bf16* Ks, const LAS bf16* Qs, int jt, int ct, int l31, int hi) {
    f32x16 acc = {};
    const LAS bf16* kp = Ks + (32 * jt + l31) * GP + 8 * hi; const LAS bf16* qp = Qs + (32 * ct + l31) * GP + 8 * hi;
#pragma unroll
    for (int d0 = 0; d0 < 8; ++d0) { const bf16x8 a = *(const LAS bf16x8*)(kp + 16 * d0); const bf16x8 b = *(const LAS bf16x8*)(qp + 16 * d0); acc = MFMA32(a, b, acc); }
    return acc;
}
__device__ __forceinline__ void gla_unit(int unit, const GlaBufs& B, LAS unsigned char* lds, int tid, int lane, int wave) {
    const int n = unit & 63, h = (unit >> 6) & 3, b = unit >> 8;
    const size_t row0 = (size_t)b * SEQ + 64 * n;
    LAS bf16* QF = (LAS bf16*)lds; LAS bf16* KF = QF + 64 * GP; LAS bf16* QB = KF + 64 * GP; LAS bf16* KB = QB + 64 * GP;
    LAS float* PS = (LAS float*)(lds + 69632);
    LAS float* LR = (LAS float*)(lds + 73728);
    WG_BAR();
    ((LAS f32x4*)LR)[tid] = ((const f32x4*)(B.GLR + row0 * 32))[tid];
    const int d = tid & 127, cgrp = tid >> 7, col = h * 128 + d;
    float gwf[16], gwb[16];
#pragma unroll
    for (int r = 0; r < 16; ++r) { gwf[r] = B.gwF[r * GKW + col]; gwb[r] = B.gwB[r * GKW + col]; }
    const float gbf = B.gbF[col], gbb = B.gbB[col];
    WG_BAR();
    float laf[16], lab[16];
#pragma unroll
    for (int cc = 0; cc < 16; ++cc) { const int c = cgrp * 16 + cc; float zf = gbf, zb = gbb;
#pragma unroll
        for (int r4 = 0; r4 < 4; ++r4) { const f32x4 a = *(const LAS f32x4*)(LR + c * 32 + 4 * r4), e = *(const LAS f32x4*)(LR + c * 32 + 16 + 4 * r4);
#pragma unroll
            for (int i = 0; i < 4; ++i) { zf += a[i] * gwf[4 * r4 + i]; zb += e[i] * gwb[4 * r4 + i]; } }
        laf[cc] = logsig16(zf); lab[cc] = logsig16(zb); }
#pragma unroll
    for (int cc = 1; cc < 16; ++cc) laf[cc] += laf[cc - 1];
#pragma unroll
    for (int cc = 14; cc >= 0; --cc) lab[cc] += lab[cc + 1];
    PS[cgrp * 128 + d] = laf[15]; PS[(4 + cgrp) * 128 + d] = lab[0];
    WG_BAR();
    float offf = 0.f, offb = 0.f, totf = 0.f, totb = 0.f;
#pragma unroll
    for (int g = 0; g < 4; ++g) { const float pf = PS[g * 128 + d], pb = PS[(4 + g) * 128 + d]; totf += pf; totb += pb; if (g < cgrp) offf += pf; if (g > cgrp) offb += pb; }
    float kef[16], keb[16];
#pragma unroll
    for (int cc = 0; cc < 16; ++cc) { const int c = cgrp * 16 + cc; const size_t row = row0 + c;
        const float Gf = laf[cc] + offf, Gb = lab[cc] + offb;
        const float q = bf2f(B.GQ[row * GKW + col]), k = bf2f(B.GK[row * GKW + col]);
        const float qf = q * __expf(Gf), kf = k * __expf(-Gf), qb = q * __expf(Gb), kb = k * __expf(-Gb);
        kef[cc] = k * __expf(totf - Gf); keb[cc] = k * __expf(totb - Gb);
        const bf16 qfh = (bf16)f2bf(qf), qbh = (bf16)f2bf(qb);
        QF[c * GP + d] = qfh; KF[c * GP + d] = (bf16)f2bf(kf); QB[c * GP + d] = qbh; KB[c * GP + d] = (bf16)f2bf(kb);
        B.QINF[row * GKW + col] = qfh; B.QINB[row * GKW + col] = qbh; }
    { v4u w0, w1; bf16* dst = B.KETF + (size_t)col * T_ + row0 + cgrp * 16;
      w0.x = pk2(kef[0], kef[1]); w0.y = pk2(kef[2], kef[3]); w0.z = pk2(kef[4], kef[5]); w0.w = pk2(kef[6], kef[7]);
      w1.x = pk2(kef[8], kef[9]); w1.y = pk2(kef[10], kef[11]); w1.z = pk2(kef[12], kef[13]); w1.w = pk2(kef[14], kef[15]);
      ((v4u*)dst)[0] = w0; ((v4u*)dst)[1] = w1;
      dst = B.KETB + (size_t)col * T_ + row0 + cgrp * 16;
      w0.x = pk2(keb[0], keb[1]); w0.y = pk2(keb[2], keb[3]); w0.z = pk2(keb[4], keb[5]); w0.w = pk2(keb[6], keb[7]);
      w1.x = pk2(keb[8], keb[9]); w1.y = pk2(keb[10], keb[11]); w1.z = pk2(keb[12], keb[13]); w1.w = pk2(keb[14], keb[15]);
      ((v4u*)dst)[0] = w0; ((v4u*)dst)[1] = w1; }
    if (cgrp == 0) { B.DECF[(size_t)(b * 64 + n) * GKW + col] = __expf(totf); B.DECB[(size_t)(b * 64 + n) * GKW + col] = __expf(totb); }
    WG_BAR();
    const int l31 = lane & 31, hi = lane >> 5;
    bf16x8 vt[2][2];
    { const bf16* vbase = B.GVT + (size_t)(h * 256 + 32 * wave + l31) * T_ + row0 + 4 * hi;
#pragma unroll
      for (int jt = 0; jt < 2; ++jt)
#pragma unroll
          for (int s = 0; s < 2; ++s) { const bf16* p = vbase + 32 * jt + 16 * s; vt[jt][s] = join8(*(const v2u*)p, *(const v2u*)(p + 8)); } }
    f32x16 o0 = {}, o1 = {};
    {
        f32x16 X = gla_xtile(KF, QF, 0, 0, l31, hi);
#pragma unroll
        for (int r = 0; r < 16; ++r) if (crow(r, hi) > l31) X[r] = 0.f;
        o0 = MFMA32(vt[0][0], pack8<0>(X), o0); o0 = MFMA32(vt[0][1], pack8<1>(X), o0);
        X = gla_xtile(KF, QF, 0, 1, l31, hi);
        o1 = MFMA32(vt[0][0], pack8<0>(X), o1); o1 = MFMA32(vt[0][1], pack8<1>(X), o1);
        X = gla_xtile(KF, QF, 1, 1, l31, hi);
#pragma unroll
        for (int r = 0; r < 16; ++r) if (crow(r, hi) > l31) X[r] = 0.f;
        o1 = MFMA32(vt[1][0], pack8<0>(X), o1); o1 = MFMA32(vt[1][1], pack8<1>(X), o1);
    }
    {
        f32x16 X = gla_xtile(KB, QB, 0, 0, l31, hi);
#pragma unroll
        for (int r = 0; r < 16; ++r) if (crow(r, hi) < l31) X[r] = 0.f;
        o0 = MFMA32(vt[0][0], pack8<0>(X), o0); o0 = MFMA32(vt[0][1], pack8<1>(X), o0);
        X = gla_xtile(KB, QB, 1, 0, l31, hi);
        o0 = MFMA32(vt[1][0], pack8<0>(X), o0); o0 = MFMA32(vt[1][1], pack8<1>(X), o0);
        X = gla_xtile(KB, QB, 1, 1, l31, hi);
#pragma unroll
        for (int r = 0; r < 16; ++r) if (crow(r, hi) < l31) X[r] = 0.f;
        o1 = MFMA32(vt[1][0], pack8<0>(X), o1); o1 = MFMA32(vt[1][1], pack8<1>(X), o1);
    }
    { bf16* ob = B.OI + (row0 + l31) * GVW + h * 256 + 32 * wave + 4 * hi;
#pragma unroll
      for (int g = 0; g < 4; ++g) { v2u w; w.x = cvtpk(o0[4 * g], o0[4 * g + 1]); w.y = cvtpk(o0[4 * g + 2], o0[4 * g + 3]); *(v2u*)(ob + 8 * g) = w;
          v2u w1; w1.x = cvtpk(o1[4 * g], o1[4 * g + 1]); w1.y = cvtpk(o1[4 * g + 2], o1[4 * g + 3]); *(v2u*)(ob + (size_t)32 * GVW + 8 * g) = w1; } }
}

constexpr int SC_Q = 0, SC_K = 17408, SC_V = 35840, SC_D = 54272, SC_STAGE = 54784;
struct ScanRegs { v4u q[8], k[8], v[8]; f32x4 d; };
__device__ __forceinline__ void gla_scan(int item, const GlaBufs& B, LAS unsigned char* lds, int tid, int lane, int wave) {
    const int half = item & 1, dir = (item >> 1) & 1, h = (item >> 2) & 3, b = item >> 4;
    const bf16* QIN = dir ? B.QINB : B.QINF; const bf16* KET = dir ? B.KETB : B.KETF; const float* DEC = dir ? B.DECB : B.DECF;
    bf16* OS = dir ? B.OSB : B.OSF;
    const int l31 = lane & 31, hi = lane >> 5;
    const int par = (wave >> 1) & 1, sub = wave & 1, pl = 64 * sub + lane;
    const bool loader = wave >= 4;
#define SC_CHUNK(st) (dir ? 63 - (st) : (st))
#define SC_LOAD(R, st) do { const int nn_ = SC_CHUNK(st); const size_t r0_ = (size_t)b * SEQ + 64 * nn_; \
        _Pragma("unroll") for (int i_ = 0; i_ < 8; ++i_) { const int pp_ = pl + 128 * i_; \
            R.q[i_] = *(const v4u*)(QIN + (r0_ + (pp_ >> 4)) * GKW + h * 128 + (pp_ & 15) * 8); \
            R.k[i_] = *(const v4u*)(KET + (size_t)(h * 128 + (pp_ >> 3)) * T_ + r0_ + (pp_ & 7) * 8); \
            R.v[i_] = *(const v4u*)(B.GVT + (size_t)(h * 256 + 128 * half + (pp_ >> 3)) * T_ + r0_ + (pp_ & 7) * 8); } \
        if (pl < 32) R.d = *(const f32x4*)(DEC + (size_t)(b * 64 + nn_) * GKW + h * 128 + pl * 4); } while (0)
#define SC_WRITE(R, sg) do { LAS unsigned char* s_ = lds + (sg) * SC_STAGE; \
        _Pragma("unroll") for (int i_ = 0; i_ < 8; ++i_) { const int pp_ = pl + 128 * i_; \
            *(LAS v4u*)(s_ + SC_Q + (pp_ >> 4) * 272 + (pp_ & 15) * 16) = R.q[i_]; \
            *(LAS v4u*)(s_ + SC_K + (pp_ >> 3) * 144 + (pp_ & 7) * 16) = R.k[i_]; \
            *(LAS v4u*)(s_ + SC_V + (pp_ >> 3) * 144 + (pp_ & 7) * 16) = R.v[i_]; } \
        if (pl < 32) *(LAS f32x4*)(s_ + SC_D + pl * 16) = R.d; } while (0)
    WG_BAR();
#define SC_INTER(Sx, dt) do { \
            { const bf16x8 a = pack8<0>(Sx); const bf16x8 b0 = join8(*(const LAS v2u*)(qb0 + (32 * (dt)) * 2), *(const LAS v2u*)(qb0 + (32 * (dt) + 8) * 2)); \
              const bf16x8 b1 = join8(*(const LAS v2u*)(qb1 + (32 * (dt)) * 2), *(const LAS v2u*)(qb1 + (32 * (dt) + 8) * 2)); i0 = MFMA32(a, b0, i0); i1 = MFMA32(a, b1, i1); } \
            { const bf16x8 a = pack8<1>(Sx); const bf16x8 b0 = join8(*(const LAS v2u*)(qb0 + (32 * (dt) + 16) * 2), *(const LAS v2u*)(qb0 + (32 * (dt) + 24) * 2)); \
              const bf16x8 b1 = join8(*(const LAS v2u*)(qb1 + (32 * (dt) + 16) * 2), *(const LAS v2u*)(qb1 + (32 * (dt) + 24) * 2)); i0 = MFMA32(a, b0, i0); i1 = MFMA32(a, b1, i1); } } while (0)
#define SC_UPD(Sx, dt) do { \
            _Pragma("unroll") for (int g = 0; g < 4; ++g) { const f32x4 dv = *(const LAS f32x4*)(sg + SC_D + (32 * (dt) + 8 * g + 4 * hi) * 4); \
                Sx[4 * g] *= dv[0]; Sx[4 * g + 1] *= dv[1]; Sx[4 * g + 2] *= dv[2]; Sx[4 * g + 3] *= dv[3]; } \
            _Pragma("unroll") for (int s = 0; s < 4; ++s) { const bf16x8 a = *(const LAS bf16x8*)(kb_ + (32 * (dt)) * 144 + 32 * s); Sx = MFMA32(a, vf[s], Sx); } } while (0)
    if (loader) {
        ScanRegs R;
        if (par == 0) {
            SC_LOAD(R, 0); SC_WRITE(R, 0); SC_LOAD(R, 2);
            WG_BAR();
            for (int st = 0; st < 64; st += 2) {
                WG_BAR();
                if (st + 2 < 64) SC_WRITE(R, 0);
                if (st + 4 < 64) SC_LOAD(R, st + 4);
                WG_BAR();
            }
        } else {
            SC_LOAD(R, 1);
            WG_BAR();
            for (int st = 0; st < 64; st += 2) {
                SC_WRITE(R, 1);
                if (st + 3 < 64) SC_LOAD(R, st + 3);
                WG_BAR();
                WG_BAR();
            }
        }
    } else {
        f32x16 S0 = {}, S1 = {}, S2 = {}, S3 = {};
        WG_BAR();
        for (int st = 0; st < 64; ++st) {
            const int n = SC_CHUNK(st); const LAS unsigned char* sg = lds + (st & 1) * SC_STAGE;
            f32x16 i0 = {}, i1 = {};
            const LAS unsigned char* qb0 = sg + SC_Q + l31 * 272 + 8 * hi; const LAS unsigned char* qb1 = qb0 + 32 * 272;
            SC_INTER(S0, 0); SC_INTER(S1, 1); SC_INTER(S2, 2); SC_INTER(S3, 3);
            { const size_t e0 = ((size_t)b * SEQ + 64 * n + l31) * GVW + h * 256 + 128 * half + 32 * wave + 4 * hi;
#pragma unroll
              for (int g = 0; g < 4; ++g) {
                  v2u w; w.x = cvtpk(i0[4 * g], i0[4 * g + 1]); w.y = cvtpk(i0[4 * g + 2], i0[4 * g + 3]); *(v2u*)(OS + e0 + 8 * g) = w;
                  v2u w1; w1.x = cvtpk(i1[4 * g], i1[4 * g + 1]); w1.y = cvtpk(i1[4 * g + 2], i1[4 * g + 3]); *(v2u*)(OS + e0 + (size_t)32 * GVW + 8 * g) = w1; } }
            const LAS unsigned char* kb_ = sg + SC_K + l31 * 144 + 16 * hi; const LAS unsigned char* vb_ = sg + SC_V + (32 * wave + l31) * 144 + 16 * hi;
            bf16x8 vf[4];
#pragma unroll
            for (int s = 0; s < 4; ++s) vf[s] = *(const LAS bf16x8*)(vb_ + 32 * s);
            SC_UPD(S0, 0); SC_UPD(S1, 1); SC_UPD(S2, 2); SC_UPD(S3, 3);
            WG_BAR();
        }
    }
#undef SC_INTER
#undef SC_UPD
#undef SC_CHUNK
#undef SC_LOAD
#undef SC_WRITE
}

struct AttnBufs { const bf16* AQ; const bf16* AK; const bf16* AV; const float* BIAS2; bf16* OP; float* LSE; };
constexpr int AT_VP = 784;
constexpr int AT_BT = 64 * AT_VP;
__device__ __forceinline__ void attn_unit(int u, const AttnBufs& A, LAS unsigned char* lds, int tid, int lane, int wave) {
    const int bh = u / 48, w48 = u % 48, p = w48 >> 4, idx = w48 & 15;
    const int b = bh >> 4, h = bh & 15;
    const int r = (p == 0) ? 1 : (p == 1 ? 4 : 16), L = SEQ / r;
    const int j = (p == 0) ? 0 : (p == 1 ? (idx >> 2) : idx), kb = (p == 0) ? idx : (p == 1 ? (idx & 3) : 0);
    const int l31 = lane & 31, hi = lane >> 5;
    const size_t tb = (size_t)b * SEQ;
    WG_BAR();
    for (int e = tid; e < 4 * 196; e += NWAVES * 64) { const int c = e / 196, i = e % 196, dl = i + c - 95;
        float v = -INFINITY; if (dl >= -64 && dl <= 64) v = A.BIAS2[(p * 129 + dl + 64) * 16 + h];
        ((LAS float*)(lds + AT_BT))[e] = v; }
    {
        const int wbase = kb * 256 - 64;
#pragma unroll
        for (int grp = 0; grp < 3; ++grp) { const int kk0 = 2 * (64 * grp + lane); const int sp0 = wbase + kk0, sp1 = sp0 + 1;
            v4u a = {0u, 0u, 0u, 0u}, c2 = {0u, 0u, 0u, 0u};
            if (sp0 >= 0 && sp0 < L) a = *(const v4u*)(A.AV + (tb + (size_t)sp0 * r + j) * AW + h * AD + 8 * wave);
            if (sp1 >= 0 && sp1 < L) c2 = *(const v4u*)(A.AV + (tb + (size_t)sp1 * r + j) * AW + h * AD + 8 * wave);
            const int w16 = kk0 & 15, slot = (kk0 & ~15) | (w16 & 3) | (((w16 >> 3) & 1) << 2) | (((w16 >> 2) & 1) << 3);
            LAS unsigned char* dst = lds + (8 * wave) * AT_VP + slot * 2;
            *(LAS unsigned*)(dst + 0 * AT_VP) = (a.x & 0xffffu) | (c2.x << 16);
            *(LAS unsigned*)(dst + 1 * AT_VP) = (a.x >> 16) | (c2.x & 0xffff0000u);
            *(LAS unsigned*)(dst + 2 * AT_VP) = (a.y & 0xffffu) | (c2.y << 16);
            *(LAS unsigned*)(dst + 3 * AT_VP) = (a.y >> 16) | (c2.y & 0xffff0000u);
            *(LAS unsigned*)(dst + 4 * AT_VP) = (a.z & 0xffffu) | (c2.z << 16);
            *(LAS unsigned*)(dst + 5 * AT_VP) = (a.z >> 16) | (c2.z & 0xffff0000u);
            *(LAS unsigned*)(dst + 6 * AT_VP) = (a.w & 0xffffu) | (c2.w << 16);
            *(LAS unsigned*)(dst + 7 * AT_VP) = (a.w >> 16) | (c2.w & 0xffff0000u); }
    }
    WG_BAR();
    const int i0 = kb * 256 + 32 * wave;
    const size_t tq = tb + (size_t)(i0 + l31) * r + j;
    bf16x8 qf[4];
#pragma unroll
    for (int d0 = 0; d0 < 4; ++d0) qf[d0] = *(const bf16x8*)(A.AQ + tq * AW + h * AD + 16 * d0 + 8 * hi);
    f32x16 S[5];
    const int cshift = 3 - (l31 & 3);
    const LAS unsigned char* btl = lds + AT_BT + cshift * AT_VP + (4 * hi + 28 - 4 * (l31 >> 2)) * 4;
    float m = -INFINITY;
#pragma unroll
    for (int t = 0; t < 5; ++t) { const int sb = i0 - 64 + 32 * t;
        if (sb >= 0 && sb < L) {
            const bf16* kp = A.AK + (tb + (size_t)(sb + l31) * r + j) * AW + h * AD + 8 * hi;
            f32x16 acc = {};
#pragma unroll
            for (int d0 = 0; d0 < 4; ++d0) { const bf16x8 kf = *(const bf16x8*)(kp + 16 * d0); acc = MFMA32(kf, qf[d0], acc); }
#pragma unroll
            for (int g = 0; g < 4; ++g) { const f32x4 bv = *(const LAS f32x4*)(btl + (32 * t + 8 * g) * 4);
#pragma unroll
                for (int i = 0; i < 4; ++i) { acc[4 * g + i] += bv[i]; m = fmaxf(m, acc[4 * g + i]); } }
            S[t] = acc;
        } else {
#pragma unroll
            for (int i = 0; i < 16; ++i) S[t][i] = -INFINITY;
        } }
    m = fmaxf(m, __shfl_xor(m, 32));
    float ssum = 0.f;
#pragma unroll
    for (int t = 0; t < 5; ++t)
#pragma unroll
        for (int i = 0; i < 16; ++i) { const float e = exp2f(S[t][i] - m); S[t][i] = e; ssum += e; }
    ssum += __shfl_xor(ssum, 32);
    f32x16 o0 = {}, o1 = {};
    const LAS unsigned char* vb = lds + l31 * AT_VP + (32 * wave) * 2 + 16 * hi;
#pragma unroll
    for (int t = 0; t < 5; ++t) { const int sb = i0 - 64 + 32 * t;
        if (sb >= 0 && sb < L) {
            const bf16x8 p0 = pack8<0>(S[t]), p1 = pack8<1>(S[t]);
            const bf16x8 v00 = *(const LAS bf16x8*)(vb + (32 * t) * 2), v01 = *(const LAS bf16x8*)(vb + (32 * t + 16) * 2);
            const bf16x8 v10 = *(const LAS bf16x8*)(vb + 32 * AT_VP + (32 * t) * 2), v11 = *(const LAS bf16x8*)(vb + 32 * AT_VP + (32 * t + 16) * 2);
            o0 = MFMA32(v00, p0, o0); o0 = MFMA32(v01, p1, o0);
            o1 = MFMA32(v10, p0, o1); o1 = MFMA32(v11, p1, o1);
        } }
    const float inv = 1.0f / ssum;
    { bf16* ob = A.OP + (size_t)p * ((size_t)T_ * AW) + tq * AW + h * AD + 4 * hi;
#pragma unroll
      for (int g = 0; g < 4; ++g) { v2u w; w.x = cvtpk(o0[4 * g] * inv, o0[4 * g + 1] * inv); w.y = cvtpk(o0[4 * g + 2] * inv, o0[4 * g + 3] * inv); *(v2u*)(ob + 8 * g) = w;
          v2u w1; w1.x = cvtpk(o1[4 * g] * inv, o1[4 * g + 1] * inv); w1.y = cvtpk(o1[4 * g + 2] * inv, o1[4 * g + 3] * inv); *(v2u*)(ob + 32 + 8 * g) = w1; } }
    if (hi == 0) A.LSE[(size_t)p * ((size_t)T_ * AH) + tq * AH + h] = m + log2f(ssum);
}
__global__ void __launch_bounds__(NWAVES * 64, 2) fwd(Args args) {
    extern __shared__ __attribute__((aligned(16))) unsigned char lds_raw[];
    LAS unsigned char* lds = (LAS unsigned char*)lds_raw;
    const int tid = threadIdx.x, lane = tid & 63, wave = __builtin_amdgcn_readfirstlane(tid >> 6);
    const int G = gridDim.x; const int bx = blockIdx.x; const int vcu = (G % 8 == 0) ? (bx % 8) * (G / 8) + bx / 8 : bx;
    const int gw = vcu * NWAVES + wave, NGW = G * NWAVES;
    unsigned char* ws = args.ws;
    const float* x = args.in[0]; float* out = args.out;
    bf16* Wt_in = (bf16*)(ws + WS_WIN); bf16* Wt_out = (bf16*)(ws + WS_WOUT); bf16* Wt_gu = (bf16*)(ws + WS_WGU); bf16* Wt_dn = (bf16*)(ws + WS_WDN);
    bf16* XN = (bf16*)(ws + WS_XN); bf16* RB = (bf16*)(ws + WS_RB);
    float* BIAS2 = (float*)(ws + WS_BIAS2); float* SSQ1 = (float*)(ws + WS_SSQ1);
    float* GLR = (float*)(RB + E_GLR);
    GlaBufs GB;
    GB.GQ = RB + E_GQ; GB.GK = RB + E_GK; GB.GVT = RB + E_GVT; GB.GLR = GLR;
    GB.OI = (bf16*)(ws + WS_XN); GB.QINF = GB.OI + (size_t)T_ * 1024; GB.QINB = GB.QINF + (size_t)T_ * 512;
    GB.KETF = (bf16*)(ws + WS_WIN); GB.KETB = GB.KETF + (size_t)T_ * 512;
    GB.DECF = (float*)(ws + WS_WIN + 16 * MiB); GB.DECB = GB.DECF + 128 * 512;
    GB.OSF = RB + E_GQ; GB.OSB = (bf16*)((unsigned char*)out + 48 * MiB);
    GB.gwF = args.in[4]; GB.gbF = args.in[5]; GB.gwB = args.in[6]; GB.gbB = args.in[7];
    bf16* Y = RB;
    bf16* X1B = (bf16*)(ws + WS_XN);
    bf16* HB = RB;
    AttnBufs AB; AB.AQ = RB + E_AQ; AB.AK = RB + E_AK; AB.AV = RB + E_AV; AB.BIAS2 = BIAS2;
    AB.OP = (bf16*)out; AB.LSE = (float*)(ws + WS_WIN + 17 * MiB);
    const int lo = args.ph_lo, hi = args.ph_hi;
#define IN(k) (lo <= (k) && (k) < hi)
#define SEAM(k) do { if (IN(k) && IN((k) + 1)) { cg::this_grid().sync(); } } while (0)

    if (IN(0)) {
        LAS float* scr = (LAS float*)(lds + wave * 16384);
        constexpr int I_IN = 32 * 193, I_OUT = 32 * 64, I_G = 32 * 176, I_D = 88 * 64, NITEMS = I_IN + I_OUT + 2 * I_G + I_D;
        for (int it = gw; it < NITEMS; it += NGW) {
            int r = it;
            if (r < I_IN) { const int kb = r / 193, nb = r % 193, n0 = nb * 32;
                int drow; float sc = 1.f;
                if (n0 < 1024) { drow = n0; sc = 0.125f * LOG2E; }
                else if (n0 < 3072) drow = n0;
                else if (n0 < 3584) { drow = n0; sc = 0.08838834764831845f; }
                else if (n0 < 4096) drow = n0;
                else if (n0 < 5120) drow = n0 + 1024;
                else if (n0 < 6144) drow = n0 - 1024;
                else drow = n0;
                p0_item(args.in[2], DM, INW, Wt_in, kb * 64, n0, drow, nullptr, sc, scr, lane); continue; }
            r -= I_IN;
            if (r < I_OUT) { const int kb = r / 64, nb = r % 64; p0_item(args.in[9], DM, DM, Wt_out, kb * 64, nb * 32, nb * 32, nullptr, 1.f, scr, lane); continue; }
            r -= I_OUT;
            if (r < I_G) { const int kb = r / 176, nb = r % 176, n0 = nb * 32; p0_item(args.in[11], DM, FF, Wt_gu, kb * 64, n0, (n0 >> 7) * 256 + (n0 & 127), args.in[10], 1.f, scr, lane); continue; }
            r -= I_G;
            if (r < I_G) { const int kb = r / 176, nb = r % 176, n0 = nb * 32; p0_item(args.in[12], DM, FF, Wt_gu, kb * 64, n0, (n0 >> 7) * 256 + 128 + (n0 & 127), args.in[10], 1.f, scr, lane); continue; }
            r -= I_G;
            { const int kb = r / 64, nb = r % 64; p0_item(args.in[13], FF, DM, Wt_dn, kb * 64, nb * 32, nb * 32, nullptr, 1.f, scr, lane); }
        }
        const float* nw = args.in[1];
        for (int m = gw; m < T_; m += NGW) {
            const f32x4* xr = (const f32x4*)(x + (size_t)m * DM) + lane; f32x4 v[8]; float s = 0.f;
#pragma unroll
            for (int j = 0; j < 8; ++j) { v[j] = xr[64 * j]; s += (v[j][0] * v[j][0] + v[j][1] * v[j][1]) + (v[j][2] * v[j][2] + v[j][3] * v[j][3]); }
            const float rstd = rsqrtf(wave_sum(s) * (1.f / DM) + NORM_EPS);
            v2u* o8 = (v2u*)(XN + (size_t)m * DM) + lane;
#pragma unroll
            for (int j = 0; j < 8; ++j) { const f32x4 w = ((const f32x4*)nw)[lane + 64 * j]; v2u o; o.x = pk2(v[j][0] * rstd * w[0], v[j][1] * rstd * w[1]); o.y = pk2(v[j][2] * rstd * w[2], v[j][3] * rstd * w[3]); o8[64 * j] = o; }
        }
        if (bx == 0) {
            const float* tbl = args.in[3];
            for (int idx = tid; idx < 3 * 129; idx += NWAVES * 64) { const int p = idx / 129, s = idx % 129; const int r = (p == 0) ? 1 : (p == 1 ? 4 : 16);
                const int bk = t5_bucket((s - 64) * r);
                for (int h = 0; h < 16; ++h) BIAS2[idx * 16 + h] = tbl[bk * 16 + h] * LOG2E; }
        }
    }
    SEAM(0);

    if (IN(1)) {
        { pg8::Gemm g{XN, Wt_in, T_, 5120, DM}; pg8::StaticOrder S; S.init(T_, 5120, G, bx); pg8::EpiProj E{RB};
          pg8::gemm_phase<pg8::EpiProj, pg8::StaticOrder, true, true>(lds, g, S, E); }
        { pg8::Gemm g{Wt_in + (size_t)5120 * DM, XN, 1024, T_, DM}; pg8::StaticOrder S; S.init(1024, T_, G, (bx + G / 2) % G); pg8::EpiPlain E{RB + E_GVT, T_};
          pg8::gemm_phase<pg8::EpiPlain, pg8::StaticOrder, true, true>(lds, g, S, E); }
        for (int o = vcu * 512 + tid; o < T_ * 32; o += G * 512) { const int t = o >> 5, j = o & 31;
            const v4u* a = (const v4u*)(XN + (size_t)t * DM); const v4u* b = (const v4u*)(Wt_in + (size_t)(6144 + j) * DM); float s = 0.f;
            for (int k = 0; k < DM / 8; ++k) { const v4u av = a[k], bv = b[k];
                s += bflo(av.x) * bflo(bv.x) + bfhi(av.x) * bfhi(bv.x) + bflo(av.y) * bflo(bv.y) + bfhi(av.y) * bfhi(bv.y)
                   + bflo(av.z) * bflo(bv.z) + bfhi(av.z) * bfhi(bv.z) + bflo(av.w) * bflo(bv.w) + bfhi(av.w) * bfhi(bv.w); }
            GLR[o] = s; }
    }
    SEAM(1);

    if (IN(2)) {
        for (int it = bx; it < 512; it += G) gla_unit(it, GB, lds, tid, lane, wave);
    }
    SEAM(2);

    if (IN(3)) {
        if (G > 64) { if (bx < 32) gla_scan(bx, GB, lds, tid, lane, wave); else for (int u = bx - 32; u < 1536; u += G - 32) attn_unit(u, AB, lds, tid, lane, wave); }
        else { for (int it = bx; it < 32; it += G) gla_scan(it, GB, lds, tid, lane, wave); for (int u = bx; u < 1536; u += G) attn_unit(u, AB, lds, tid, lane, wave); }
    }
    SEAM(3);

    if (IN(4)) {
        const bf16* GR = RB + E_GR; const float* gnw = args.in[8];
        for (int item = gw; item < T_ * 8; item += NGW) { const int row = item >> 3, part = item & 7;
            if (part < 4) {
                const int hh = 4 * part + (lane >> 4); const size_t eo = (size_t)row * AW + part * 256 + lane * 4;
                const float l0 = AB.LSE[(size_t)row * AH + hh], l1 = AB.LSE[(size_t)T_ * AH + (size_t)row * AH + hh], l2 = AB.LSE[(size_t)2 * T_ * AH + (size_t)row * AH + hh];
                const float M = fmaxf(fmaxf(l0, l1), l2); const float w0 = exp2f(l0 - M), w1 = exp2f(l1 - M), w2 = exp2f(l2 - M); const float iw = 1.0f / (w0 + w1 + w2);
                const v2u a0 = *(const v2u*)(AB.OP + eo), a1 = *(const v2u*)(AB.OP + (size_t)T_ * AW + eo), a2 = *(const v2u*)(AB.OP + (size_t)2 * T_ * AW + eo);
                const float y0 = (w0 * bflo(a0.x) + w1 * bflo(a1.x) + w2 * bflo(a2.x)) * iw, y1 = (w0 * bfhi(a0.x) + w1 * bfhi(a1.x) + w2 * bfhi(a2.x)) * iw;
                const float y2 = (w0 * bflo(a0.y) + w1 * bflo(a1.y) + w2 * bflo(a2.y)) * iw, y3 = (w0 * bfhi(a0.y) + w1 * bfhi(a1.y) + w2 * bfhi(a2.y)) * iw;
                v2u ov; ov.x = pk2(y0, y1); ov.y = pk2(y2, y3);
                *(v2u*)(Y + (size_t)row * DM + part * 256 + lane * 4) = ov;
            } else { const int h = part - 4; const size_t o = (size_t)row * GVW + h * 256;
                const v2u a = ((const v2u*)(GB.OI + o))[lane], c = ((const v2u*)(GB.OSF + o))[lane], e = ((const v2u*)(GB.OSB + o))[lane], g = ((const v2u*)(GR + o))[lane];
                float v[4] = {bflo(a.x) + bflo(c.x) + bflo(e.x), bfhi(a.x) + bfhi(c.x) + bfhi(e.x), bflo(a.y) + bflo(c.y) + bflo(e.y), bfhi(a.y) + bfhi(c.y) + bfhi(e.y)};
                const float gr[4] = {bflo(g.x), bfhi(g.x), bflo(g.y), bfhi(g.y)};
                const float ss = wave_sum((v[0] * v[0] + v[1] * v[1]) + (v[2] * v[2] + v[3] * v[3]));
                const float rstd = rsqrtf(ss * (1.0f / 256.0f) + NORM_EPS);
                const f32x4 w = ((const f32x4*)(gnw + h * 256))[lane];
                float y[4];
#pragma unroll
                for (int i = 0; i < 4; ++i) y[i] = v[i] * rstd * w[i] * (gr[i] / (1.0f + __expf(-gr[i])));
                v2u ov; ov.x = pk2(y[0], y[1]); ov.y = pk2(y[2], y[3]);
                ((v2u*)(Y + (size_t)row * DM + 1024 + h * 256))[lane] = ov; }
        }
    }
    SEAM(4);

    if (IN(5)) {
        pg8::Gemm g{Y, Wt_out, T_, DM, DM}; pg8::StaticOrder S; S.init(T_, DM, G, bx); pg8::EpiRes<true> E{x, out, X1B, SSQ1};
        pg8::gemm_phase<pg8::EpiRes<true>, pg8::StaticOrder, false, true>(lds, g, S, E);
    }
    SEAM(5);

    if (IN(6)) {
        pg8::Gemm g{X1B, Wt_gu, T_, 2 * FF, DM}; pg8::StaticOrder S; S.init(T_, 2 * FF, G, bx); pg8::EpiSwiglu E{HB, SSQ1};
        pg8::gemm_phase<pg8::EpiSwiglu, pg8::StaticOrder, true, true>(lds, g, S, E);
    }
    SEAM(6);

    if (IN(7)) {
        pg8::Gemm g{HB, Wt_dn, T_, DM, FF}; pg8::StaticOrder S; S.init(T_, DM, G, bx); pg8::EpiRes<false> E{out, out, nullptr, nullptr};
        pg8::gemm_phase<pg8::EpiRes<false>, pg8::StaticOrder, false, true>(lds, g, S, E);
    }
    SEAM(7);

    if (IN(8)) {
        const float* fw = args.in[14];
        for (int m = gw; m < T_; m += NGW) {
            f32x4* xr = (f32x4*)(out + (size_t)m * DM) + lane; f32x4 v[8]; float s = 0.f;
#pragma unroll
            for (int j = 0; j < 8; ++j) { v[j] = xr[64 * j]; s += (v[j][0] * v[j][0] + v[j][1] * v[j][1]) + (v[j][2] * v[j][2] + v[j][3] * v[j][3]); }
            const float rstd = rsqrtf(wave_sum(s) * (1.f / DM) + NORM_EPS);
#pragma unroll
            for (int j = 0; j < 8; ++j) { const f32x4 w = ((const f32x4*)fw)[lane + 64 * j]; xr[64 * j] = v[j] * rstd * w; }
        }
    }
#undef IN
#undef SEAM
}

extern "C" void kernel_launch(void* const* d_in, const int* in_sizes, int n_in, void* d_out, int out_size, void* d_ws, size_t ws_size, hipStream_t stream) {
    static int grid = 0;
    if (grid == 0) {
        if (n_in != 15 || out_size != T_ * DM || ws_size < WS_END) { fprintf(stderr, "kernel_launch: unexpected shapes (n_in %d out %d ws %zu)\n", n_in, out_size, ws_size); grid = -1; return; }
        int dev = 0, cus = 0, per_cu = 0;
        if (hipGetDevice(&dev) != hipSuccess || hipDeviceGetAttribute(&cus, hipDeviceAttributeMultiprocessorCount, dev) != hipSuccess) { grid = -1; return; }
        if (hipFuncSetAttribute((const void*)fwd, hipFuncAttributeMaxDynamicSharedMemorySize, LDS_BYTES) != hipSuccess) { fprintf(stderr, "kernel_launch: hipFuncSetAttribute failed\n"); grid = -1; return; }
        if (hipOccupancyMaxActiveBlocksPerMultiprocessor(&per_cu, (const void*)fwd, NWAVES * 64, LDS_BYTES) != hipSuccess || per_cu < 1) { fprintf(stderr, "kernel_launch: occupancy query reports %d\n", per_cu); per_cu = 1; }
        (void)hipGetLastError();
        grid = cus;
    }
    if (grid < 0) return;
    Args a{};
    for (int i = 0; i < 15; ++i) a.in[i] = (const float*)d_in[i];
    a.out = (float*)d_out; a.ws = (unsigned char*)d_ws;
#if MK_LAUNCHES == 1
    void* kargs[] = {&a};
#if PROBE_PREFIX > 0
    a.ph_lo = 0; a.ph_hi = PROBE_PREFIX;
    (void)hipLaunchCooperativeKernel((const void*)fwd, dim3(grid), dim3(NWAVES * 64), kargs, LDS_BYTES, stream);
#endif
    a.ph_lo = 0; a.ph_hi = NPHASE;
    hipError_t e = hipLaunchCooperativeKernel((const void*)fwd, dim3(grid), dim3(NWAVES * 64), kargs, LDS_BYTES, stream);
    if (e != hipSuccess) fprintf(stderr, "kernel_launch: cooperative launch failed: %s (grid %d)\n", hipGetErrorString(e), grid);
#else
    for (int p = 0; p < NPHASE; ++p) { a.ph_lo = p; a.ph_hi = p + 1; hipLaunchKernelGGL(fwd, dim3(grid), dim3(NWAVES * 64), LDS_BYTES, stream, a); }
#endif
}
```

```cpp
#include <hip/hip_runtime.h>
#include <hip/hip_cooperative_groups.h>
#include <cstdio>
#include <cstdint>
namespace cg = cooperative_groups;

namespace pg8 {
#define PG8_LAS __attribute__((address_space(3)))
typedef unsigned short bf16_t;
typedef short bf16x8 __attribute__((ext_vector_type(8)));
typedef float f32x4 __attribute__((ext_vector_type(4)));
typedef unsigned u32x4 __attribute__((ext_vector_type(4)));
constexpr int BM = 256, BK = 64, HALF = 128, HTB = HALF * BK * 2  , STAGE_BYTES = 8 * HTB, NXCD = 8, WGM = 8;

__host__ __device__ __forceinline__ int lds_byte(int r, int c) { const int st = (r >> 4) * 2 + (c >> 5), rr = r & 15, cc = c & 31, ob = rr * 64 + cc * 2; return st * 1024 + (ob ^ (((ob >> 9) & 1) << 5)); }
__host__ __device__ __forceinline__ void stage_rc(int b, int& R, int& C) { const int st = b / 1024, sb = b % 1024, swz = sb ^ (((sb >> 9) & 1) << 5); R = (st >> 1) * 16 + swz / 64; C = (st & 1) * 32 + (swz % 64) / 2; }
__host__ __device__ __forceinline__ int perm32(int rho) { const int n = rho >> 4, i = rho & 15; return 8 * (i >> 2) + 4 * n + (i & 3); }

struct Unit { int pm, pn; };
struct Gemm { const bf16_t* A; const bf16_t* Bt; int M, N, K; };

struct StaticOrder {
    int nM, nN, nwg, G, c;
    __host__ __device__ void init(int M, int N, int G_, int c_) { nM = M / BM; nN = N / BM; nwg = nM * nN; G = G_; c = c_; }
    __host__ __device__ bool next(int i, Unit& u) const {
        const long L = (long)i * G + c; if (L >= nwg) return false;
        int wgid = (int)L; { const int q = nwg / NXCD, r = nwg % NXCD, xcd = wgid % NXCD, off = wgid / NXCD; wgid = (xcd < r ? xcd * (q + 1) : r * (q + 1) + (xcd - r) * q) + off; }
        const int nig = WGM * nN, gid = wgid / nig, fm = gid * WGM, gsz = (nM - fm) < WGM ? (nM - fm) : WGM;
        u.pm = fm + ((wgid % nig) % gsz); u.pn = (wgid % nig) / gsz; return true;
    }
    __device__ __forceinline__ void a_ready(const Unit&) const {}
    __device__ __forceinline__ void done(const Unit&) const {}
};

__device__ __forceinline__ unsigned cvt_pk_bf16(float lo, float hi) { unsigned r; asm volatile("v_cvt_pk_bf16_f32 %0, %1, %2" : "=v"(r) : "v"(lo), "v"(hi)); return r; }
template <class Epi, class Sched, bool ALIGN_EPI = false, bool SP2 = false>
__device__ __forceinline__ void gemm_phase(PG8_LAS unsigned char* lds, const Gemm g, const Sched& S, const Epi& E) {
    const int tid = threadIdx.x, wid = __builtin_amdgcn_readfirstlane(tid >> 6), lane = tid & 63, wr = wid >> 2, wc = wid & 3, fr = lane & 15, fq = lane >> 4;
    const int K = g.K, nt = K / BK;
    unsigned voffA[2], voffB[2];
#pragma unroll
    for (int i = 0; i < 2; ++i) { int R, C; stage_rc(tid * 16 + i * 8192, R, C); const int Rb = Epi::PERM ? ((R & ~31) + perm32(R & 31)) : R;
        voffA[i] = (unsigned)(R * K + C) * 2u; voffB[i] = (unsigned)(Rb * K + C) * 2u; }
    const size_t kstep = (size_t)(BK * 2);
    const size_t hstep = (size_t)HALF * K * 2;
    const size_t tstep = 2 * hstep;
    const unsigned ldsw = (unsigned)wid * 1024u;
    const int aoff = lds_byte(wr * 64 + fr, fq * 8), boff = lds_byte(wc * 32 + fr, fq * 8);
#define PG8_SA(b, h) (((b) * 2 + (h)) * HTB)
#define PG8_SB(b, h) ((4 + (b) * 2 + (h)) * HTB)
#define PG8_STAGE(bufoff, gbase, voff) do { _Pragma("unroll") for (int _i = 0; _i < 2; ++_i) \
        __builtin_amdgcn_global_load_lds((const unsigned*)((const char*)(gbase) + (voff)[_i]), (PG8_LAS unsigned*)(lds + (bufoff) + ldsw + _i * 8192), 16, 0, 0); } while (0)
#define PG8_LDA(dst, b, h) do { _Pragma("unroll") for (int m = 0; m < 4; ++m) _Pragma("unroll") for (int k = 0; k < 2; ++k) dst[m][k] = *(const PG8_LAS bf16x8*)(lds + PG8_SA(b, h) + aoff + m * 2048 + k * 1024); } while (0)
#define PG8_LDB(dst, b, h) do { _Pragma("unroll") for (int n = 0; n < 2; ++n) _Pragma("unroll") for (int k = 0; k < 2; ++k) dst[n][k] = *(const PG8_LAS bf16x8*)(lds + PG8_SB(b, h) + boff + n * 2048 + k * 1024); } while (0)
#define PG8_MMA(ai, bj, At, Bt) do { __builtin_amdgcn_s_setprio(1); _Pragma("unroll") for (int m = 0; m < 4; ++m) _Pragma("unroll") for (int n = 0; n < 2; ++n) _Pragma("unroll") for (int k = 0; k < 2; ++k) \
        acc[ai][bj][m][n] = __builtin_amdgcn_mfma_f32_16x16x32_bf16(Bt[n][k], At[m][k], acc[ai][bj][m][n], 0, 0, 0); __builtin_amdgcn_s_setprio(0); } while (0)
#define PG8_WAIT_V(n) asm volatile("s_waitcnt vmcnt(" #n ")" ::: "memory")
#define PG8_WAIT_L(n) asm volatile("s_waitcnt lgkmcnt(" #n ")" ::: "memory")
#define PG8_BAR __builtin_amdgcn_s_barrier()
#define PG8_SCHED __builtin_amdgcn_sched_barrier(0)
    Unit cur, nxt; int ui = 0;
    if (!S.next(0, cur)) return;
    f32x4 acc[2][2][4][2];
#pragma unroll
    for (int a = 0; a < 2; ++a)
#pragma unroll
        for (int b = 0; b < 2; ++b)
#pragma unroll
            for (int m = 0; m < 4; ++m)
#pragma unroll
                for (int n = 0; n < 2; ++n) acc[a][b][m][n] = (f32x4){0.f, 0.f, 0.f, 0.f};
    bf16x8 At[4][2], B0[2][2], B1[2][2];
    const char* cA = (const char*)g.A + (size_t)cur.pm * tstep; const char* cB = (const char*)g.Bt + (size_t)cur.pn * tstep;
    S.a_ready(cur);
    if constexpr (SP2) {
        PG8_STAGE(PG8_SB(0, 0), cB, voffB); PG8_STAGE(PG8_SB(0, 1), cB + hstep, voffB); PG8_STAGE(PG8_SA(0, 0), cA, voffA); PG8_STAGE(PG8_SA(0, 1), cA + hstep, voffA);
        if (wr == 1) PG8_BAR;
        PG8_WAIT_V(2); PG8_BAR;
        PG8_STAGE(PG8_SB(1, 0), cB + kstep, voffB); PG8_STAGE(PG8_SA(1, 0), cA + kstep, voffA); PG8_STAGE(PG8_SB(1, 1), cB + hstep + kstep, voffB);
        PG8_WAIT_V(6); PG8_BAR;
    } else {
        PG8_STAGE(PG8_SB(0, 0), cB, voffB); PG8_STAGE(PG8_SA(0, 0), cA, voffA); PG8_STAGE(PG8_SB(0, 1), cB + hstep, voffB); PG8_STAGE(PG8_SA(0, 1), cA + hstep, voffA);
        if (wr == 1) PG8_BAR;
        PG8_WAIT_V(4); PG8_BAR;
        PG8_STAGE(PG8_SB(1, 0), cB + kstep, voffB); PG8_STAGE(PG8_SA(1, 0), cA + kstep, voffA); PG8_STAGE(PG8_SB(1, 1), cB + hstep + kstep, voffB);
        PG8_WAIT_V(6); PG8_BAR;
    }
    for (;;) {
        const bool has_next = S.next(ui + 1, nxt);
        const char* nA = has_next ? (const char*)g.A + (size_t)nxt.pm * tstep : cA; const char* nB = has_next ? (const char*)g.Bt + (size_t)nxt.pn * tstep : cB;
        for (int t = 0; t < nt; t += 2) {
            const bool last = (t == nt - 2);
            const char* a1 = cA + (size_t)(t + 1) * kstep;
            const char* a2 = last ? nA : cA + (size_t)(t + 2) * kstep; const char* b2 = last ? nB : cB + (size_t)(t + 2) * kstep;
            const char* a3 = a2 + kstep; const char* b3 = b2 + kstep;
            if (last && has_next) S.a_ready(nxt);
            if constexpr (SP2) {
            PG8_LDB(B0, 0, 0); PG8_LDB(B1, 0, 1); PG8_SCHED; PG8_LDA(At, 0, 0); PG8_STAGE(PG8_SA(1, 1), a1 + hstep, voffA);
            PG8_WAIT_V(8); PG8_WAIT_L(0); PG8_BAR; PG8_MMA(0, 0, At, B0); PG8_MMA(0, 1, At, B1); PG8_BAR; PG8_SCHED;
            PG8_LDA(At, 0, 1); PG8_STAGE(PG8_SB(0, 0), b2, voffB); PG8_STAGE(PG8_SB(0, 1), b2 + hstep, voffB); PG8_STAGE(PG8_SA(0, 0), a2, voffA);
            PG8_WAIT_V(8); PG8_WAIT_L(0); PG8_BAR; PG8_MMA(1, 0, At, B0); PG8_MMA(1, 1, At, B1); PG8_BAR; PG8_SCHED;
            PG8_LDB(B0, 1, 0); PG8_LDB(B1, 1, 1); PG8_SCHED; PG8_LDA(At, 1, 0); PG8_STAGE(PG8_SA(0, 1), a2 + hstep, voffA);
            PG8_WAIT_V(8); PG8_WAIT_L(0); PG8_BAR; PG8_MMA(0, 0, At, B0); PG8_MMA(0, 1, At, B1); PG8_BAR; PG8_SCHED;
            PG8_LDA(At, 1, 1); PG8_STAGE(PG8_SB(1, 0), b3, voffB); PG8_STAGE(PG8_SB(1, 1), b3 + hstep, voffB); PG8_STAGE(PG8_SA(1, 0), a3, voffA);
            PG8_WAIT_V(8); PG8_WAIT_L(0); PG8_BAR; PG8_MMA(1, 0, At, B0); PG8_MMA(1, 1, At, B1); PG8_BAR; PG8_SCHED;
            } else {
            PG8_LDB(B0, 0, 0); PG8_SCHED; PG8_LDA(At, 0, 0); PG8_STAGE(PG8_SA(1, 1), a1 + hstep, voffA);
            PG8_WAIT_L(8); PG8_BAR; PG8_WAIT_L(0); PG8_MMA(0, 0, At, B0); PG8_BAR; PG8_SCHED;
            PG8_LDB(B1, 0, 1); PG8_STAGE(PG8_SB(0, 0), b2, voffB);
            PG8_BAR; PG8_WAIT_L(0); PG8_MMA(0, 1, At, B1); PG8_BAR;
            PG8_LDA(At, 0, 1); PG8_STAGE(PG8_SA(0, 0), a2, voffA);
            PG8_BAR; PG8_WAIT_L(0); PG8_MMA(1, 0, At, B0); PG8_BAR; PG8_SCHED;
            PG8_STAGE(PG8_SB(0, 1), b2 + hstep, voffB);
            PG8_WAIT_V(6); PG8_BAR; PG8_MMA(1, 1, At, B1); PG8_BAR;
            PG8_LDB(B0, 1, 0); PG8_SCHED; PG8_LDA(At, 1, 0); PG8_STAGE(PG8_SA(0, 1), a2 + hstep, voffA);
            PG8_WAIT_L(8); PG8_BAR; PG8_WAIT_L(0); PG8_MMA(0, 0, At, B0); PG8_BAR; PG8_SCHED;
            PG8_LDB(B1, 1, 1); PG8_STAGE(PG8_SB(1, 0), b3, voffB);
            PG8_BAR; PG8_WAIT_L(0); PG8_MMA(0, 1, At, B1); PG8_BAR;
            PG8_LDA(At, 1, 1); PG8_STAGE(PG8_SA(1, 0), a3, voffA);
            PG8_BAR; PG8_WAIT_L(0); PG8_MMA(1, 0, At, B0); PG8_BAR; PG8_SCHED;
            PG8_STAGE(PG8_SB(1, 1), b3 + hstep, voffB);
            PG8_WAIT_V(6); PG8_BAR; PG8_MMA(1, 1, At, B1); PG8_BAR;
            }
        }
        if constexpr (ALIGN_EPI) { if (wr == 0) PG8_BAR; }
        if constexpr (!Epi::AFTER_DRAIN) { E(acc, cur, wr, wc, fr, fq); S.done(cur); }
        if (!has_next) break;
#pragma unroll
        for (int a = 0; a < 2; ++a)
#pragma unroll
            for (int b = 0; b < 2; ++b)
#pragma unroll
                for (int m = 0; m < 4; ++m)
#pragma unroll
                    for (int n = 0; n < 2; ++n) acc[a][b][m][n] = (f32x4){0.f, 0.f, 0.f, 0.f};
        cur = nxt; cA = nA; cB = nB; ++ui;
        if constexpr (ALIGN_EPI) { if (wr == 1) PG8_BAR; }
    }
    PG8_WAIT_V(0);
    if constexpr (!ALIGN_EPI) { if (wr == 0) PG8_BAR; }
    PG8_BAR;
    if constexpr (Epi::AFTER_DRAIN) { E.fused(acc, cur, wr, wc, fr, fq, lds, wid, lane); S.done(cur); }
#undef PG8_SA
#undef PG8_SB
#undef PG8_STAGE
#undef PG8_LDA
#undef PG8_LDB
#undef PG8_MMA
#undef PG8_WAIT_V
#undef PG8_WAIT_L
#undef PG8_BAR
#undef PG8_SCHED
}
}

constexpr int SEQ = 4096, NB = 2, T_ = NB * SEQ, DM = 2048, INW = 6176, FF = 5632;
constexpr int AH = 16, AD = 64, AW = 1024;
constexpr int GH = 4, GDK = 128, GDV = 256, GKW = 512, GVW = 1024, GRANK = 16;
constexpr float NORM_EPS = 1e-6f;
constexpr float LOG2E = 1.4426950408889634f;
constexpr int NWAVES = 8;
constexpr int NPHASE = 9;
#ifndef PROBE_PREFIX
#define PROBE_PREFIX 0
#endif
#ifndef MK_LAUNCHES
#define MK_LAUNCHES 1
#endif

constexpr size_t MiB = 1u << 20;
constexpr size_t WS_CTL = 0;
constexpr size_t WS_BIAS2 = 64 * 1024;
constexpr size_t WS_SSQ1 = 128 * 1024;
constexpr size_t WS_WIN = 1 * MiB;
constexpr size_t WS_WOUT = 26 * MiB;
constexpr size_t WS_WGU = 34 * MiB;
constexpr size_t WS_WDN = 78 * MiB;
constexpr size_t WS_XN = 100 * MiB;
constexpr size_t WS_RB = 132 * MiB;
constexpr size_t WS_END = 229 * MiB;
constexpr size_t E_AQ = 0, E_AK = (size_t)T_ * 1024, E_AV = 2 * (size_t)T_ * 1024, E_GQ = 3 * (size_t)T_ * 1024, E_GK = E_GQ + (size_t)T_ * 512,
                 E_GVT = 4 * (size_t)T_ * 1024, E_GR = 5 * (size_t)T_ * 1024, E_GLR = 6 * (size_t)T_ * 1024;

#define GAS __attribute__((address_space(1)))
#define LAS __attribute__((address_space(3)))
typedef unsigned short bf16;
typedef unsigned v4u __attribute__((ext_vector_type(4)));
typedef unsigned v2u __attribute__((ext_vector_type(2)));
typedef float f32x4 __attribute__((ext_vector_type(4)));
#define LDS_WAIT() asm volatile("s_waitcnt lgkmcnt(0)" ::: "memory")
__device__ __forceinline__ unsigned f2bf(float f) { unsigned u = __builtin_bit_cast(unsigned, f); return (u + 0x7fffu + ((u >> 16) & 1u)) >> 16; }
__device__ __forceinline__ unsigned pk2(float lo, float hi) { return f2bf(lo) | (f2bf(hi) << 16); }
__device__ __forceinline__ float bf2f(unsigned b) { return __builtin_bit_cast(float, b << 16); }
__device__ __forceinline__ float bflo(unsigned w) { return __builtin_bit_cast(float, w << 16); }
__device__ __forceinline__ float bfhi(unsigned w) { return __builtin_bit_cast(float, w & 0xffff0000u); }
__device__ __forceinline__ float wave_sum(float v) {
#pragma unroll
    for (int o = 1; o < 64; o <<= 1) v += __shfl_xor(v, o);
    return v;
}
__device__ __forceinline__ float wave_max(float v) {
#pragma unroll
    for (int o = 1; o < 64; o <<= 1) v = fmaxf(v, __shfl_xor(v, o));
    return v;
}

namespace pg8 {
struct EpiProj {
    static constexpr bool PERM = true, AFTER_DRAIN = false;
    bf16_t* rb;
    __device__ __forceinline__ void operator()(const f32x4 (&acc)[2][2][4][2], const Unit& u, int wr, int wc, int fr, int fq) const {
        const int pn = u.pn; bf16_t* base; int ldc, colt;
        if (pn < 12) { base = rb + (size_t)(pn >> 2) * ((size_t)T_ * 1024); ldc = 1024; colt = (pn & 3) * 256; }
        else if (pn < 16) { base = rb + E_GQ + (size_t)((pn - 12) >> 1) * ((size_t)T_ * 512); ldc = 512; colt = ((pn - 12) & 1) * 256; }
        else { base = rb + E_GR; ldc = 1024; colt = (pn - 16) * 256; }
        const int row0 = u.pm * BM + wr * 64 + fr, col0 = colt + wc * 32 + 8 * fq;
#pragma unroll
        for (int ai = 0; ai < 2; ++ai)
#pragma unroll
            for (int m = 0; m < 4; ++m) { bf16_t* rowp = base + (size_t)(row0 + ai * HALF + m * 16) * ldc + col0;
#pragma unroll
                for (int bj = 0; bj < 2; ++bj) { const f32x4 v0 = acc[ai][bj][m][0], v1 = acc[ai][bj][m][1];
                    u32x4 w; w.x = cvt_pk_bf16(v0[0], v0[1]); w.y = cvt_pk_bf16(v0[2], v0[3]); w.z = cvt_pk_bf16(v1[0], v1[1]); w.w = cvt_pk_bf16(v1[2], v1[3]);
                    *(u32x4*)(rowp + bj * HALF) = w; } }
    }
};
struct EpiPlain {
    static constexpr bool PERM = true, AFTER_DRAIN = false;
    bf16_t* O; int ldc;
    __device__ __forceinline__ void operator()(const f32x4 (&acc)[2][2][4][2], const Unit& u, int wr, int wc, int fr, int fq) const {
        const int row0 = u.pm * BM + wr * 64 + fr, col0 = u.pn * BM + wc * 32 + 8 * fq;
#pragma unroll
        for (int ai = 0; ai < 2; ++ai)
#pragma unroll
            for (int m = 0; m < 4; ++m) { bf16_t* rowp = O + (size_t)(row0 + ai * HALF + m * 16) * ldc + col0;
#pragma unroll
                for (int bj = 0; bj < 2; ++bj) { const f32x4 v0 = acc[ai][bj][m][0], v1 = acc[ai][bj][m][1];
                    u32x4 w; w.x = cvt_pk_bf16(v0[0], v0[1]); w.y = cvt_pk_bf16(v0[2], v0[3]); w.z = cvt_pk_bf16(v1[0], v1[1]); w.w = cvt_pk_bf16(v1[2], v1[3]);
                    *(u32x4*)(rowp + bj * HALF) = w; } }
    }
};
template <bool AUX> struct EpiRes {
    static constexpr bool PERM = false, AFTER_DRAIN = true;
    const float* base; float* out; bf16_t* xb; float* ssq;
    __device__ __forceinline__ void fused(f32x4 (&acc)[2][2][4][2], const Unit& u, int wr, int wc, int fr, int fq, PG8_LAS unsigned char* lds, int wid, int lane) const {
        PG8_LAS float* P = (PG8_LAS float*)lds;
        const int col0 = u.pn * BM + wc * 32 + 4 * fq;
#pragma unroll
        for (int ai = 0; ai < 2; ++ai)
#pragma unroll
            for (int m = 0; m < 4; ++m) { const int rl = ai * HALF + wr * 64 + m * 16 + fr; const size_t off = (size_t)(u.pm * BM + rl) * DM + col0; float s = 0.f;
#pragma unroll
                for (int bj = 0; bj < 2; ++bj)
#pragma unroll
                    for (int n = 0; n < 2; ++n) { const f32x4 bs = *(const f32x4*)(base + off + bj * HALF + n * 16); const f32x4 v = bs + acc[ai][bj][m][n];
                        *(f32x4*)(out + off + bj * HALF + n * 16) = v;
                        if (AUX) { s += (v[0] * v[0] + v[1] * v[1]) + (v[2] * v[2] + v[3] * v[3]);
                            typedef unsigned u32x2 __attribute__((ext_vector_type(2))); u32x2 w; w.x = cvt_pk_bf16(v[0], v[1]); w.y = cvt_pk_bf16(v[2], v[3]);
                            *(u32x2*)(xb + off + bj * HALF + n * 16) = w; } }
                if (AUX) { s += __shfl_xor(s, 16); s += __shfl_xor(s, 32); if (fq == 0) P[rl * 4 + wc] = s; }
            }
        if (AUX) {
            asm volatile("s_waitcnt lgkmcnt(0)" ::: "memory"); __builtin_amdgcn_s_barrier(); asm volatile("" ::: "memory");
            const int tid = wid * 64 + lane;
            if (tid < 256) { const float s = (P[tid * 4 + 0] + P[tid * 4 + 1]) + (P[tid * 4 + 2] + P[tid * 4 + 3]); ssq[(size_t)(u.pm * BM + tid) * 8 + u.pn] = s; }
        }
    }
};
struct EpiSwiglu {
    static constexpr bool PERM = true, AFTER_DRAIN = false;
    bf16_t* H; const float* ssq;
    __device__ __forceinline__ void operator()(const f32x4 (&acc)[2][2][4][2], const Unit& u, int wr, int wc, int fr, int fq) const {
        const int row0 = u.pm * BM + wr * 64 + fr, col0 = u.pn * HALF + wc * 32 + 8 * fq;
#pragma unroll
        for (int ai = 0; ai < 2; ++ai)
#pragma unroll
            for (int m = 0; m < 4; ++m) { const int r = row0 + ai * HALF + m * 16;
                const f32x4 s0 = *(const f32x4*)(ssq + (size_t)r * 8), s1 = *(const f32x4*)(ssq + (size_t)r * 8 + 4);
                const float tot = ((s0[0] + s0[1]) + (s0[2] + s0[3])) + ((s1[0] + s1[1]) + (s1[2] + s1[3]));
                const float rstd = rsqrtf(tot * (1.0f / DM) + NORM_EPS);
                float hv[8];
#pragma unroll
                for (int n = 0; n < 2; ++n)
#pragma unroll
                    for (int i = 0; i < 4; ++i) { const float g = acc[ai][0][m][n][i] * rstd, up = acc[ai][1][m][n][i] * rstd; hv[n * 4 + i] = g / (1.0f + __expf(-g)) * up; }
                u32x4 w; w.x = cvt_pk_bf16(hv[0], hv[1]); w.y = cvt_pk_bf16(hv[2], hv[3]); w.z = cvt_pk_bf16(hv[4], hv[5]); w.w = cvt_pk_bf16(hv[6], hv[7]);
                *(u32x4*)(H + (size_t)r * FF + col0) = w; }
    }
};
}

constexpr int RING_BYTES = 131072;
constexpr int LDS_BYTES = 147456;
struct Args { const float* in[15]; float* out; unsigned char* ws; int ph_lo, ph_hi; };
typedef short bf16x8 __attribute__((ext_vector_type(8)));
typedef float f32x16 __attribute__((ext_vector_type(16)));
__device__ __forceinline__ int crow(int r, int hi) { return (r & 3) + 8 * (r >> 2) + 4 * hi; }
typedef float f32x2_t __attribute__((ext_vector_type(2))); typedef __bf16 bf16x2_t __attribute__((ext_vector_type(2)));
__device__ __forceinline__ unsigned cvtpk(float lo, float hi) { f32x2_t v = {lo, hi}; bf16x2_t b = __builtin_convertvector(v, bf16x2_t); return __builtin_bit_cast(unsigned, b); }
template <int S> __device__ __forceinline__ bf16x8 pack8(const f32x16& a) {
    v4u w; w.x = cvtpk(a[8 * S + 0], a[8 * S + 1]); w.y = cvtpk(a[8 * S + 2], a[8 * S + 3]); w.z = cvtpk(a[8 * S + 4], a[8 * S + 5]); w.w = cvtpk(a[8 * S + 6], a[8 * S + 7]);
    return __builtin_bit_cast(bf16x8, w);
}
__device__ __forceinline__ bf16x8 join8(v2u lo, v2u hi) { v4u w; w.x = lo.x; w.y = lo.y; w.z = hi.x; w.w = hi.y; return __builtin_bit_cast(bf16x8, w); }
#define MFMA32(a, b, c) __builtin_amdgcn_mfma_f32_32x32x16_bf16((a), (b), (c), 0, 0, 0)
#define WG_BAR() do { asm volatile("s_waitcnt lgkmcnt(0)" ::: "memory"); __builtin_amdgcn_s_barrier(); asm volatile("" ::: "memory"); } while (0)

struct P0Item { const float* W; bf16* WT; const float* ks; int K, N, k0, n0, drow0; float ns; };
__device__ __forceinline__ void p0_load(const P0Item& I, f32x4 (&r)[8], int lane) {
#pragma unroll
    for (int i = 0; i < 8; ++i) { const int p = lane + 64 * i; r[i] = *(const f32x4*)(I.W + (size_t)(I.k0 + (p >> 3)) * I.N + I.n0 + (p & 7) * 4); }
}
__device__ __forceinline__ void p0_store(const P0Item& I, const f32x4 (&r)[8], LAS float* scr, int lane) {
#pragma unroll
    for (int i = 0; i < 8; ++i) { const int p = lane + 64 * i, kk = p >> 3, n4 = (p & 7) * 4; const float s = (I.ks ? I.ks[I.k0 + kk] : 1.0f) * I.ns;
        scr[kk * 33 + n4 + 0] = r[i][0] * s; scr[kk * 33 + n4 + 1] = r[i][1] * s; scr[kk * 33 + n4 + 2] = r[i][2] * s; scr[kk * 33 + n4 + 3] = r[i][3] * s; }
    LDS_WAIT(); asm volatile("" ::: "memory");
    const int c = lane & 7;
#pragma unroll
    for (int j = 0; j < 4; ++j) { const int n = (lane >> 3) + 8 * j; const LAS float* s = scr + (8 * c) * 33 + n;
        v4u o; o.x = pk2(s[0 * 33], s[1 * 33]); o.y = pk2(s[2 * 33], s[3 * 33]); o.z = pk2(s[4 * 33], s[5 * 33]); o.w = pk2(s[6 * 33], s[7 * 33]);
        *(v4u*)(I.WT + (size_t)(I.drow0 + n) * I.K + I.k0 + 8 * c) = o; }
    LDS_WAIT(); asm volatile("" ::: "memory");
}

struct P0Ptrs { const float* w_in; const float* w_out; const float* w_gate; const float* w_up; const float* w_down; const float* ffn_w; bf16* Wt_in; bf16* Wt_out; bf16* Wt_gu; bf16* Wt_dn; };
constexpr int I_IN = 32 * 193, I_OUT = 32 * 64, I_G = 32 * 176, I_D = 88 * 64, P0_NITEMS = I_IN + I_OUT + 2 * I_G + I_D;
__device__ __forceinline__ void p0_decode(int it, const P0Ptrs& P, P0Item& I) {
    int r = it; I.ks = nullptr; I.ns = 1.f;
    if (r < I_IN) { const int kb = r / 193, nb = r % 193, n0 = nb * 32; int drow;
        if (n0 < 1024) { drow = n0; I.ns = 0.125f * LOG2E; }
        else if (n0 < 3072) drow = n0;
        else if (n0 < 3584) { drow = n0; I.ns = 0.08838834764831845f; }
        else if (n0 < 4096) drow = n0;
        else if (n0 < 5120) drow = n0 + 1024;
        else if (n0 < 6144) drow = n0 - 1024;
        else drow = n0;
        I.W = P.w_in; I.WT = P.Wt_in; I.K = DM; I.N = INW; I.k0 = kb * 64; I.n0 = n0; I.drow0 = drow; return; }
    r -= I_IN;
    if (r < I_OUT) { const int kb = r / 64, nb = r % 64; I.W = P.w_out; I.WT = P.Wt_out; I.K = DM; I.N = DM; I.k0 = kb * 64; I.n0 = nb * 32; I.drow0 = nb * 32; return; }
    r -= I_OUT;
    if (r < I_G) { const int kb = r / 176, nb = r % 176, n0 = nb * 32; I.W = P.w_gate; I.WT = P.Wt_gu; I.K = DM; I.N = FF; I.k0 = kb * 64; I.n0 = n0; I.drow0 = (n0 >> 7) * 256 + (n0 & 127); I.ks = P.ffn_w; return; }
    r -= I_G;
    if (r < I_G) { const int kb = r / 176, nb = r % 176, n0 = nb * 32; I.W = P.w_up; I.WT = P.Wt_gu; I.K = DM; I.N = FF; I.k0 = kb * 64; I.n0 = n0; I.drow0 = (n0 >> 7) * 256 + 128 + (n0 & 127); I.ks = P.ffn_w; return; }
    r -= I_G;
    { const int kb = r / 64, nb = r % 64; I.W = P.w_down; I.WT = P.Wt_dn; I.K = FF; I.N = DM; I.k0 = kb * 64; I.n0 = nb * 32; I.drow0 = nb * 32; }
}

__device__ __forceinline__ int t5_bucket(int rel) {
    const int nb = 16, max_exact = 8; int ret = rel > 0 ? nb : 0; const int n = rel < 0 ? -rel : rel;
    if (n < max_exact) return ret + n;
    int large = max_exact + (int)(log((double)n / (double)max_exact) / log(1024.0 / 8.0) * (double)(nb - max_exact));
    if (large > nb - 1) large = nb - 1;
    return ret + large;
}
__device__ __forceinline__ float logsig16(float z) { return (fminf(z, 0.f) - log1pf(__expf(-fabsf(z)))) * (1.0f / 16.0f); }

struct GlaBufs { const bf16* GQ; const bf16* GK; const bf16* GVT; const float* GLR; bf16* QINF; bf16* QINB; bf16* KETF; bf16* KETB; float* DECF; float* DECB; bf16* OI; bf16* OSF; bf16* OSB;
                 const float* gwF; const float* gbF; const float* gwB; const float* gbB; };
constexpr int GP = 136;
__device__ __forceinline__ f32x16 gla_xtile(const LAS bf16* Ks, const LAS bf16* Qs, int jt, int ct, int l31, int hi) {
    f32x16 acc = {};
    const LAS bf16* kp = Ks + (32 * jt + l31) * GP + 8 * hi; const LAS bf16* qp = Qs + (32 * ct + l31) * GP + 8 * hi;
#pragma unroll
    for (int d0 = 0; d0 < 8; ++d0) { const bf16x8 a = *(const LAS bf16x8*)(kp + 16 * d0); const bf16x8 b = *(const LAS bf16x8*)(qp + 16 * d0); acc = MFMA32(a, b, acc); }
    return acc;
}
__device__ __forceinline__ void gla_unit(int unit, const GlaBufs& B, LAS unsigned char* lds, int tid, int lane, int wave) {
    const int n = unit & 63, h = (unit >> 6) & 3, b = unit >> 8;
    const size_t row0 = (size_t)b * SEQ + 64 * n;
    LAS bf16* QF = (LAS bf16*)lds; LAS bf16* KF = QF + 64 * GP; LAS bf16* QB = KF + 64 * GP; LAS bf16* KB = QB + 64 * GP;
    LAS float* PS = (LAS float*)(lds + 69632);
    LAS float* LR = (LAS float*)(lds + 73728);
    WG_BAR();
    ((LAS f32x4*)LR)[tid] = ((const f32x4*)(B.GLR + row0 * 32))[tid];
    const int d = tid & 127, cgrp = tid >> 7, col = h * 128 + d;
    float gwf[16], gwb[16];
#pragma unroll
    for (int r = 0; r < 16; ++r) { gwf[r] = B.gwF[r * GKW + col]; gwb[r] = B.gwB[r * GKW + col]; }
    const float gbf = B.gbF[col], gbb = B.gbB[col];
    WG_BAR();
    float laf[16], lab[16];
#pragma unroll
    for (int cc = 0; cc < 16; ++cc) { const int c = cgrp * 16 + cc; float zf = gbf, zb = gbb;
#pragma unroll
        for (int r4 = 0; r4 < 4; ++r4) { const f32x4 a = *(const LAS f32x4*)(LR + c * 32 + 4 * r4), e = *(const LAS f32x4*)(LR + c * 32 + 16 + 4 * r4);
#pragma unroll
            for (int i = 0; i < 4; ++i) { zf += a[i] * gwf[4 * r4 + i]; zb += e[i] * gwb[4 * r4 + i]; } }
        laf[cc] = logsig16(zf); lab[cc] = logsig16(zb); }
#pragma unroll
    for (int cc = 1; cc < 16; ++cc) laf[cc] += laf[cc - 1];
#pragma unroll
    for (int cc = 14; cc >= 0; --cc) lab[cc] += lab[cc + 1];
    PS[cgrp * 128 + d] = laf[15]; PS[(4 + cgrp) * 128 + d] = lab[0];
    WG_BAR();
    float offf = 0.f, offb = 0.f, totf = 0.f, totb = 0.f;
#pragma unroll
    for (int g = 0; g < 4; ++g) { const float pf = PS[g * 128 + d], pb = PS[(4 + g) * 128 + d]; totf += pf; totb += pb; if (g < cgrp) offf += pf; if (g > cgrp) offb += pb; }
    float kef[16], keb[16];
#pragma unroll
    for (int cc = 0; cc < 16; ++cc) { const int c = cgrp * 16 + cc; const size_t row = row0 + c;
        const float Gf = laf[cc] + offf, Gb = lab[cc] + offb;
        const float q = bf2f(B.GQ[row * GKW + col]), k = bf2f(B.GK[row * GKW + col]);
        const float qf = q * __expf(Gf), kf = k * __expf(-Gf), qb = q * __expf(Gb), kb = k * __expf(-Gb);
        kef[cc] = k * __expf(totf - Gf); keb[cc] = k * __expf(totb - Gb);
        const bf16 qfh = (bf16)f2bf(qf), qbh = (bf16)f2bf(qb);
        QF[c * GP + d] = qfh; KF[c * GP + d] = (bf16)f2bf(kf); QB[c * GP + d] = qbh; KB[c * GP + d] = (bf16)f2bf(kb);
        B.QINF[row * GKW + col] = qfh; B.QINB[row * GKW + col] = qbh; }
    { v4u w0, w1; bf16* dst = B.KETF + (size_t)col * T_ + row0 + cgrp * 16;
      w0.x = pk2(kef[0], kef[1]); w0.y = pk2(kef[2], kef[3]); w0.z = pk2(kef[4], kef[5]); w0.w = pk2(kef[6], kef[7]);
      w1.x = pk2(kef[8], kef[9]); w1.y = pk2(kef[10], kef[11]); w1.z = pk2(kef[12], kef[13]); w1.w = pk2(kef[14], kef[15]);
      ((v4u*)dst)[0] = w0; ((v4u*)dst)[1] = w1;
      dst = B.KETB + (size_t)col * T_ + row0 + cgrp * 16;
      w0.x = pk2(keb[0], keb[1]); w0.y = pk2(keb[2], keb[3]); w0.z = pk2(keb[4], keb[5]); w0.w = pk2(keb[6], keb[7]);
      w1.x = pk2(keb[8], keb[9]); w1.y = pk2(keb[10], keb[11]); w1.z = pk2(keb[12], keb[13]); w1.w = pk2(keb[14], keb[15]);
      ((v4u*)dst)[0] = w0; ((v4u*)dst)[1] = w1; }
    if (cgrp == 0) { B.DECF[(size_t)(b * 64 + n) * GKW + col] = __expf(totf); B.DECB[(size_t)(b * 64 + n) * GKW + col] = __expf(totb); }
    WG_BAR();
    const int l31 = lane & 31, hi = lane >> 5;
    bf16x8 vt[2][2];
    { const bf16* vbase = B.GVT + (size_t)(h * 256 + 32 * wave + l31) * T_ + row0 + 4 * hi;
#pragma unroll
      for (int jt = 0; jt < 2; ++jt)
#pragma unroll
          for (int s = 0; s < 2; ++s) { const bf16* p = vbase + 32 * jt + 16 * s; vt[jt][s] = join8(*(const v2u*)p, *(const v2u*)(p + 8)); } }
    f32x16 o0 = {}, o1 = {};
    {
        f32x16 X = gla_xtile(KF, QF, 0, 0, l31, hi);
#pragma unroll
        for (int r = 0; r < 16; ++r) if (crow(r, hi) > l31) X[r] = 0.f;
        o0 = MFMA32(vt[0][0], pack8<0>(X), o0); o0 = MFMA32(vt[0][1], pack8<1>(X), o0);
        X = gla_xtile(KF, QF, 0, 1, l31, hi);
        o1 = MFMA32(vt[0][0], pack8<0>(X), o1); o1 = MFMA32(vt[0][1], pack8<1>(X), o1);
        X = gla_xtile(KF, QF, 1, 1, l31, hi);
#pragma unroll
        for (int r = 0; r < 16; ++r) if (crow(r, hi) > l31) X[r] = 0.f;
        o1 = MFMA32(vt[1][0], pack8<0>(X), o1); o1 = MFMA32(vt[1][1], pack8<1>(X), o1);
    }
    {
        f32x16 X = gla_xtile(KB, QB, 0, 0, l31, hi);
#pragma unroll
        for (int r = 0; r < 16; ++r) if (crow(r, hi) < l31) X[r] = 0.f;
        o0 = MFMA32(vt[0][0], pack8<0>(X), o0); o0 = MFMA32(vt[0][1], pack8<1>(X), o0);
        X = gla_xtile(KB, QB, 1, 0, l31, hi);
        o0 = MFMA32(vt[1][0], pack8<0>(X), o0); o0 = MFMA32(vt[1][1], pack8<1>(X), o0);
        X = gla_xtile(KB, QB, 1, 1, l31, hi);
#pragma unroll
        for (int r = 0; r < 16; ++r) if (crow(r, hi) < l31) X[r] = 0.f;
        o1 = MFMA32(vt[1][0], pack8<0>(X), o1); o1 = MFMA32(vt[1][1], pack8<1>(X), o1);
    }
    { bf16* ob = B.OI + (row0 + l31) * GVW + h * 256 + 32 * wave + 4 * hi;
#pragma unroll
      for (int g = 0; g < 4; ++g) { v2u w; w.x = cvtpk(o0[4 * g], o0[4 * g + 1]); w.y = cvtpk(o0[4 * g + 2], o0[4 * g + 3]); *(v2u*)(ob + 8 * g) = w;
          v2u w1; w1.x = cvtpk(o1[4 * g], o1[4 * g + 1]); w1.y = cvtpk(o1[4 * g + 2], o1[4 * g + 3]); *(v2u*)(ob + (size_t)32 * GVW + 8 * g) = w1; } }
}

constexpr int SC_Q = 0, SC_K = 17408, SC_V = 35840, SC_D = 54272, SC_STAGE = 54784;
struct ScanRegs { v4u q[8], k[8], v[8]; f32x4 d; };
__device__ __forceinline__ void gla_scan(int item, const GlaBufs& B, LAS unsigned char* lds, int tid, int lane, int wave) {
    const int half = item & 1, dir = (item >> 1) & 1, h = (item >> 2) & 3, b = item >> 4;
    const bf16* QIN = dir ? B.QINB : B.QINF; const bf16* KET = dir ? B.KETB : B.KETF; const float* DEC = dir ? B.DECB : B.DECF;
    bf16* OS = dir ? B.OSB : B.OSF;
    const int l31 = lane & 31, hi = lane >> 5;
    const int par = (wave >> 1) & 1, sub = wave & 1, pl = 64 * sub + lane;
    const bool loader = wave >= 4;
#define SC_CHUNK(st) (dir ? 63 - (st) : (st))
#define SC_LOAD(R, st) do { const int nn_ = SC_CHUNK(st); const size_t r0_ = (size_t)b * SEQ + 64 * nn_; \
        _Pragma("unroll") for (int i_ = 0; i_ < 8; ++i_) { const int pp_ = pl + 128 * i_; \
            R.q[i_] = *(const v4u*)(QIN + (r0_ + (pp_ >> 4)) * GKW + h * 128 + (pp_ & 15) * 8); \
            R.k[i_] = *(const v4u*)(KET + (size_t)(h * 128 + (pp_ >> 3)) * T_ + r0_ + (pp_ & 7) * 8); \
            R.v[i_] = *(const v4u*)(B.GVT + (size_t)(h * 256 + 128 * half + (pp_ >> 3)) * T_ + r0_ + (pp_ & 7) * 8); } \
        if (pl < 32) R.d = *(const f32x4*)(DEC + (size_t)(b * 64 + nn_) * GKW + h * 128 + pl * 4); } while (0)
#define SC_WRITE(R, sg) do { LAS unsigned char* s_ = lds + (sg) * SC_STAGE; \
        _Pragma("unroll") for (int i_ = 0; i_ < 8; ++i_) { const int pp_ = pl + 128 * i_; \
            *(LAS v4u*)(s_ + SC_Q + (pp_ >> 4) * 272 + (pp_ & 15) * 16) = R.q[i_]; \
            *(LAS v4u*)(s_ + SC_K + (pp_ >> 3) * 144 + (pp_ & 7) * 16) = R.k[i_]; \
            *(LAS v4u*)(s_ + SC_V + (pp_ >> 3) * 144 + (pp_ & 7) * 16) = R.v[i_]; } \
        if (pl < 32) *(LAS f32x4*)(s_ + SC_D + pl * 16) = R.d; } while (0)
    WG_BAR();
#define SC_INTER(Sx, dt) do { \
            { const bf16x8 a = pack8<0>(Sx); const bf16x8 b0 = join8(*(const LAS v2u*)(qb0 + (32 * (dt)) * 2), *(const LAS v2u*)(qb0 + (32 * (dt) + 8) * 2)); \
              const bf16x8 b1 = join8(*(const LAS v2u*)(qb1 + (32 * (dt)) * 2), *(const LAS v2u*)(qb1 + (32 * (dt) + 8) * 2)); i0 = MFMA32(a, b0, i0); i1 = MFMA32(a, b1, i1); } \
            { const bf16x8 a = pack8<1>(Sx); const bf16x8 b0 = join8(*(const LAS v2u*)(qb0 + (32 * (dt) + 16) * 2), *(const LAS v2u*)(qb0 + (32 * (dt) + 24) * 2)); \
              const bf16x8 b1 = join8(*(const LAS v2u*)(qb1 + (32 * (dt) + 16) * 2), *(const LAS v2u*)(qb1 + (32 * (dt) + 24) * 2)); i0 = MFMA32(a, b0, i0); i1 = MFMA32(a, b1, i1); } } while (0)
#define SC_UPD(Sx, dt) do { \
            _Pragma("unroll") for (int g = 0; g < 4; ++g) { const f32x4 dv = *(const LAS f32x4*)(sg + SC_D + (32 * (dt) + 8 * g + 4 * hi) * 4); \
                Sx[4 * g] *= dv[0]; Sx[4 * g + 1] *= dv[1]; Sx[4 * g + 2] *= dv[2]; Sx[4 * g + 3] *= dv[3]; } \
            _Pragma("unroll") for (int s = 0; s < 4; ++s) { const bf16x8 a = *(const LAS bf16x8*)(kb_ + (32 * (dt)) * 144 + 32 * s); Sx = MFMA32(a, vf[s], Sx); } } while (0)
    if (loader) {
        ScanRegs R;
        if (par == 0) {
            SC_LOAD(R, 0); SC_WRITE(R, 0); SC_LOAD(R, 2);
            WG_BAR();
            for (int st = 0; st < 64; st += 2) {
                WG_BAR();
                if (st + 2 < 64) SC_WRITE(R, 0);
                if (st + 4 < 64) SC_LOAD(R, st + 4);
                WG_BAR();
            }
        } else {
            SC_LOAD(R, 1);
            WG_BAR();
            for (int st = 0; st < 64; st += 2) {
                SC_WRITE(R, 1);
                if (st + 3 < 64) SC_LOAD(R, st + 3);
                WG_BAR();
                WG_BAR();
            }
        }
    } else {
        f32x16 S0 = {}, S1 = {}, S2 = {}, S3 = {};
        WG_BAR();
        for (int st = 0; st < 64; ++st) {
            const int n = SC_CHUNK(st); const LAS unsigned char* sg = lds + (st & 1) * SC_STAGE;
            f32x16 i0 = {}, i1 = {};
            const LAS unsigned char* qb0 = sg + SC_Q + l31 * 272 + 8 * hi; const LAS unsigned char* qb1 = qb0 + 32 * 272;
            SC_INTER(S0, 0); SC_INTER(S1, 1); SC_INTER(S2, 2); SC_INTER(S3, 3);
            { const size_t e0 = ((size_t)b * SEQ + 64 * n + l31) * GVW + h * 256 + 128 * half + 32 * wave + 4 * hi;
#pragma unroll
              for (int g = 0; g < 4; ++g) {
                  v2u w; w.x = cvtpk(i0[4 * g], i0[4 * g + 1]); w.y = cvtpk(i0[4 * g + 2], i0[4 * g + 3]); *(v2u*)(OS + e0 + 8 * g) = w;
                  v2u w1; w1.x = cvtpk(i1[4 * g], i1[4 * g + 1]); w1.y = cvtpk(i1[4 * g + 2], i1[4 * g + 3]); *(v2u*)(OS + e0 + (size_t)32 * GVW + 8 * g) = w1; } }
            const LAS unsigned char* kb_ = sg + SC_K + l31 * 144 + 16 * hi; const LAS unsigned char* vb_ = sg + SC_V + (32 * wave + l31) * 144 + 16 * hi;
            bf16x8 vf[4];
#pragma unroll
            for (int s = 0; s < 4; ++s) vf[s] = *(const LAS bf16x8*)(vb_ + 32 * s);
            SC_UPD(S0, 0); SC_UPD(S1, 1); SC_UPD(S2, 2); SC_UPD(S3, 3);
            WG_BAR();
        }
    }
#undef SC_INTER
#undef SC_UPD
#undef SC_CHUNK
#undef SC_LOAD
#undef SC_WRITE
}

struct AttnBufs { const bf16* AQ; const bf16* AK; const bf16* AV; const float* BIAS2; bf16* OP; float* LSE; };
constexpr int AT_VP = 784;
constexpr int AT_BT = 64 * AT_VP;
__device__ __forceinline__ void attn_unit(int u, const AttnBufs& A, LAS unsigned char* lds, int tid, int lane, int wave) {
    const int bh = u / 48, w48 = u % 48, p = w48 >> 4, idx = w48 & 15;
    const int b = bh >> 4, h = bh & 15;
    const int r = (p == 0) ? 1 : (p == 1 ? 4 : 16), L = SEQ / r;
    const int j = (p == 0) ? 0 : (p == 1 ? (idx >> 2) : idx), kb = (p == 0) ? idx : (p == 1 ? (idx & 3) : 0);
    const int l31 = lane & 31, hi = lane >> 5;
    const size_t tb = (size_t)b * SEQ;
    WG_BAR();
    for (int e = tid; e < 4 * 196; e += NWAVES * 64) { const int c = e / 196, i = e % 196, dl = i + c - 95;
        float v = -INFINITY; if (dl >= -64 && dl <= 64) v = A.BIAS2[(p * 129 + dl + 64) * 16 + h];
        ((LAS float*)(lds + AT_BT))[e] = v; }
    {
        const int wbase = kb * 256 - 64;
#pragma unroll
        for (int grp = 0; grp < 3; ++grp) { const int kk0 = 2 * (64 * grp + lane); const int sp0 = wbase + kk0, sp1 = sp0 + 1;
            v4u a = {0u, 0u, 0u, 0u}, c2 = {0u, 0u, 0u, 0u};
            if (sp0 >= 0 && sp0 < L) a = *(const v4u*)(A.AV + (tb + (size_t)sp0 * r + j) * AW + h * AD + 8 * wave);
            if (sp1 >= 0 && sp1 < L) c2 = *(const v4u*)(A.AV + (tb + (size_t)sp1 * r + j) * AW + h * AD + 8 * wave);
            const int w16 = kk0 & 15, slot = (kk0 & ~15) | (w16 & 3) | (((w16 >> 3) & 1) << 2) | (((w16 >> 2) & 1) << 3);
            LAS unsigned char* dst = lds + (8 * wave) * AT_VP + slot * 2;
            *(LAS unsigned*)(dst + 0 * AT_VP) = (a.x & 0xffffu) | (c2.x << 16);
            *(LAS unsigned*)(dst + 1 * AT_VP) = (a.x >> 16) | (c2.x & 0xffff0000u);
            *(LAS unsigned*)(dst + 2 * AT_VP) = (a.y & 0xffffu) | (c2.y << 16);
            *(LAS unsigned*)(dst + 3 * AT_VP) = (a.y >> 16) | (c2.y & 0xffff0000u);
            *(LAS unsigned*)(dst + 4 * AT_VP) = (a.z & 0xffffu) | (c2.z << 16);
            *(LAS unsigned*)(dst + 5 * AT_VP) = (a.z >> 16) | (c2.z & 0xffff0000u);
            *(LAS unsigned*)(dst + 6 * AT_VP) = (a.w & 0xffffu) | (c2.w << 16);
            *(LAS unsigned*)(dst + 7 * AT_VP) = (a.w >> 16) | (c2.w & 0xffff0000u); }
    }
    WG_BAR();
    const int i0 = kb * 256 + 32 * wave;
    const size_t tq = tb + (size_t)(i0 + l31) * r + j;
    bf16x8 qf[4];
#pragma unroll
    for (int d0 = 0; d0 < 4; ++d0) qf[d0] = *(const bf16x8*)(A.AQ + tq * AW + h * AD + 16 * d0 + 8 * hi);
    f32x16 S[5];
    const int cshift = 3 - (l31 & 3);
    const LAS unsigned char* btl = lds + AT_BT + cshift * AT_VP + (4 * hi + 28 - 4 * (l31 >> 2)) * 4;
    float m = -INFINITY;
#pragma unroll
    for (int t = 0; t < 5; ++t) { const int sb = i0 - 64 + 32 * t;
        if (sb >= 0 && sb < L) {
            const bf16* kp = A.AK + (tb + (size_t)(sb + l31) * r + j) * AW + h * AD + 8 * hi;
            f32x16 acc = {};
#pragma unroll
            for (int d0 = 0; d0 < 4; ++d0) { const bf16x8 kf = *(const bf16x8*)(kp + 16 * d0); acc = MFMA32(kf, qf[d0], acc); }
#pragma unroll
            for (int g = 0; g < 4; ++g) { const f32x4 bv = *(const LAS f32x4*)(btl + (32 * t + 8 * g) * 4);
#pragma unroll
                for (int i = 0; i < 4; ++i) { acc[4 * g + i] += bv[i]; m = fmaxf(m, acc[4 * g + i]); } }
            S[t] = acc;
        } else {
#pragma unroll
            for (int i = 0; i < 16; ++i) S[t][i] = -INFINITY;
        } }
    m = fmaxf(m, __shfl_xor(m, 32));
    float ssum = 0.f;
#pragma unroll
    for (int t = 0; t < 5; ++t)
#pragma unroll
        for (int i = 0; i < 16; ++i) { const float e = exp2f(S[t][i] - m); S[t][i] = e; ssum += e; }
    ssum += __shfl_xor(ssum, 32);
    f32x16 o0 = {}, o1 = {};
    const LAS unsigned char* vb = lds + l31 * AT_VP + (32 * wave) * 2 + 16 * hi;
#pragma unroll
    for (int t = 0; t < 5; ++t) { const int sb = i0 - 64 + 32 * t;
        if (sb >= 0 && sb < L) {
            const bf16x8 p0 = pack8<0>(S[t]), p1 = pack8<1>(S[t]);
            const bf16x8 v00 = *(const LAS bf16x8*)(vb + (32 * t) * 2), v01 = *(const LAS bf16x8*)(vb + (32 * t + 16) * 2);
            const bf16x8 v10 = *(const LAS bf16x8*)(vb + 32 * AT_VP + (32 * t) * 2), v11 = *(const LAS bf16x8*)(vb + 32 * AT_VP + (32 * t + 16) * 2);
            o0 = MFMA32(v00, p0, o0); o0 = MFMA32(v01, p1, o0);
            o1 = MFMA32(v10, p0, o1); o1 = MFMA32(v11, p1, o1);
        } }
    const float inv = 1.0f / ssum;
    { bf16* ob = A.OP + (size_t)p * ((size_t)T_ * AW) + tq * AW + h * AD + 4 * hi;
#pragma unroll
      for (int g = 0; g < 4; ++g) { v2u w; w.x = cvtpk(o0[4 * g] * inv, o0[4 * g + 1] * inv); w.y = cvtpk(o0[4 * g + 2] * inv, o0[4 * g + 3] * inv); *(v2u*)(ob + 8 * g) = w;
          v2u w1; w1.x = cvtpk(o1[4 * g] * inv, o1[4 * g + 1] * inv); w1.y = cvtpk(o1[4 * g + 2] * inv, o1[4 * g + 3] * inv); *(v2u*)(ob + 32 + 8 * g) = w1; } }
    if (hi == 0) A.LSE[(size_t)p * ((size_t)T_ * AH) + tq * AH + h] = m + log2f(ssum);
}
__global__ void __launch_bounds__(NWAVES * 64, 2) fwd(Args args) {
    extern __shared__ __attribute__((aligned(16))) unsigned char lds_raw[];
    LAS unsigned char* lds = (LAS unsigned char*)lds_raw;
    const int tid = threadIdx.x, lane = tid & 63, wave = __builtin_amdgcn_readfirstlane(tid >> 6);
    const int G = gridDim.x; const int bx = blockIdx.x; const int vcu = (G % 8 == 0) ? (bx % 8) * (G / 8) + bx / 8 : bx;
    const int gw = vcu * NWAVES + wave, NGW = G * NWAVES;
    unsigned char* ws = args.ws;
    const float* x = args.in[0]; float* out = args.out;
    bf16* Wt_in = (bf16*)(ws + WS_WIN); bf16* Wt_out = (bf16*)(ws + WS_WOUT); bf16* Wt_gu = (bf16*)(ws + WS_WGU); bf16* Wt_dn = (bf16*)(ws + WS_WDN);
    bf16* XN = (bf16*)(ws + WS_XN); bf16* RB = (bf16*)(ws + WS_RB);
    float* BIAS2 = (float*)(ws + WS_BIAS2); float* SSQ1 = (float*)(ws + WS_SSQ1);
    float* GLR = (float*)(RB + E_GLR);
    GlaBufs GB;
    GB.GQ = RB + E_GQ; GB.GK = RB + E_GK; GB.GVT = RB + E_GVT; GB.GLR = GLR;
    GB.OI = (bf16*)(ws + WS_XN); GB.QINF = GB.OI + (size_t)T_ * 1024; GB.QINB = GB.QINF + (size_t)T_ * 512;
    GB.KETF = (bf16*)(ws + WS_WIN); GB.KETB = GB.KETF + (size_t)T_ * 512;
    GB.DECF = (float*)(ws + WS_WIN + 16 * MiB); GB.DECB = GB.DECF + 128 * 512;
    GB.OSF = RB + E_GQ; GB.OSB = (bf16*)((unsigned char*)out + 48 * MiB);
    GB.gwF = args.in[4]; GB.gbF = args.in[5]; GB.gwB = args.in[6]; GB.gbB = args.in[7];
    bf16* Y = RB;
    bf16* X1B = (bf16*)(ws + WS_XN);
    bf16* HB = RB;
    AttnBufs AB; AB.AQ = RB + E_AQ; AB.AK = RB + E_AK; AB.AV = RB + E_AV; AB.BIAS2 = BIAS2;
    AB.OP = (bf16*)out; AB.LSE = (float*)(ws + WS_WIN + 17 * MiB);
    const int lo = args.ph_lo, hi = args.ph_hi;
#define IN(k) (lo <= (k) && (k) < hi)
#define SEAM(k) do { if (IN(k) && IN((k) + 1)) { cg::this_grid().sync(); } } while (0)

    if (IN(0)) {
        LAS float* scr = (LAS float*)(lds + wave * 16384);
        P0Ptrs PP; PP.w_in = args.in[2]; PP.w_out = args.in[9]; PP.w_gate = args.in[11]; PP.w_up = args.in[12]; PP.w_down = args.in[13]; PP.ffn_w = args.in[10];
        PP.Wt_in = Wt_in; PP.Wt_out = Wt_out; PP.Wt_gu = Wt_gu; PP.Wt_dn = Wt_dn;
        {
            P0Item Ic, In; f32x4 rc[8], rn[8];
            int it = gw;
            if (it < P0_NITEMS) { p0_decode(it, PP, Ic); p0_load(Ic, rc, lane); }
            while (it < P0_NITEMS) {
                const int nx = it + NGW;
                if (nx < P0_NITEMS) { p0_decode(nx, PP, In); p0_load(In, rn, lane); }
                p0_store(Ic, rc, scr, lane);
                Ic = In;
#pragma unroll
                for (int i = 0; i < 8; ++i) rc[i] = rn[i];
                it = nx;
            }
        }
        const float* nw = args.in[1];
        for (int m = gw; m < T_; m += NGW) {
            const f32x4* xr = (const f32x4*)(x + (size_t)m * DM) + lane; f32x4 v[8]; float s = 0.f;
#pragma unroll
            for (int j = 0; j < 8; ++j) { v[j] = xr[64 * j]; s += (v[j][0] * v[j][0] + v[j][1] * v[j][1]) + (v[j][2] * v[j][2] + v[j][3] * v[j][3]); }
            const float rstd = rsqrtf(wave_sum(s) * (1.f / DM) + NORM_EPS);
            v2u* o8 = (v2u*)(XN + (size_t)m * DM) + lane;
#pragma unroll
            for (int j = 0; j < 8; ++j) { const f32x4 w = ((const f32x4*)nw)[lane + 64 * j]; v2u o; o.x = pk2(v[j][0] * rstd * w[0], v[j][1] * rstd * w[1]); o.y = pk2(v[j][2] * rstd * w[2], v[j][3] * rstd * w[3]); o8[64 * j] = o; }
        }
        if (bx == 0) {
            const float* tbl = args.in[3];
            for (int idx = tid; idx < 3 * 129; idx += NWAVES * 64) { const int p = idx / 129, s = idx % 129; const int r = (p == 0) ? 1 : (p == 1 ? 4 : 16);
                const int bk = t5_bucket((s - 64) * r);
                for (int h = 0; h < 16; ++h) BIAS2[idx * 16 + h] = tbl[bk * 16 + h] * LOG2E; }
        }
    }
    SEAM(0);

    if (IN(1)) {
        { pg8::Gemm g{XN, Wt_in, T_, 5120, DM}; pg8::StaticOrder S; S.init(T_, 5120, G, bx); pg8::EpiProj E{RB};
          pg8::gemm_phase<pg8::EpiProj, pg8::StaticOrder, true, true>(lds, g, S, E); }
        { pg8::Gemm g{Wt_in + (size_t)5120 * DM, XN, 1024, T_, DM}; pg8::StaticOrder S; S.init(1024, T_, G, (bx + G / 2) % G); pg8::EpiPlain E{RB + E_GVT, T_};
          pg8::gemm_phase<pg8::EpiPlain, pg8::StaticOrder, true, true>(lds, g, S, E); }
        for (int tb = bx; tb < T_ / 32; tb += G) {
            const int l31 = lane & 31, hi5 = lane >> 5;
            const bf16* ap = XN + (size_t)(tb * 32 + l31) * DM + 256 * wave + 8 * hi5; const bf16* bp = Wt_in + (size_t)(6144 + l31) * DM + 256 * wave + 8 * hi5;
            bf16x8 af[16], bfr[16];
#pragma unroll
            for (int s = 0; s < 16; ++s) { af[s] = *(const bf16x8*)(ap + 16 * s); bfr[s] = *(const bf16x8*)(bp + 16 * s); }
            f32x16 acc = {};
#pragma unroll
            for (int s = 0; s < 16; ++s) acc = MFMA32(af[s], bfr[s], acc);
            __syncthreads();
            LAS float* part = (LAS float*)lds;
#pragma unroll
            for (int r = 0; r < 16; ++r) part[(wave * 16 + r) * 64 + lane] = acc[r];
            __syncthreads();
#pragma unroll
            for (int rr = 0; rr < 2; ++rr) { const int r = 2 * wave + rr; float s = 0.f;
#pragma unroll
                for (int w = 0; w < 8; ++w) s += part[(w * 16 + r) * 64 + lane];
                GLR[(size_t)(tb * 32 + crow(r, hi5)) * 32 + l31] = s; }
        }
    }
    SEAM(1);

    if (IN(2)) {
        for (int it = bx; it < 512; it += G) gla_unit(it, GB, lds, tid, lane, wave);
    }
    SEAM(2);

    if (IN(3)) {
        if (G > 64) { if (bx < 32) gla_scan(bx, GB, lds, tid, lane, wave); else for (int u = bx - 32; u < 1536; u += G - 32) attn_unit(u, AB, lds, tid, lane, wave); }
        else { for (int it = bx; it < 32; it += G) gla_scan(it, GB, lds, tid, lane, wave); for (int u = bx; u < 1536; u += G) attn_unit(u, AB, lds, tid, lane, wave); }
    }
    SEAM(3);

    if (IN(4)) {
        const bf16* GR = RB + E_GR; const float* gnw = args.in[8];
        for (int item = gw; item < T_ * 8; item += NGW) { const int row = item >> 3, part = item & 7;
            if (part < 4) {
                const int hh = 4 * part + (lane >> 4); const size_t eo = (size_t)row * AW + part * 256 + lane * 4;
                const float l0 = AB.LSE[(size_t)row * AH + hh], l1 = AB.LSE[(size_t)T_ * AH + (size_t)row * AH + hh], l2 = AB.LSE[(size_t)2 * T_ * AH + (size_t)row * AH + hh];
                const float M = fmaxf(fmaxf(l0, l1), l2); const float w0 = exp2f(l0 - M), w1 = exp2f(l1 - M), w2 = exp2f(l2 - M); const float iw = 1.0f / (w0 + w1 + w2);
                const v2u a0 = *(const v2u*)(AB.OP + eo), a1 = *(const v2u*)(AB.OP + (size_t)T_ * AW + eo), a2 = *(const v2u*)(AB.OP + (size_t)2 * T_ * AW + eo);
                const float y0 = (w0 * bflo(a0.x) + w1 * bflo(a1.x) + w2 * bflo(a2.x)) * iw, y1 = (w0 * bfhi(a0.x) + w1 * bfhi(a1.x) + w2 * bfhi(a2.x)) * iw;
                const float y2 = (w0 * bflo(a0.y) + w1 * bflo(a1.y) + w2 * bflo(a2.y)) * iw, y3 = (w0 * bfhi(a0.y) + w1 * bfhi(a1.y) + w2 * bfhi(a2.y)) * iw;
                v2u ov; ov.x = pk2(y0, y1); ov.y = pk2(y2, y3);
                *(v2u*)(Y + (size_t)row * DM + part * 256 + lane * 4) = ov;
            } else { const int h = part - 4; const size_t o = (size_t)row * GVW + h * 256;
                const v2u a = ((const v2u*)(GB.OI + o))[lane], c = ((const v2u*)(GB.OSF + o))[lane], e = ((const v2u*)(GB.OSB + o))[lane], g = ((const v2u*)(GR + o))[lane];
                float v[4] = {bflo(a.x) + bflo(c.x) + bflo(e.x), bfhi(a.x) + bfhi(c.x) + bfhi(e.x), bflo(a.y) + bflo(c.y) + bflo(e.y), bfhi(a.y) + bfhi(c.y) + bfhi(e.y)};
                const float gr[4] = {bflo(g.x), bfhi(g.x), bflo(g.y), bfhi(g.y)};
                const float ss = wave_sum((v[0] * v[0] + v[1] * v[1]) + (v[2] * v[2] + v[3] * v[3]));
                const float rstd = rsqrtf(ss * (1.0f / 256.0f) + NORM_EPS);
                const f32x4 w = ((const f32x4*)(gnw + h * 256))[lane];
                float y[4];
#pragma unroll
                for (int i = 0; i < 4; ++i) y[i] = v[i] * rstd * w[i] * (gr[i] / (1.0f + __expf(-gr[i])));
                v2u ov; ov.x = pk2(y[0], y[1]); ov.y = pk2(y[2], y[3]);
                ((v2u*)(Y + (size_t)row * DM + 1024 + h * 256))[lane] = ov; }
        }
    }
    SEAM(4);

    if (IN(5)) {
        pg8::Gemm g{Y, Wt_out, T_, DM, DM}; pg8::StaticOrder S; S.init(T_, DM, G, bx); pg8::EpiRes<true> E{x, out, X1B, SSQ1};
        pg8::gemm_phase<pg8::EpiRes<true>, pg8::StaticOrder, false, true>(lds, g, S, E);
    }
    SEAM(5);

    if (IN(6)) {
        pg8::Gemm g{X1B, Wt_gu, T_, 2 * FF, DM}; pg8::StaticOrder S; S.init(T_, 2 * FF, G, bx); pg8::EpiSwiglu E{HB, SSQ1};
        pg8::gemm_phase<pg8::EpiSwiglu, pg8::StaticOrder, true, true>(lds, g, S, E);
    }
    SEAM(6);

    if (IN(7)) {
        pg8::Gemm g{HB, Wt_dn, T_, DM, FF}; pg8::StaticOrder S; S.init(T_, DM, G, bx); pg8::EpiRes<false> E{out, out, nullptr, nullptr};
        pg8::gemm_phase<pg8::EpiRes<false>, pg8::StaticOrder, false, true>(lds, g, S, E);
    }
    SEAM(7);

    if (IN(8)) {
        const float* fw = args.in[14];
        for (int m = gw; m < T_; m += NGW) {
            f32x4* xr = (f32x4*)(out + (size_t)m * DM) + lane; f32x4 v[8]; float s = 0.f;
#pragma unroll
            for (int j = 0; j < 8; ++j) { v[j] = xr[64 * j]; s += (v[j][0] * v[j][0] + v[j][1] * v[j][1]) + (v[j][2] * v[j][2] + v[j][3] * v[j][3]); }
            const float rstd = rsqrtf(wave_sum(s) * (1.f / DM) + NORM_EPS);
#pragma unroll
            for (int j = 0; j < 8; ++j) { const f32x4 w = ((const f32x4*)fw)[lane + 64 * j]; xr[64 * j] = v[j] * rstd * w; }
        }
    }
#undef IN
#undef SEAM
}

extern "C" void kernel_launch(void* const* d_in, const int* in_sizes, int n_in, void* d_out, int out_size, void* d_ws, size_t ws_size, hipStream_t stream) {
    static int grid = 0;
    if (grid == 0) {
        if (n_in != 15 || out_size != T_ * DM || ws_size < WS_END) { fprintf(stderr, "kernel_launch: unexpected shapes (n_in %d out %d ws %zu)\n", n_in, out_size, ws_size); grid = -1; return; }
        int dev = 0, cus = 0, per_cu = 0;
        if (hipGetDevice(&dev) != hipSuccess || hipDeviceGetAttribute(&cus, hipDeviceAttributeMultiprocessorCount, dev) != hipSuccess) { grid = -1; return; }
        if (hipFuncSetAttribute((const void*)fwd, hipFuncAttributeMaxDynamicSharedMemorySize, LDS_BYTES) != hipSuccess) { fprintf(stderr, "kernel_launch: hipFuncSetAttribute failed\n"); grid = -1; return; }
        if (hipOccupancyMaxActiveBlocksPerMultiprocessor(&per_cu, (const void*)fwd, NWAVES * 64, LDS_BYTES) != hipSuccess || per_cu < 1) { fprintf(stderr, "kernel_launch: occupancy query reports %d\n", per_cu); per_cu = 1; }
        (void)hipGetLastError();
        grid = cus;
    }
    if (grid < 0) return;
    Args a{};
    for (int i = 0; i < 15; ++i) a.in[i] = (const float*)d_in[i];
    a.out = (float*)d_out; a.ws = (unsigned char*)d_ws;
#if MK_LAUNCHES == 1
    void* kargs[] = {&a};
#if PROBE_PREFIX > 0
    a.ph_lo = 0; a.ph_hi = PROBE_PREFIX;
    (void)hipLaunchCooperativeKernel((const void*)fwd, dim3(grid), dim3(NWAVES * 64), kargs, LDS_BYTES, stream);
#endif
    a.ph_lo = 0; a.ph_hi = NPHASE;
    hipError_t e = hipLaunchCooperativeKernel((const void*)fwd, dim3(grid), dim3(NWAVES * 64), kargs, LDS_BYTES, stream);
    if (e != hipSuccess) fprintf(stderr, "kernel_launch: cooperative launch failed: %s (grid %d)\n", hipGetErrorString(e), grid);
#else
    for (int p = 0; p < NPHASE; ++p) { a.ph_lo = p; a.ph_hi = p + 1; hipLaunchKernelGGL(fwd, dim3(grid), dim3(NWAVES * 64), LDS_BYTES, stream, a); }
#endif
}
```

```cpp
#include <hip/hip_runtime.h>
#include <hip/hip_cooperative_groups.h>
#include <cstdio>
#include <cstdint>
namespace cg = cooperative_groups;

namespace pg8 {
#define PG8_LAS __attribute__((address_space(3)))
typedef unsigned short bf16_t;
typedef short bf16x8 __attribute__((ext_vector_type(8)));
typedef float f32x4 __attribute__((ext_vector_type(4)));
typedef unsigned u32x4 __attribute__((ext_vector_type(4)));
constexpr int BM = 256, BK = 64, HALF = 128, HTB = HALF * BK * 2  , STAGE_BYTES = 8 * HTB, NXCD = 8, WGM = 8;

__host__ __device__ __forceinline__ int lds_byte(int r, int c) { const int st = (r >> 4) * 2 + (c >> 5), rr = r & 15, cc = c & 31, ob = rr * 64 + cc * 2; return st * 1024 + (ob ^ (((ob >> 9) & 1) << 5)); }
__host__ __device__ __forceinline__ void stage_rc(int b, int& R, int& C) { const int st = b / 1024, sb = b % 1024, swz = sb ^ (((sb >> 9) & 1) << 5); R = (st >> 1) * 16 + swz / 64; C = (st & 1) * 32 + (swz % 64) / 2; }
__host__ __device__ __forceinline__ int perm32(int rho) { const int n = rho >> 4, i = rho & 15; return 8 * (i >> 2) + 4 * n + (i & 3); }

struct Unit { int pm, pn; };
struct Gemm { const bf16_t* A; const bf16_t* Bt; int M, N, K; };

struct StaticOrder {
    int nM, nN, nwg, G, c;
    __host__ __device__ void init(int M, int N, int G_, int c_) { nM = M / BM; nN = N / BM; nwg = nM * nN; G = G_; c = c_; }
    __host__ __device__ bool next(int i, Unit& u) const {
        const long L = (long)i * G + c; if (L >= nwg) return false;
        int wgid = (int)L; { const int q = nwg / NXCD, r = nwg % NXCD, xcd = wgid % NXCD, off = wgid / NXCD; wgid = (xcd < r ? xcd * (q + 1) : r * (q + 1) + (xcd - r) * q) + off; }
        const int nig = WGM * nN, gid = wgid / nig, fm = gid * WGM, gsz = (nM - fm) < WGM ? (nM - fm) : WGM;
        u.pm = fm + ((wgid % nig) % gsz); u.pn = (wgid % nig) / gsz; return true;
    }
    __device__ __forceinline__ void a_ready(const Unit&) const {}
    __device__ __forceinline__ void done(const Unit&) const {}
};

__device__ __forceinline__ unsigned cvt_pk_bf16(float lo, float hi) { unsigned r; asm volatile("v_cvt_pk_bf16_f32 %0, %1, %2" : "=v"(r) : "v"(lo), "v"(hi)); return r; }
template <class Epi, class Sched, bool ALIGN_EPI = false, bool SP2 = false>
__device__ __forceinline__ void gemm_phase(PG8_LAS unsigned char* lds, const Gemm g, const Sched& S, const Epi& E) {
    const int tid = threadIdx.x, wid = __builtin_amdgcn_readfirstlane(tid >> 6), lane = tid & 63, wr = wid >> 2, wc = wid & 3, fr = lane & 15, fq = lane >> 4;
    const int K = g.K, nt = K / BK;
    unsigned voffA[2], voffB[2];
#pragma unroll
    for (int i = 0; i < 2; ++i) { int R, C; stage_rc(tid * 16 + i * 8192, R, C); const int Rb = Epi::PERM ? ((R & ~31) + perm32(R & 31)) : R;
        voffA[i] = (unsigned)(R * K + C) * 2u; voffB[i] = (unsigned)(Rb * K + C) * 2u; }
    const size_t kstep = (size_t)(BK * 2);
    const size_t hstep = (size_t)HALF * K * 2;
    const size_t tstep = 2 * hstep;
    const unsigned ldsw = (unsigned)wid * 1024u;
    const int aoff = lds_byte(wr * 64 + fr, fq * 8), boff = lds_byte(wc * 32 + fr, fq * 8);
#define PG8_SA(b, h) (((b) * 2 + (h)) * HTB)
#define PG8_SB(b, h) ((4 + (b) * 2 + (h)) * HTB)
#define PG8_STAGE(bufoff, gbase, voff) do { _Pragma("unroll") for (int _i = 0; _i < 2; ++_i) \
        __builtin_amdgcn_global_load_lds((const unsigned*)((const char*)(gbase) + (voff)[_i]), (PG8_LAS unsigned*)(lds + (bufoff) + ldsw + _i * 8192), 16, 0, 0); } while (0)
#define PG8_LDA(dst, b, h) do { _Pragma("unroll") for (int m = 0; m < 4; ++m) _Pragma("unroll") for (int k = 0; k < 2; ++k) dst[m][k] = *(const PG8_LAS bf16x8*)(lds + PG8_SA(b, h) + aoff + m * 2048 + k * 1024); } while (0)
#define PG8_LDB(dst, b, h) do { _Pragma("unroll") for (int n = 0; n < 2; ++n) _Pragma("unroll") for (int k = 0; k < 2; ++k) dst[n][k] = *(const PG8_LAS bf16x8*)(lds + PG8_SB(b, h) + boff + n * 2048 + k * 1024); } while (0)
#define PG8_MMA(ai, bj, At, Bt) do { __builtin_amdgcn_s_setprio(1); _Pragma("unroll") for (int m = 0; m < 4; ++m) _Pragma("unroll") for (int n = 0; n < 2; ++n) _Pragma("unroll") for (int k = 0; k < 2; ++k) \
        acc[ai][bj][m][n] = __builtin_amdgcn_mfma_f32_16x16x32_bf16(Bt[n][k], At[m][k], acc[ai][bj][m][n], 0, 0, 0); __builtin_amdgcn_s_setprio(0); } while (0)
#define PG8_WAIT_V(n) asm volatile("s_waitcnt vmcnt(" #n ")" ::: "memory")
#define PG8_WAIT_L(n) asm volatile("s_waitcnt lgkmcnt(" #n ")" ::: "memory")
#define PG8_BAR __builtin_amdgcn_s_barrier()
#define PG8_SCHED __builtin_amdgcn_sched_barrier(0)
    Unit cur, nxt; int ui = 0;
    if (!S.next(0, cur)) return;
    f32x4 acc[2][2][4][2];
#pragma unroll
    for (int a = 0; a < 2; ++a)
#pragma unroll
        for (int b = 0; b < 2; ++b)
#pragma unroll
            for (int m = 0; m < 4; ++m)
#pragma unroll
                for (int n = 0; n < 2; ++n) acc[a][b][m][n] = (f32x4){0.f, 0.f, 0.f, 0.f};
    bf16x8 At[4][2], B0[2][2], B1[2][2];
    const char* cA = (const char*)g.A + (size_t)cur.pm * tstep; const char* cB = (const char*)g.Bt + (size_t)cur.pn * tstep;
    S.a_ready(cur);
    if constexpr (SP2) {
        PG8_STAGE(PG8_SB(0, 0), cB, voffB); PG8_STAGE(PG8_SB(0, 1), cB + hstep, voffB); PG8_STAGE(PG8_SA(0, 0), cA, voffA); PG8_STAGE(PG8_SA(0, 1), cA + hstep, voffA);
        if (wr == 1) PG8_BAR;
        PG8_WAIT_V(2); PG8_BAR;
        PG8_STAGE(PG8_SB(1, 0), cB + kstep, voffB); PG8_STAGE(PG8_SA(1, 0), cA + kstep, voffA); PG8_STAGE(PG8_SB(1, 1), cB + hstep + kstep, voffB);
        PG8_WAIT_V(6); PG8_BAR;
    } else {
        PG8_STAGE(PG8_SB(0, 0), cB, voffB); PG8_STAGE(PG8_SA(0, 0), cA, voffA); PG8_STAGE(PG8_SB(0, 1), cB + hstep, voffB); PG8_STAGE(PG8_SA(0, 1), cA + hstep, voffA);
        if (wr == 1) PG8_BAR;
        PG8_WAIT_V(4); PG8_BAR;
        PG8_STAGE(PG8_SB(1, 0), cB + kstep, voffB); PG8_STAGE(PG8_SA(1, 0), cA + kstep, voffA); PG8_STAGE(PG8_SB(1, 1), cB + hstep + kstep, voffB);
        PG8_WAIT_V(6); PG8_BAR;
    }
    for (;;) {
        const bool has_next = S.next(ui + 1, nxt);
        const char* nA = has_next ? (const char*)g.A + (size_t)nxt.pm * tstep : cA; const char* nB = has_next ? (const char*)g.Bt + (size_t)nxt.pn * tstep : cB;
        for (int t = 0; t < nt; t += 2) {
            const bool last = (t == nt - 2);
            const char* a1 = cA + (size_t)(t + 1) * kstep;
            const char* a2 = last ? nA : cA + (size_t)(t + 2) * kstep; const char* b2 = last ? nB : cB + (size_t)(t + 2) * kstep;
            const char* a3 = a2 + kstep; const char* b3 = b2 + kstep;
            if (last && has_next) S.a_ready(nxt);
            if constexpr (SP2) {
            PG8_LDB(B0, 0, 0); PG8_LDB(B1, 0, 1); PG8_SCHED; PG8_LDA(At, 0, 0); PG8_STAGE(PG8_SA(1, 1), a1 + hstep, voffA);
            PG8_WAIT_V(8); PG8_WAIT_L(0); PG8_BAR; PG8_MMA(0, 0, At, B0); PG8_MMA(0, 1, At, B1); PG8_BAR; PG8_SCHED;
            PG8_LDA(At, 0, 1); PG8_STAGE(PG8_SB(0, 0), b2, voffB); PG8_STAGE(PG8_SB(0, 1), b2 + hstep, voffB); PG8_STAGE(PG8_SA(0, 0), a2, voffA);
            PG8_WAIT_V(8); PG8_WAIT_L(0); PG8_BAR; PG8_MMA(1, 0, At, B0); PG8_MMA(1, 1, At, B1); PG8_BAR; PG8_SCHED;
            PG8_LDB(B0, 1, 0); PG8_LDB(B1, 1, 1); PG8_SCHED; PG8_LDA(At, 1, 0); PG8_STAGE(PG8_SA(0, 1), a2 + hstep, voffA);
            PG8_WAIT_V(8); PG8_WAIT_L(0); PG8_BAR; PG8_MMA(0, 0, At, B0); PG8_MMA(0, 1, At, B1); PG8_BAR; PG8_SCHED;
            PG8_LDA(At, 1, 1); PG8_STAGE(PG8_SB(1, 0), b3, voffB); PG8_STAGE(PG8_SB(1, 1), b3 + hstep, voffB); PG8_STAGE(PG8_SA(1, 0), a3, voffA);
            PG8_WAIT_V(8); PG8_WAIT_L(0); PG8_BAR; PG8_MMA(1, 0, At, B0); PG8_MMA(1, 1, At, B1); PG8_BAR; PG8_SCHED;
            } else {
            PG8_LDB(B0, 0, 0); PG8_SCHED; PG8_LDA(At, 0, 0); PG8_STAGE(PG8_SA(1, 1), a1 + hstep, voffA);
            PG8_WAIT_L(8); PG8_BAR; PG8_WAIT_L(0); PG8_MMA(0, 0, At, B0); PG8_BAR; PG8_SCHED;
            PG8_LDB(B1, 0, 1); PG8_STAGE(PG8_SB(0, 0), b2, voffB);
            PG8_BAR; PG8_WAIT_L(0); PG8_MMA(0, 1, At, B1); PG8_BAR;
            PG8_LDA(At, 0, 1); PG8_STAGE(PG8_SA(0, 0), a2, voffA);
            PG8_BAR; PG8_WAIT_L(0); PG8_MMA(1, 0, At, B0); PG8_BAR; PG8_SCHED;
            PG8_STAGE(PG8_SB(0, 1), b2 + hstep, voffB);
            PG8_WAIT_V(6); PG8_BAR; PG8_MMA(1, 1, At, B1); PG8_BAR;
            PG8_LDB(B0, 1, 0); PG8_SCHED; PG8_LDA(At, 1, 0); PG8_STAGE(PG8_SA(0, 1), a2 + hstep, voffA);
            PG8_WAIT_L(8); PG8_BAR; PG8_WAIT_L(0); PG8_MMA(0, 0, At, B0); PG8_BAR; PG8_SCHED;
            PG8_LDB(B1, 1, 1); PG8_STAGE(PG8_SB(1, 0), b3, voffB);
            PG8_BAR; PG8_WAIT_L(0); PG8_MMA(0, 1, At, B1); PG8_BAR;
            PG8_LDA(At, 1, 1); PG8_STAGE(PG8_SA(1, 0), a3, voffA);
            PG8_BAR; PG8_WAIT_L(0); PG8_MMA(1, 0, At, B0); PG8_BAR; PG8_SCHED;
            PG8_STAGE(PG8_SB(1, 1), b3 + hstep, voffB);
            PG8_WAIT_V(6); PG8_BAR; PG8_MMA(1, 1, At, B1); PG8_BAR;
            }
        }
        if constexpr (ALIGN_EPI) { if (wr == 0) PG8_BAR; }
        if constexpr (!Epi::AFTER_DRAIN) { E(acc, cur, wr, wc, fr, fq); S.done(cur); }
        if (!has_next) break;
#pragma unroll
        for (int a = 0; a < 2; ++a)
#pragma unroll
            for (int b = 0; b < 2; ++b)
#pragma unroll
                for (int m = 0; m < 4; ++m)
#pragma unroll
                    for (int n = 0; n < 2; ++n) acc[a][b][m][n] = (f32x4){0.f, 0.f, 0.f, 0.f};
        cur = nxt; cA = nA; cB = nB; ++ui;
        if constexpr (ALIGN_EPI) { if (wr == 1) PG8_BAR; }
    }
    PG8_WAIT_V(0);
    if constexpr (!ALIGN_EPI) { if (wr == 0) PG8_BAR; }
    PG8_BAR;
    if constexpr (Epi::AFTER_DRAIN) { E.fused(acc, cur, wr, wc, fr, fq, lds, wid, lane); S.done(cur); }
#undef PG8_SA
#undef PG8_SB
#undef PG8_STAGE
#undef PG8_LDA
#undef PG8_LDB
#undef PG8_MMA
#undef PG8_WAIT_V
#undef PG8_WAIT_L
#undef PG8_BAR
#undef PG8_SCHED
}
}

constexpr int SEQ = 4096, NB = 2, T_ = NB * SEQ, DM = 2048, INW = 6176, FF = 5632;
constexpr int AH = 16, AD = 64, AW = 1024;
constexpr int GH = 4, GDK = 128, GDV = 256, GKW = 512, GVW = 1024, GRANK = 16;
constexpr float NORM_EPS = 1e-6f;
constexpr float LOG2E = 1.4426950408889634f;
constexpr int NWAVES = 8;
constexpr int NPHASE = 9;
#ifndef PROBE_PREFIX
#define PROBE_PREFIX 0
#endif
#ifndef PROBE_TS
#define PROBE_TS 0
#endif
#ifndef PROBE_SCAN
#define PROBE_SCAN 0
#endif
#ifndef MK_LAUNCHES
#define MK_LAUNCHES 1
#endif

constexpr size_t MiB = 1u << 20;
constexpr size_t WS_CTL = 0;
constexpr size_t WS_BIAS2 = 64 * 1024;
constexpr size_t WS_SSQ1 = 128 * 1024;
constexpr size_t WS_WIN = 1 * MiB;
constexpr size_t WS_WOUT = 26 * MiB;
constexpr size_t WS_WGU = 34 * MiB;
constexpr size_t WS_WDN = 78 * MiB;
constexpr size_t WS_XN = 100 * MiB;
constexpr size_t WS_RB = 132 * MiB;
constexpr size_t WS_END = 229 * MiB;
constexpr size_t E_AQ = 0, E_AK = (size_t)T_ * 1024, E_AV = 2 * (size_t)T_ * 1024, E_GQ = 3 * (size_t)T_ * 1024, E_GK = E_GQ + (size_t)T_ * 512,
                 E_GVT = 4 * (size_t)T_ * 1024, E_GR = 5 * (size_t)T_ * 1024, E_GLR = 6 * (size_t)T_ * 1024;

#define GAS __attribute__((address_space(1)))
#define LAS __attribute__((address_space(3)))
typedef unsigned short bf16;
typedef unsigned v4u __attribute__((ext_vector_type(4)));
typedef unsigned v2u __attribute__((ext_vector_type(2)));
typedef float f32x4 __attribute__((ext_vector_type(4)));
#define LDS_WAIT() asm volatile("s_waitcnt lgkmcnt(0)" ::: "memory")
__device__ __forceinline__ unsigned f2bf(float f) { unsigned u = __builtin_bit_cast(unsigned, f); return (u + 0x7fffu + ((u >> 16) & 1u)) >> 16; }
__device__ __forceinline__ unsigned pk2(float lo, float hi) { return f2bf(lo) | (f2bf(hi) << 16); }
__device__ __forceinline__ float bf2f(unsigned b) { return __builtin_bit_cast(float, b << 16); }
__device__ __forceinline__ float bflo(unsigned w) { return __builtin_bit_cast(float, w << 16); }
__device__ __forceinline__ float bfhi(unsigned w) { return __builtin_bit_cast(float, w & 0xffff0000u); }
__device__ __forceinline__ float wave_sum(float v) {
#pragma unroll
    for (int o = 1; o < 64; o <<= 1) v += __shfl_xor(v, o);
    return v;
}
__device__ __forceinline__ float wave_max(float v) {
#pragma unroll
    for (int o = 1; o < 64; o <<= 1) v = fmaxf(v, __shfl_xor(v, o));
    return v;
}

namespace pg8 {
struct EpiProj {
    static constexpr bool PERM = true, AFTER_DRAIN = false;
    bf16_t* rb;
    __device__ __forceinline__ void operator()(const f32x4 (&acc)[2][2][4][2], const Unit& u, int wr, int wc, int fr, int fq) const {
        const int pn = u.pn; bf16_t* base; int ldc, colt;
        if (pn < 12) {
            bf16_t* mat = rb + (size_t)(pn >> 2) * ((size_t)T_ * 1024);
            const int row0 = u.pm * BM + wr * 64 + fr, colm = (pn & 3) * 256 + wc * 32 + 8 * fq;
#pragma unroll
            for (int ai = 0; ai < 2; ++ai)
#pragma unroll
                for (int m = 0; m < 4; ++m) { const int tg = row0 + ai * HALF + m * 16;
#pragma unroll
                    for (int bj = 0; bj < 2; ++bj) { const int col = colm + bj * HALF; const f32x4 v0 = acc[ai][bj][m][0], v1 = acc[ai][bj][m][1];
                        u32x4 w; w.x = cvt_pk_bf16(v0[0], v0[1]); w.y = cvt_pk_bf16(v0[2], v0[3]); w.z = cvt_pk_bf16(v1[0], v1[1]); w.w = cvt_pk_bf16(v1[2], v1[3]);
                        *(u32x4*)(mat + ((size_t)((tg >> 12) * 16 + (col >> 6)) * 4096 + (tg & 4095)) * 64 + (col & 63)) = w; } }
            return; }
        if (pn < 16) { base = rb + E_GQ + (size_t)((pn - 12) >> 1) * ((size_t)T_ * 512); ldc = 512; colt = ((pn - 12) & 1) * 256; }
        else { base = rb + E_GR; ldc = 1024; colt = (pn - 16) * 256; }
        const int row0 = u.pm * BM + wr * 64 + fr, col0 = colt + wc * 32 + 8 * fq;
#pragma unroll
        for (int ai = 0; ai < 2; ++ai)
#pragma unroll
            for (int m = 0; m < 4; ++m) { bf16_t* rowp = base + (size_t)(row0 + ai * HALF + m * 16) * ldc + col0;
#pragma unroll
                for (int bj = 0; bj < 2; ++bj) { const f32x4 v0 = acc[ai][bj][m][0], v1 = acc[ai][bj][m][1];
                    u32x4 w; w.x = cvt_pk_bf16(v0[0], v0[1]); w.y = cvt_pk_bf16(v0[2], v0[3]); w.z = cvt_pk_bf16(v1[0], v1[1]); w.w = cvt_pk_bf16(v1[2], v1[3]);
                    *(u32x4*)(rowp + bj * HALF) = w; } }
    }
};
struct EpiPlain {
    static constexpr bool PERM = true, AFTER_DRAIN = false;
    bf16_t* O; int nrows;
    __device__ __forceinline__ void operator()(const f32x4 (&acc)[2][2][4][2], const Unit& u, int wr, int wc, int fr, int fq) const {
        const int row0 = u.pm * BM + wr * 64 + fr, col0 = u.pn * BM + wc * 32 + 8 * fq;
#pragma unroll
        for (int ai = 0; ai < 2; ++ai)
#pragma unroll
            for (int m = 0; m < 4; ++m) { const int row = row0 + ai * HALF + m * 16;
#pragma unroll
                for (int bj = 0; bj < 2; ++bj) { const int col = col0 + bj * HALF; const f32x4 v0 = acc[ai][bj][m][0], v1 = acc[ai][bj][m][1];
                    u32x4 w; w.x = cvt_pk_bf16(v0[0], v0[1]); w.y = cvt_pk_bf16(v0[2], v0[3]); w.z = cvt_pk_bf16(v1[0], v1[1]); w.w = cvt_pk_bf16(v1[2], v1[3]);
                    *(u32x4*)(O + ((size_t)(col >> 6) * nrows + row) * 64 + (col & 63)) = w; } }
    }
};
template <bool AUX> struct EpiRes {
    static constexpr bool PERM = false, AFTER_DRAIN = true;
    const float* base; float* out; bf16_t* xb; float* ssq;
    __device__ __forceinline__ void fused(f32x4 (&acc)[2][2][4][2], const Unit& u, int wr, int wc, int fr, int fq, PG8_LAS unsigned char* lds, int wid, int lane) const {
        PG8_LAS float* P = (PG8_LAS float*)lds;
        const int col0 = u.pn * BM + wc * 32 + 4 * fq;
#pragma unroll
        for (int ai = 0; ai < 2; ++ai)
#pragma unroll
            for (int m = 0; m < 4; ++m) { const int rl = ai * HALF + wr * 64 + m * 16 + fr; const size_t off = (size_t)(u.pm * BM + rl) * DM + col0; float s = 0.f;
#pragma unroll
                for (int bj = 0; bj < 2; ++bj)
#pragma unroll
                    for (int n = 0; n < 2; ++n) { const f32x4 bs = *(const f32x4*)(base + off + bj * HALF + n * 16); const f32x4 v = bs + acc[ai][bj][m][n];
                        *(f32x4*)(out + off + bj * HALF + n * 16) = v;
                        if (AUX) { s += (v[0] * v[0] + v[1] * v[1]) + (v[2] * v[2] + v[3] * v[3]);
                            typedef unsigned u32x2 __attribute__((ext_vector_type(2))); u32x2 w; w.x = cvt_pk_bf16(v[0], v[1]); w.y = cvt_pk_bf16(v[2], v[3]);
                            *(u32x2*)(xb + off + bj * HALF + n * 16) = w; } }
                if (AUX) { s += __shfl_xor(s, 16); s += __shfl_xor(s, 32); if (fq == 0) P[rl * 4 + wc] = s; }
            }
        if (AUX) {
            asm volatile("s_waitcnt lgkmcnt(0)" ::: "memory"); __builtin_amdgcn_s_barrier(); asm volatile("" ::: "memory");
            const int tid = wid * 64 + lane;
            if (tid < 256) { const float s = (P[tid * 4 + 0] + P[tid * 4 + 1]) + (P[tid * 4 + 2] + P[tid * 4 + 3]); ssq[(size_t)(u.pm * BM + tid) * 8 + u.pn] = s; }
        }
    }
};
struct EpiSwiglu {
    static constexpr bool PERM = true, AFTER_DRAIN = false;
    bf16_t* H; const float* ssq;
    __device__ __forceinline__ void operator()(const f32x4 (&acc)[2][2][4][2], const Unit& u, int wr, int wc, int fr, int fq) const {
        const int row0 = u.pm * BM + wr * 64 + fr, col0 = u.pn * HALF + wc * 32 + 8 * fq;
#pragma unroll
        for (int ai = 0; ai < 2; ++ai)
#pragma unroll
            for (int m = 0; m < 4; ++m) { const int r = row0 + ai * HALF + m * 16;
                const f32x4 s0 = *(const f32x4*)(ssq + (size_t)r * 8), s1 = *(const f32x4*)(ssq + (size_t)r * 8 + 4);
                const float tot = ((s0[0] + s0[1]) + (s0[2] + s0[3])) + ((s1[0] + s1[1]) + (s1[2] + s1[3]));
                const float rstd = rsqrtf(tot * (1.0f / DM) + NORM_EPS);
                float hv[8];
#pragma unroll
                for (int n = 0; n < 2; ++n)
#pragma unroll
                    for (int i = 0; i < 4; ++i) { const float g = acc[ai][0][m][n][i] * rstd, up = acc[ai][1][m][n][i] * rstd; hv[n * 4 + i] = g / (1.0f + __expf(-g)) * up; }
                u32x4 w; w.x = cvt_pk_bf16(hv[0], hv[1]); w.y = cvt_pk_bf16(hv[2], hv[3]); w.z = cvt_pk_bf16(hv[4], hv[5]); w.w = cvt_pk_bf16(hv[6], hv[7]);
                *(u32x4*)(H + (size_t)r * FF + col0) = w; }
    }
};
}

constexpr int RING_BYTES = 131072;
constexpr int LDS_BYTES = 147456;
struct Args { const float* in[15]; float* out; unsigned char* ws; int ph_lo, ph_hi; };
typedef short bf16x8 __attribute__((ext_vector_type(8)));
typedef float f32x16 __attribute__((ext_vector_type(16)));
__device__ __forceinline__ int crow(int r, int hi) { return (r & 3) + 8 * (r >> 2) + 4 * hi; }
typedef float f32x2_t __attribute__((ext_vector_type(2))); typedef __bf16 bf16x2_t __attribute__((ext_vector_type(2)));
__device__ __forceinline__ unsigned cvtpk(float lo, float hi) { f32x2_t v = {lo, hi}; bf16x2_t b = __builtin_convertvector(v, bf16x2_t); return __builtin_bit_cast(unsigned, b); }
template <int S> __device__ __forceinline__ bf16x8 pack8(const f32x16& a) {
    v4u w; w.x = cvtpk(a[8 * S + 0], a[8 * S + 1]); w.y = cvtpk(a[8 * S + 2], a[8 * S + 3]); w.z = cvtpk(a[8 * S + 4], a[8 * S + 5]); w.w = cvtpk(a[8 * S + 6], a[8 * S + 7]);
    return __builtin_bit_cast(bf16x8, w);
}
__device__ __forceinline__ bf16x8 join8(v2u lo, v2u hi) { v4u w; w.x = lo.x; w.y = lo.y; w.z = hi.x; w.w = hi.y; return __builtin_bit_cast(bf16x8, w); }
#define MFMA32(a, b, c) __builtin_amdgcn_mfma_f32_32x32x16_bf16((a), (b), (c), 0, 0, 0)
#define WG_BAR() do { asm volatile("s_waitcnt lgkmcnt(0)" ::: "memory"); __builtin_amdgcn_s_barrier(); asm volatile("" ::: "memory"); } while (0)

struct P0Item { const float* W; bf16* WT; const float* ks; int K, N, k0, n0, drow0; float ns; };
__device__ __forceinline__ void p0_load(const P0Item& I, f32x4 (&r)[8], int lane) {
#pragma unroll
    for (int i = 0; i < 8; ++i) { const int p = lane + 64 * i; r[i] = *(const f32x4*)(I.W + (size_t)(I.k0 + (p >> 3)) * I.N + I.n0 + (p & 7) * 4); }
}
__device__ __forceinline__ void p0_store(const P0Item& I, const f32x4 (&r)[8], LAS float* scr, int lane) {
#pragma unroll
    for (int i = 0; i < 8; ++i) { const int p = lane + 64 * i, kk = p >> 3, n4 = (p & 7) * 4; const float s = (I.ks ? I.ks[I.k0 + kk] : 1.0f) * I.ns;
        scr[kk * 33 + n4 + 0] = r[i][0] * s; scr[kk * 33 + n4 + 1] = r[i][1] * s; scr[kk * 33 + n4 + 2] = r[i][2] * s; scr[kk * 33 + n4 + 3] = r[i][3] * s; }
    LDS_WAIT(); asm volatile("" ::: "memory");
    const int c = lane & 7;
#pragma unroll
    for (int j = 0; j < 4; ++j) { const int n = (lane >> 3) + 8 * j; const LAS float* s = scr + (8 * c) * 33 + n;
        v4u o; o.x = pk2(s[0 * 33], s[1 * 33]); o.y = pk2(s[2 * 33], s[3 * 33]); o.z = pk2(s[4 * 33], s[5 * 33]); o.w = pk2(s[6 * 33], s[7 * 33]);
        *(v4u*)(I.WT + (size_t)(I.drow0 + n) * I.K + I.k0 + 8 * c) = o; }
    LDS_WAIT(); asm volatile("" ::: "memory");
}

struct P0Ptrs { const float* w_in; const float* w_out; const float* w_gate; const float* w_up; const float* w_down; const float* ffn_w; bf16* Wt_in; bf16* Wt_out; bf16* Wt_gu; bf16* Wt_dn; };
constexpr int I_IN = 32 * 193, I_OUT = 32 * 64, I_G = 32 * 176, I_D = 88 * 64, P0_NITEMS = I_IN + I_OUT + 2 * I_G + I_D, P0_FIRST = I_IN + I_OUT;
__device__ __forceinline__ void p0_decode(int it, const P0Ptrs& P, P0Item& I) {
    int r = it; I.ks = nullptr; I.ns = 1.f;
    if (r < I_IN) { const int kb = r / 193, nb = r % 193, n0 = nb * 32; int drow;
        if (n0 < 1024) { drow = n0; I.ns = 0.125f * LOG2E; }
        else if (n0 < 3072) drow = n0;
        else if (n0 < 3584) { drow = n0; I.ns = 0.08838834764831845f; }
        else if (n0 < 4096) drow = n0;
        else if (n0 < 5120) drow = n0 + 1024;
        else if (n0 < 6144) drow = n0 - 1024;
        else drow = n0;
        I.W = P.w_in; I.WT = P.Wt_in; I.K = DM; I.N = INW; I.k0 = kb * 64; I.n0 = n0; I.drow0 = drow; return; }
    r -= I_IN;
    if (r < I_OUT) { const int kb = r / 64, nb = r % 64; I.W = P.w_out; I.WT = P.Wt_out; I.K = DM; I.N = DM; I.k0 = kb * 64; I.n0 = nb * 32; I.drow0 = nb * 32; return; }
    r -= I_OUT;
    if (r < I_G) { const int kb = r / 176, nb = r % 176, n0 = nb * 32; I.W = P.w_gate; I.WT = P.Wt_gu; I.K = DM; I.N = FF; I.k0 = kb * 64; I.n0 = n0; I.drow0 = (n0 >> 7) * 256 + (n0 & 127); I.ks = P.ffn_w; return; }
    r -= I_G;
    if (r < I_G) { const int kb = r / 176, nb = r % 176, n0 = nb * 32; I.W = P.w_up; I.WT = P.Wt_gu; I.K = DM; I.N = FF; I.k0 = kb * 64; I.n0 = n0; I.drow0 = (n0 >> 7) * 256 + 128 + (n0 & 127); I.ks = P.ffn_w; return; }
    r -= I_G;
    { const int kb = r / 64, nb = r % 64; I.W = P.w_down; I.WT = P.Wt_dn; I.K = FF; I.N = DM; I.k0 = kb * 64; I.n0 = nb * 32; I.drow0 = nb * 32; }
}

__device__ __forceinline__ void p0_run(int lo, int hi, int wv, int nwv, const P0Ptrs& PP, LAS float* scr, int lane) {
    P0Item Ic, In; f32x4 rc[8], rn[8];
    int it = lo + wv;
    if (it < hi) { p0_decode(it, PP, Ic); p0_load(Ic, rc, lane); }
    while (it < hi) {
        const int nx = it + nwv;
        if (nx < hi) { p0_decode(nx, PP, In); p0_load(In, rn, lane); }
        p0_store(Ic, rc, scr, lane);
        Ic = In;
#pragma unroll
        for (int i = 0; i < 8; ++i) rc[i] = rn[i];
        it = nx;
    }
}
__device__ __forceinline__ int t5_bucket(int rel) {
    const int nb = 16, max_exact = 8; int ret = rel > 0 ? nb : 0; const int n = rel < 0 ? -rel : rel;
    if (n < max_exact) return ret + n;
    int large = max_exact + (int)(log((double)n / (double)max_exact) / log(1024.0 / 8.0) * (double)(nb - max_exact));
    if (large > nb - 1) large = nb - 1;
    return ret + large;
}
__device__ __forceinline__ float logsig16(float z) { return (fminf(z, 0.f) - log1pf(__expf(-fabsf(z)))) * (1.0f / 16.0f); }

struct GlaBufs { const bf16* GQ; const bf16* GK; const bf16* GVT; const float* GLR; bf16* QINF; bf16* QINB; bf16* KETF; bf16* KETB; float* DECF; float* DECB; bf16* OI; bf16* OSF; bf16* OSB;
                 const float* gwF; const float* gbF; const float* gwB; const float* gbB; };
constexpr int GP = 136;
__device__ __forceinline__ f32x16 gla_xtile(const LAS bf16* Ks, const LAS bf16* Qs, int jt, int ct, int l31, int hi) {
    f32x16 acc = {};
    const LAS bf16* kp = Ks + (32 * jt + l31) * GP + 8 * hi; const LAS bf16* qp = Qs + (32 * ct + l31) * GP + 8 * hi;
#pragma unroll
    for (int d0 = 0; d0 < 8; ++d0) { const bf16x8 a = *(const LAS bf16x8*)(kp + 16 * d0); const bf16x8 b = *(const LAS bf16x8*)(qp + 16 * d0); acc = MFMA32(a, b, acc); }
    return acc;
}
__device__ __forceinline__ void gla_unit(int unit, const GlaBufs& B, LAS unsigned char* lds, int tid, int lane, int wave) {
    const int n = unit & 63, h = (unit >> 6) & 3, b = unit >> 8;
    const size_t row0 = (size_t)b * SEQ + 64 * n;
    LAS bf16* QF = (LAS bf16*)lds; LAS bf16* KF = QF + 64 * GP; LAS bf16* QB = KF + 64 * GP; LAS bf16* KB = QB + 64 * GP;
    LAS float* PS = (LAS float*)(lds + 69632);
    LAS float* LR = (LAS float*)(lds + 73728);
    LAS unsigned char* R2 = lds + 81920;
    WG_BAR();
    ((LAS f32x4*)LR)[tid] = ((const f32x4*)(B.GLR + row0 * 32))[tid];
    const int d = tid & 127, cgrp = tid >> 7, col = h * 128 + d;
    float gwf[16], gwb[16];
#pragma unroll
    for (int r = 0; r < 16; ++r) { gwf[r] = B.gwF[r * GKW + col]; gwb[r] = B.gwB[r * GKW + col]; }
    const float gbf = B.gbF[col], gbb = B.gbB[col];
    WG_BAR();
    float laf[16], lab[16];
#pragma unroll
    for (int cc = 0; cc < 16; ++cc) { const int c = cgrp * 16 + cc; float zf = gbf, zb = gbb;
#pragma unroll
        for (int r4 = 0; r4 < 4; ++r4) { const f32x4 a = *(const LAS f32x4*)(LR + c * 32 + 4 * r4), e = *(const LAS f32x4*)(LR + c * 32 + 16 + 4 * r4);
#pragma unroll
            for (int i = 0; i < 4; ++i) { zf += a[i] * gwf[4 * r4 + i]; zb += e[i] * gwb[4 * r4 + i]; } }
        laf[cc] = logsig16(zf); lab[cc] = logsig16(zb); }
#pragma unroll
    for (int cc = 1; cc < 16; ++cc) laf[cc] += laf[cc - 1];
#pragma unroll
    for (int cc = 14; cc >= 0; --cc) lab[cc] += lab[cc + 1];
    PS[cgrp * 128 + d] = laf[15]; PS[(4 + cgrp) * 128 + d] = lab[0];
    WG_BAR();
    float offf = 0.f, offb = 0.f, totf = 0.f, totb = 0.f;
#pragma unroll
    for (int g = 0; g < 4; ++g) { const float pf = PS[g * 128 + d], pb = PS[(4 + g) * 128 + d]; totf += pf; totb += pb; if (g < cgrp) offf += pf; if (g > cgrp) offb += pb; }
    float kef[16], keb[16];
#pragma unroll
    for (int cc = 0; cc < 16; ++cc) { const int c = cgrp * 16 + cc; const size_t row = row0 + c;
        const float Gf = laf[cc] + offf, Gb = lab[cc] + offb;
        const float q = bf2f(B.GQ[row * GKW + col]), k = bf2f(B.GK[row * GKW + col]);
        const float qf = q * __expf(Gf), kf = k * __expf(-Gf), qb = q * __expf(Gb), kb = k * __expf(-Gb);
        kef[cc] = k * __expf(totf - Gf); keb[cc] = k * __expf(totb - Gb);
        const bf16 qfh = (bf16)f2bf(qf), qbh = (bf16)f2bf(qb);
        QF[c * GP + d] = qfh; KF[c * GP + d] = (bf16)f2bf(kf); QB[c * GP + d] = qbh; KB[c * GP + d] = (bf16)f2bf(kb);
        const size_t qo = (((size_t)(b * 64 + n) * 4 + h) * 64 + c) * 128 + d; B.QINF[qo] = qfh; B.QINB[qo] = qbh; }
    { v4u w0, w1; LAS unsigned char* dst = R2 + d * 144 + cgrp * 32;
      w0.x = pk2(kef[0], kef[1]); w0.y = pk2(kef[2], kef[3]); w0.z = pk2(kef[4], kef[5]); w0.w = pk2(kef[6], kef[7]);
      w1.x = pk2(kef[8], kef[9]); w1.y = pk2(kef[10], kef[11]); w1.z = pk2(kef[12], kef[13]); w1.w = pk2(kef[14], kef[15]);
      ((LAS v4u*)dst)[0] = w0; ((LAS v4u*)dst)[1] = w1;
      dst += 128 * 144;
      w0.x = pk2(keb[0], keb[1]); w0.y = pk2(keb[2], keb[3]); w0.z = pk2(keb[4], keb[5]); w0.w = pk2(keb[6], keb[7]);
      w1.x = pk2(keb[8], keb[9]); w1.y = pk2(keb[10], keb[11]); w1.z = pk2(keb[12], keb[13]); w1.w = pk2(keb[14], keb[15]);
      ((LAS v4u*)dst)[0] = w0; ((LAS v4u*)dst)[1] = w1; }
    if (cgrp == 0) { B.DECF[(size_t)(b * 64 + n) * GKW + col] = __expf(totf); B.DECB[(size_t)(b * 64 + n) * GKW + col] = __expf(totb); }
    WG_BAR();
    {
#pragma unroll
        for (int i = 0; i < 4; ++i) { const int pc = tid + 512 * (i & 1), dirb = i >> 1, row = pc >> 3, ch = pc & 7;
            const v4u v = *(const LAS v4u*)(R2 + dirb * (128 * 144) + row * 144 + ch * 16);
            *(v4u*)((dirb ? B.KETB : B.KETF) + ((size_t)(b * 64 + n) * GKW + h * 128) * 64 + pc * 8) = v; }
    }
    const int l31 = lane & 31, hi = lane >> 5;
    bf16x8 vt[2][2];
    { const bf16* vbase = B.GVT + ((size_t)(b * 64 + n) * GVW + h * 256 + 32 * wave + l31) * 64 + 4 * hi;
#pragma unroll
      for (int jt = 0; jt < 2; ++jt)
#pragma unroll
          for (int s = 0; s < 2; ++s) { const bf16* p = vbase + 32 * jt + 16 * s; vt[jt][s] = join8(*(const v2u*)p, *(const v2u*)(p + 8)); } }
    f32x16 o0 = {}, o1 = {};
    {
        f32x16 X = gla_xtile(KF, QF, 0, 0, l31, hi);
#pragma unroll
        for (int r = 0; r < 16; ++r) if (crow(r, hi) > l31) X[r] = 0.f;
        o0 = MFMA32(vt[0][0], pack8<0>(X), o0); o0 = MFMA32(vt[0][1], pack8<1>(X), o0);
        X = gla_xtile(KF, QF, 0, 1, l31, hi);
        o1 = MFMA32(vt[0][0], pack8<0>(X), o1); o1 = MFMA32(vt[0][1], pack8<1>(X), o1);
        X = gla_xtile(KF, QF, 1, 1, l31, hi);
#pragma unroll
        for (int r = 0; r < 16; ++r) if (crow(r, hi) > l31) X[r] = 0.f;
        o1 = MFMA32(vt[1][0], pack8<0>(X), o1); o1 = MFMA32(vt[1][1], pack8<1>(X), o1);
    }
    {
        f32x16 X = gla_xtile(KB, QB, 0, 0, l31, hi);
#pragma unroll
        for (int r = 0; r < 16; ++r) if (crow(r, hi) < l31) X[r] = 0.f;
        o0 = MFMA32(vt[0][0], pack8<0>(X), o0); o0 = MFMA32(vt[0][1], pack8<1>(X), o0);
        X = gla_xtile(KB, QB, 1, 0, l31, hi);
        o0 = MFMA32(vt[1][0], pack8<0>(X), o0); o0 = MFMA32(vt[1][1], pack8<1>(X), o0);
        X = gla_xtile(KB, QB, 1, 1, l31, hi);
#pragma unroll
        for (int r = 0; r < 16; ++r) if (crow(r, hi) < l31) X[r] = 0.f;
        o1 = MFMA32(vt[1][0], pack8<0>(X), o1); o1 = MFMA32(vt[1][1], pack8<1>(X), o1);
    }
    WG_BAR();
    { LAS unsigned char* ot = R2 + l31 * 528 + (32 * wave + 4 * hi) * 2;
#pragma unroll
      for (int g = 0; g < 4; ++g) { v2u w; w.x = cvtpk(o0[4 * g], o0[4 * g + 1]); w.y = cvtpk(o0[4 * g + 2], o0[4 * g + 3]); *(LAS v2u*)(ot + 16 * g) = w;
          v2u w1; w1.x = cvtpk(o1[4 * g], o1[4 * g + 1]); w1.y = cvtpk(o1[4 * g + 2], o1[4 * g + 3]); *(LAS v2u*)(ot + 32 * 528 + 16 * g) = w1; } }
    WG_BAR();
#pragma unroll
    for (int i = 0; i < 4; ++i) { const int pc = tid + 512 * i, row = pc >> 5, ch = pc & 31;
        *(v4u*)(B.OI + (row0 + row) * GVW + h * 256 + ch * 8) = *(const LAS v4u*)(R2 + row * 528 + ch * 16); }
}

constexpr int SC_Q = 0, SC_K = 17408, SC_V = 35840, SC_D = 54272, SC_STAGE = 54784;
struct ScanRegs { v4u q[8], k[8], v[8]; f32x4 d; };
constexpr int SC_DUMP = 2 * 54784, SC_OST = SC_DUMP + 2048, SC_OP = 272, SC_OSZ = 64 * SC_OP;
constexpr int SC_PF = 6;
__device__ __forceinline__ void gla_scan(int item, const GlaBufs& B, LAS unsigned char* lds, int tid, int lane, int wave) {
    const int half = item & 1, dir = (item >> 1) & 1, h = (item >> 2) & 3, b = item >> 4;
    const bf16* QIN = dir ? B.QINB : B.QINF; const bf16* KET = dir ? B.KETB : B.KETF; const float* DEC = dir ? B.DECB : B.DECF;
    bf16* OS = dir ? B.OSB : B.OSF;
    const int l31 = lane & 31, hi = lane >> 5;
    const int par = (wave >> 1) & 1, pl = 64 * (wave & 1) + lane;
#define SC_CHUNK(st) (dir ? 63 - (st) : (st))
#define SC_LOAD(R, st) do { const int nn_ = SC_CHUNK(st); const size_t cg_ = (size_t)b * 64 + nn_; \
        const v4u* qs_ = (const v4u*)(QIN + (cg_ * 4 + h) * (64 * 128)) + pl; const v4u* ks_ = (const v4u*)(KET + (cg_ * GKW + h * 128) * 64) + pl; \
        const v4u* vs_ = (const v4u*)(B.GVT + (cg_ * GVW + h * 256 + 128 * half) * 64) + pl;     \
        _Pragma("unroll") for (int i_ = 0; i_ < 8; ++i_) { R.q[i_] = qs_[128 * i_]; R.k[i_] = ks_[128 * i_]; R.v[i_] = vs_[128 * i_]; } \
        if (pl < 32) R.d = *(const f32x4*)(DEC + (size_t)(b * 64 + nn_) * GKW + h * 128 + pl * 4); } while (0)
#if PROBE_SCAN == 2
#define SC_LOAD2(R, st) do { SC_LOAD(R, st); _Pragma("unroll") for (int i_ = 0; i_ < 8; ++i_) asm volatile("" : "+v"(R.q[i_]), "+v"(R.k[i_]), "+v"(R.v[i_])); SC_LOAD(R, st); } while (0)
#else
#define SC_LOAD2(R, st) SC_LOAD(R, st)
#endif
#define SC_WRITE(R, sg) do { LAS unsigned char* s_ = lds + (sg) * SC_STAGE; \
        _Pragma("unroll") for (int i_ = 0; i_ < 8; ++i_) { const int pp_ = pl + 128 * i_; \
            *(LAS v4u*)(s_ + SC_Q + (pp_ >> 4) * 272 + (pp_ & 15) * 16) = R.q[i_]; \
            *(LAS v4u*)(s_ + SC_K + (pp_ >> 3) * 144 + (pp_ & 7) * 16) = R.k[i_]; \
            *(LAS v4u*)(s_ + SC_V + (pp_ >> 3) * 144 + (pp_ & 7) * 16) = R.v[i_]; } \
        if (pl < 32) *(LAS f32x4*)(s_ + SC_D + pl * 16) = R.d; } while (0)
    WG_BAR();
    if (wave >= 4) {
        ScanRegs R;
        const int t4 = tid & 255;
#define SC_OUT(so) do { const LAS unsigned char* ot_ = lds + SC_OST + ((so) & 1) * SC_OSZ; bf16* og_ = OS + ((size_t)b * SEQ + 64 * SC_CHUNK(so)) * GVW + h * 256 + 128 * half; \
        _Pragma("unroll") for (int i_ = 0; i_ < 4; ++i_) { const int p_ = t4 + 256 * i_; *(v4u*)(og_ + (size_t)(p_ >> 4) * GVW + (p_ & 15) * 8) = *(const LAS v4u*)(ot_ + (p_ >> 4) * SC_OP + (p_ & 15) * 16); } } while (0)
        if (par == 0) { SC_LOAD(R, 0); SC_WRITE(R, 0); SC_LOAD(R, 2); } else { SC_LOAD(R, 1); }
        WG_BAR();
        for (int st = 0; st < 64; ++st) {
            if (((st + 1) & 1) == par) { if (st + 1 < 64) SC_WRITE(R, (st + 1) & 1); if (st + 3 < 64) SC_LOAD2(R, st + 3); }
            if (st > 0) SC_OUT(st - 1);
            WG_BAR();
        }
        SC_OUT(63);
#undef SC_OUT
    } else {
        f32x16 S0 = {}, S1 = {}, S2 = {}, S3 = {};
        WG_BAR();
        for (int st = 0; st < 64; ++st) {
            const int n = SC_CHUNK(st); const LAS unsigned char* sg = lds + (st & 1) * SC_STAGE;
            if (st + SC_PF < 64) {
                const size_t cg_ = (size_t)b * 64 + SC_CHUNK(st + SC_PF); const int ln = 32 * wave + l31;
                const bf16* t0 = hi ? (KET + (cg_ * GKW + h * 128) * 64) : (QIN + (cg_ * 4 + h) * (64 * 128));
                const bf16* t1 = B.GVT + (cg_ * GVW + h * 256 + 128 * half) * 64;
                __builtin_amdgcn_global_load_lds((const unsigned*)(t0 + ln * 64), (LAS unsigned*)(lds + SC_DUMP + wave * 512), 4, 0, 0);
                __builtin_amdgcn_global_load_lds((const unsigned*)(t1 + ln * 64), (LAS unsigned*)(lds + SC_DUMP + wave * 512 + 256), 4, 0, 0);
            }
            const LAS unsigned char* qb0 = sg + SC_Q + l31 * 272 + 8 * hi; const LAS unsigned char* qb1 = qb0 + 32 * 272;
            bf16x8 q0[8], q1[8];
#pragma unroll
            for (int k = 0; k < 8; ++k) { q0[k] = join8(*(const LAS v2u*)(qb0 + 32 * k), *(const LAS v2u*)(qb0 + 32 * k + 16)); q1[k] = join8(*(const LAS v2u*)(qb1 + 32 * k), *(const LAS v2u*)(qb1 + 32 * k + 16)); }
            bf16x8 sa[8];
            sa[0] = pack8<0>(S0); sa[1] = pack8<1>(S0); sa[2] = pack8<0>(S1); sa[3] = pack8<1>(S1); sa[4] = pack8<0>(S2); sa[5] = pack8<1>(S2); sa[6] = pack8<0>(S3); sa[7] = pack8<1>(S3);
            f32x16 i0 = {}, i1 = {};
#pragma unroll
            for (int k = 0; k < 8; ++k) { i0 = MFMA32(sa[k], q0[k], i0); i1 = MFMA32(sa[k], q1[k], i1); }
#if PROBE_SCAN == 1
            { f32x16 j0 = {}, j1 = {};
              _Pragma("unroll") for (int k = 0; k < 8; ++k) { asm volatile("" : "+v"(sa[k])); j0 = MFMA32(sa[k], q0[k], j0); j1 = MFMA32(sa[k], q1[k], j1); }
              asm volatile("" :: "v"(j0), "v"(j1)); }
#endif
            __builtin_amdgcn_sched_barrier(0);
            const LAS unsigned char* vb_ = sg + SC_V + (32 * wave + l31) * 144 + 16 * hi;
            f32x4 dv[16]; bf16x8 vf[4];
#pragma unroll
            for (int k = 0; k < 16; ++k) dv[k] = *(const LAS f32x4*)(sg + SC_D + (32 * (k >> 2) + 8 * (k & 3) + 4 * hi) * 4);
#pragma unroll
            for (int s = 0; s < 4; ++s) vf[s] = *(const LAS bf16x8*)(vb_ + 32 * s);
#pragma unroll
            for (int g = 0; g < 4; ++g) {
#pragma unroll
                for (int i = 0; i < 4; ++i) { S0[4 * g + i] *= dv[g][i]; S1[4 * g + i] *= dv[4 + g][i]; S2[4 * g + i] *= dv[8 + g][i]; S3[4 * g + i] *= dv[12 + g][i]; } }
            __builtin_amdgcn_sched_barrier(0);
            const LAS unsigned char* kb_ = sg + SC_K + l31 * 144 + 16 * hi;
            bf16x8 kf[16];
#pragma unroll
            for (int k = 0; k < 16; ++k) kf[k] = *(const LAS bf16x8*)(kb_ + (32 * (k >> 2)) * 144 + 32 * (k & 3));
#pragma unroll
            for (int s = 0; s < 4; ++s) { S0 = MFMA32(kf[s], vf[s], S0); S1 = MFMA32(kf[4 + s], vf[s], S1); S2 = MFMA32(kf[8 + s], vf[s], S2); S3 = MFMA32(kf[12 + s], vf[s], S3); }
            __builtin_amdgcn_sched_barrier(0);
            { LAS unsigned char* ot = lds + SC_OST + (st & 1) * SC_OSZ + l31 * SC_OP + (32 * wave + 4 * hi) * 2;
#pragma unroll
              for (int g = 0; g < 4; ++g) {
                  v2u w; w.x = cvtpk(i0[4 * g], i0[4 * g + 1]); w.y = cvtpk(i0[4 * g + 2], i0[4 * g + 3]); *(LAS v2u*)(ot + 16 * g) = w;
                  v2u w1; w1.x = cvtpk(i1[4 * g], i1[4 * g + 1]); w1.y = cvtpk(i1[4 * g + 2], i1[4 * g + 3]); *(LAS v2u*)(ot + 32 * SC_OP + 16 * g) = w1; } }
            WG_BAR();
        }
    }
#undef SC_CHUNK
#undef SC_LOAD
#undef SC_WRITE
}

struct AttnBufs { const bf16* AQ; const bf16* AK; const bf16* AV; const float* BIAS2; bf16* OP; float* LSE; };
constexpr int AT_KP = 144;
constexpr int AT_VT = 384 * AT_KP;
constexpr int AT_VP = 784;
constexpr int AT_BT = AT_VT + 64 * AT_VP;
constexpr int AT_OS = AT_BT + 4 * 784, AT_OP = 144;
struct AttnPre { v4u k[6]; v4u v[6]; bf16x8 q[4]; float bt[2]; };
struct AttnUnit { int b, h, p, r, L, j, kb; };
__device__ __forceinline__ AttnUnit attn_decode(int u) {
    AttnUnit U; const int bh = u / 48, w48 = u % 48, idx = w48 & 15; U.p = w48 >> 4; U.b = bh >> 4; U.h = bh & 15;
    U.r = (U.p == 0) ? 1 : (U.p == 1 ? 4 : 16); U.L = SEQ / U.r;
    U.j = (U.p == 0) ? 0 : (U.p == 1 ? (idx >> 2) : idx); U.kb = (U.p == 0) ? idx : (U.p == 1 ? (idx & 3) : 0);
    return U;
}
__device__ __forceinline__ void attn_issue(const AttnUnit& U, const AttnBufs& A, AttnPre& R, int tid, int lane, int wave) {
    const size_t hb = (size_t)(U.b * AH + U.h) * SEQ; const int wbase = U.kb * 256 - 64;
    const v4u z = {0u, 0u, 0u, 0u};
#pragma unroll
    for (int i = 0; i < 6; ++i) { const int pc = tid + 512 * i, sp = wbase + (pc >> 3);
        R.k[i] = z; if (sp >= 0 && sp < U.L) R.k[i] = *(const v4u*)(A.AK + (hb + (size_t)sp * U.r + U.j) * AD + (pc & 7) * 8); }
#pragma unroll
    for (int g = 0; g < 3; ++g) { const int sp0 = wbase + 2 * (64 * g + lane), sp1 = sp0 + 1;
        R.v[2 * g] = z; R.v[2 * g + 1] = z;
        if (sp0 >= 0 && sp0 < U.L) R.v[2 * g] = *(const v4u*)(A.AV + (hb + (size_t)sp0 * U.r + U.j) * AD + 8 * wave);
        if (sp1 >= 0 && sp1 < U.L) R.v[2 * g + 1] = *(const v4u*)(A.AV + (hb + (size_t)sp1 * U.r + U.j) * AD + 8 * wave); }
    { const int l31 = lane & 31, hi = lane >> 5; const size_t tq = hb + (size_t)(U.kb * 256 + 32 * wave + l31) * U.r + U.j;
#pragma unroll
      for (int d0 = 0; d0 < 4; ++d0) R.q[d0] = *(const bf16x8*)(A.AQ + tq * AD + 16 * d0 + 8 * hi); }
#pragma unroll
    for (int i = 0; i < 2; ++i) { const int e = tid + 512 * i; float v = -INFINITY;
        if (e < 4 * 196) { const int dl = (e % 196) + (e / 196) - 95; if (dl >= -64 && dl <= 64) v = A.BIAS2[(U.p * 129 + dl + 64) * 16 + U.h]; }
        R.bt[i] = v; }
}
__device__ __forceinline__ void attn_stage(const AttnPre& R, LAS unsigned char* lds, int tid, int lane, int wave) {
#pragma unroll
    for (int i = 0; i < 6; ++i) { const int pc = tid + 512 * i; *(LAS v4u*)(lds + (pc >> 3) * AT_KP + (pc & 7) * 16) = R.k[i]; }
#pragma unroll
    for (int g = 0; g < 3; ++g) { const int kk0 = 2 * (64 * g + lane); const v4u a = R.v[2 * g], c2 = R.v[2 * g + 1];
        const int w16 = kk0 & 15, slot = (kk0 & ~15) | (w16 & 3) | (((w16 >> 3) & 1) << 2) | (((w16 >> 2) & 1) << 3);
        LAS unsigned char* dst = lds + AT_VT + (8 * wave) * AT_VP + slot * 2;
        *(LAS unsigned*)(dst + 0 * AT_VP) = (a.x & 0xffffu) | (c2.x << 16);
        *(LAS unsigned*)(dst + 1 * AT_VP) = (a.x >> 16) | (c2.x & 0xffff0000u);
        *(LAS unsigned*)(dst + 2 * AT_VP) = (a.y & 0xffffu) | (c2.y << 16);
        *(LAS unsigned*)(dst + 3 * AT_VP) = (a.y >> 16) | (c2.y & 0xffff0000u);
        *(LAS unsigned*)(dst + 4 * AT_VP) = (a.z & 0xffffu) | (c2.z << 16);
        *(LAS unsigned*)(dst + 5 * AT_VP) = (a.z >> 16) | (c2.z & 0xffff0000u);
        *(LAS unsigned*)(dst + 6 * AT_VP) = (a.w & 0xffffu) | (c2.w << 16);
        *(LAS unsigned*)(dst + 7 * AT_VP) = (a.w >> 16) | (c2.w & 0xffff0000u); }
#pragma unroll
    for (int i = 0; i < 2; ++i) { const int e = tid + 512 * i; if (e < 4 * 196) ((LAS float*)(lds + AT_BT))[e] = R.bt[i]; }
}
__device__ __forceinline__ void attn_compute(const AttnUnit& U, const AttnBufs& A, const bf16x8 (&qf)[4], LAS unsigned char* lds, int lane, int wave) {
    const int l31 = lane & 31, hi = lane >> 5;
    const int i0 = U.kb * 256 + 32 * wave;
    const size_t tq = (size_t)U.b * SEQ + (size_t)(i0 + l31) * U.r + U.j;
    f32x16 S[5];
    const int cshift = 3 - (l31 & 3);
    const LAS unsigned char* btl = lds + AT_BT + cshift * 784 + (4 * hi + 28 - 4 * (l31 >> 2)) * 4;
    const LAS unsigned char* kbp = lds + (32 * wave + l31) * AT_KP + 16 * hi;
    float m = -INFINITY;
#pragma unroll
    for (int t = 0; t < 5; ++t) { const int sb = i0 - 64 + 32 * t;
        if (sb >= 0 && sb < U.L) {
            bf16x8 kf[4];
#pragma unroll
            for (int d0 = 0; d0 < 4; ++d0) kf[d0] = *(const LAS bf16x8*)(kbp + (32 * t) * AT_KP + 32 * d0);
            f32x4 bv[4];
#pragma unroll
            for (int g = 0; g < 4; ++g) bv[g] = *(const LAS f32x4*)(btl + (32 * t + 8 * g) * 4);
            f32x16 acc = {};
#pragma unroll
            for (int d0 = 0; d0 < 4; ++d0) acc = MFMA32(kf[d0], qf[d0], acc);
#pragma unroll
            for (int g = 0; g < 4; ++g)
#pragma unroll
                for (int i = 0; i < 4; ++i) { acc[4 * g + i] += bv[g][i]; m = fmaxf(m, acc[4 * g + i]); }
            S[t] = acc;
        } else {
#pragma unroll
            for (int i = 0; i < 16; ++i) S[t][i] = -INFINITY;
        } }
    m = fmaxf(m, __shfl_xor(m, 32));
    float ssum = 0.f;
#pragma unroll
    for (int t = 0; t < 5; ++t)
#pragma unroll
        for (int i = 0; i < 16; ++i) { const float e = exp2f(S[t][i] - m); S[t][i] = e; ssum += e; }
    ssum += __shfl_xor(ssum, 32);
    f32x16 o0 = {}, o1 = {};
    const LAS unsigned char* vb = lds + AT_VT + l31 * AT_VP + (32 * wave) * 2 + 16 * hi;
#pragma unroll
    for (int t = 0; t < 5; ++t) { const int sb = i0 - 64 + 32 * t;
        if (sb >= 0 && sb < U.L) {
            const bf16x8 v00 = *(const LAS bf16x8*)(vb + (32 * t) * 2), v01 = *(const LAS bf16x8*)(vb + (32 * t + 16) * 2);
            const bf16x8 v10 = *(const LAS bf16x8*)(vb + 32 * AT_VP + (32 * t) * 2), v11 = *(const LAS bf16x8*)(vb + 32 * AT_VP + (32 * t + 16) * 2);
            const bf16x8 p0 = pack8<0>(S[t]), p1 = pack8<1>(S[t]);
            o0 = MFMA32(v00, p0, o0); o0 = MFMA32(v01, p1, o0);
            o1 = MFMA32(v10, p0, o1); o1 = MFMA32(v11, p1, o1);
        } }
    const float inv = 1.0f / ssum;
    { LAS unsigned char* ot = lds + AT_OS + wave * (32 * AT_OP) + l31 * AT_OP + 8 * hi;
#pragma unroll
      for (int g = 0; g < 4; ++g) { v2u w; w.x = cvtpk(o0[4 * g] * inv, o0[4 * g + 1] * inv); w.y = cvtpk(o0[4 * g + 2] * inv, o0[4 * g + 3] * inv); *(LAS v2u*)(ot + 16 * g) = w;
          v2u w1; w1.x = cvtpk(o1[4 * g] * inv, o1[4 * g + 1] * inv); w1.y = cvtpk(o1[4 * g + 2] * inv, o1[4 * g + 3] * inv); *(LAS v2u*)(ot + 64 + 16 * g) = w1; }
      asm volatile("s_waitcnt lgkmcnt(0)" ::: "memory");
      bf16* ob = A.OP + (size_t)U.p * ((size_t)T_ * AW) + U.h * AD;
#pragma unroll
      for (int i = 0; i < 4; ++i) { const int pc = lane + 64 * i, row = pc >> 3, ch = pc & 7;
          const v4u v = *(const LAS v4u*)(lds + AT_OS + wave * (32 * AT_OP) + row * AT_OP + ch * 16);
          *(v4u*)(ob + ((size_t)U.b * SEQ + (size_t)(i0 + row) * U.r + U.j) * AW + ch * 8) = v; } }
    if (hi == 0) A.LSE[(size_t)U.p * ((size_t)T_ * AH) + tq * AH + U.h] = m + log2f(ssum);
}
__device__ __forceinline__ void attn_units(int u0, int ustep, const AttnBufs& A, LAS unsigned char* lds, int tid, int lane, int wave) {
    if (u0 >= 1536) return;
    AttnPre R; AttnUnit U = attn_decode(u0);
    attn_issue(U, A, R, tid, lane, wave);
    for (int u = u0; u < 1536; u += ustep) {
        WG_BAR();
        attn_stage(R, lds, tid, lane, wave);
        bf16x8 qf[4];
#pragma unroll
        for (int d0 = 0; d0 < 4; ++d0) qf[d0] = R.q[d0];
        const AttnUnit Uc = U;
        if (u + ustep < 1536) { U = attn_decode(u + ustep); attn_issue(U, A, R, tid, lane, wave); }
        WG_BAR();
        attn_compute(Uc, A, qf, lds, lane, wave);
    }
}
__global__ void __launch_bounds__(NWAVES * 64, 2) fwd(Args args) {
    extern __shared__ __attribute__((aligned(16))) unsigned char lds_raw[];
    LAS unsigned char* lds = (LAS unsigned char*)lds_raw;
    const int tid = threadIdx.x, lane = tid & 63, wave = __builtin_amdgcn_readfirstlane(tid >> 6);
    const int G = gridDim.x; const int bx = blockIdx.x; const int vcu = (G % 8 == 0) ? (bx % 8) * (G / 8) + bx / 8 : bx;
    const int gw = vcu * NWAVES + wave, NGW = G * NWAVES;
    unsigned char* ws = args.ws;
    const float* x = args.in[0]; float* out = args.out;
    bf16* Wt_in = (bf16*)(ws + WS_WIN); bf16* Wt_out = (bf16*)(ws + WS_WOUT); bf16* Wt_gu = (bf16*)(ws + WS_WGU); bf16* Wt_dn = (bf16*)(ws + WS_WDN);
    bf16* XN = (bf16*)(ws + WS_XN); bf16* RB = (bf16*)(ws + WS_RB);
    float* BIAS2 = (float*)(ws + WS_BIAS2); float* SSQ1 = (float*)(ws + WS_SSQ1);
    float* GLR = (float*)(RB + E_GLR);
    GlaBufs GB;
    GB.GQ = RB + E_GQ; GB.GK = RB + E_GK; GB.GVT = RB + E_GVT; GB.GLR = GLR;
    GB.OI = (bf16*)(ws + WS_XN); GB.QINF = GB.OI + (size_t)T_ * 1024; GB.QINB = GB.QINF + (size_t)T_ * 512;
    GB.KETF = (bf16*)(ws + WS_WIN); GB.KETB = GB.KETF + (size_t)T_ * 512;
    GB.DECF = (float*)(ws + WS_WIN + 16 * MiB); GB.DECB = GB.DECF + 128 * 512;
    GB.OSF = RB + E_GQ; GB.OSB = (bf16*)((unsigned char*)out + 48 * MiB);
    GB.gwF = args.in[4]; GB.gbF = args.in[5]; GB.gwB = args.in[6]; GB.gbB = args.in[7];
    bf16* Y = RB;
    bf16* X1B = (bf16*)(ws + WS_XN);
    bf16* HB = RB;
    AttnBufs AB; AB.AQ = RB + E_AQ; AB.AK = RB + E_AK; AB.AV = RB + E_AV; AB.BIAS2 = BIAS2;
    AB.OP = (bf16*)out; AB.LSE = (float*)(ws + WS_WIN + 17 * MiB);
    const int lo = args.ph_lo, hi = args.ph_hi;
#define IN(k) (lo <= (k) && (k) < hi)
#define SEAM(k) do { if (IN(k) && IN((k) + 1)) { cg::this_grid().sync(); } } while (0)
    unsigned long long* TS = (unsigned long long*)(ws + 768 * 1024);
#define STAMP(k) do { if (PROBE_TS && tid == 0) TS[bx * 16 + (k)] = __builtin_amdgcn_s_memrealtime(); } while (0)

    P0Ptrs PP; PP.w_in = args.in[2]; PP.w_out = args.in[9]; PP.w_gate = args.in[11]; PP.w_up = args.in[12]; PP.w_down = args.in[13]; PP.ffn_w = args.in[10];
    PP.Wt_in = Wt_in; PP.Wt_out = Wt_out; PP.Wt_gu = Wt_gu; PP.Wt_dn = Wt_dn;

    if (IN(0)) {
        LAS float* scr = (LAS float*)(lds + wave * 16384);
        p0_run(0, P0_FIRST, gw, NGW, PP, scr, lane);
        const float* nw = args.in[1];
        for (int m = gw; m < T_; m += NGW) {
            const f32x4* xr = (const f32x4*)(x + (size_t)m * DM) + lane; f32x4 v[8]; float s = 0.f;
#pragma unroll
            for (int j = 0; j < 8; ++j) { v[j] = xr[64 * j]; s += (v[j][0] * v[j][0] + v[j][1] * v[j][1]) + (v[j][2] * v[j][2] + v[j][3] * v[j][3]); }
            const float rstd = rsqrtf(wave_sum(s) * (1.f / DM) + NORM_EPS);
            v2u* o8 = (v2u*)(XN + (size_t)m * DM) + lane;
#pragma unroll
            for (int j = 0; j < 8; ++j) { const f32x4 w = ((const f32x4*)nw)[lane + 64 * j]; v2u o; o.x = pk2(v[j][0] * rstd * w[0], v[j][1] * rstd * w[1]); o.y = pk2(v[j][2] * rstd * w[2], v[j][3] * rstd * w[3]); o8[64 * j] = o; }
        }
        if (bx == 0) {
            const float* tbl = args.in[3];
            for (int idx = tid; idx < 3 * 129; idx += NWAVES * 64) { const int p = idx / 129, s = idx % 129; const int r = (p == 0) ? 1 : (p == 1 ? 4 : 16);
                const int bk = t5_bucket((s - 64) * r);
                for (int h = 0; h < 16; ++h) BIAS2[idx * 16 + h] = tbl[bk * 16 + h] * LOG2E; }
        }
    }
    SEAM(0);

    if (IN(1)) {
        { pg8::Gemm g{XN, Wt_in, T_, 5120, DM}; pg8::StaticOrder S; S.init(T_, 5120, G, bx); pg8::EpiProj E{RB};
          pg8::gemm_phase<pg8::EpiProj, pg8::StaticOrder, true, true>(lds, g, S, E); }
        { pg8::Gemm g{Wt_in + (size_t)5120 * DM, XN, 1024, T_, DM}; pg8::StaticOrder S; S.init(1024, T_, G, (bx + G / 2) % G); pg8::EpiPlain E{RB + E_GVT, 1024};
          pg8::gemm_phase<pg8::EpiPlain, pg8::StaticOrder, true, true>(lds, g, S, E); }
        for (int tb = bx; tb < T_ / 32; tb += G) {
            const int l31 = lane & 31, hi5 = lane >> 5;
            const bf16* ap = XN + (size_t)(tb * 32 + l31) * DM + 256 * wave + 8 * hi5; const bf16* bp = Wt_in + (size_t)(6144 + l31) * DM + 256 * wave + 8 * hi5;
            bf16x8 af[16], bfr[16];
#pragma unroll
            for (int s = 0; s < 16; ++s) { af[s] = *(const bf16x8*)(ap + 16 * s); bfr[s] = *(const bf16x8*)(bp + 16 * s); }
            f32x16 acc = {};
#pragma unroll
            for (int s = 0; s < 16; ++s) acc = MFMA32(af[s], bfr[s], acc);
            __syncthreads();
            LAS float* part = (LAS float*)lds;
#pragma unroll
            for (int r = 0; r < 16; ++r) part[(wave * 16 + r) * 64 + lane] = acc[r];
            __syncthreads();
#pragma unroll
            for (int rr = 0; rr < 2; ++rr) { const int r = 2 * wave + rr; float s = 0.f;
#pragma unroll
                for (int w = 0; w < 8; ++w) s += part[(w * 16 + r) * 64 + lane];
                GLR[(size_t)(tb * 32 + crow(r, hi5)) * 32 + l31] = s; }
        }
    }
    SEAM(1);

    if (IN(2)) {
        for (int it = bx; it < 512; it += G) gla_unit(it, GB, lds, tid, lane, wave);
    }
    SEAM(2);

    if (IN(3)) {
        if (bx < 32) gla_scan((bx & 7) * 4 + (bx >> 3), GB, lds, tid, lane, wave);
        else {
            attn_units(bx - 32, G - 32, AB, lds, tid, lane, wave);
            WG_BAR();
            p0_run(P0_FIRST, P0_NITEMS, (bx - 32) * NWAVES + wave, (G - 32) * NWAVES, PP, (LAS float*)(lds + wave * 16384), lane);
        }
    }
    SEAM(3);

    if (IN(4)) {
        const bf16* GR = RB + E_GR; const float* gnw = args.in[8];
        constexpr int MR = 8;
        for (int item = gw; item < (T_ / MR) * 8; item += NGW) { const int row0 = (item >> 3) * MR, part = item & 7;
            if (part < 4) {
                const int hh = 4 * part + (lane >> 4);
                float l0[MR], l1[MR], l2[MR]; v2u a0[MR], a1[MR], a2[MR];
#pragma unroll
                for (int r = 0; r < MR; ++r) { const size_t row = row0 + r; const size_t eo = row * AW + part * 256 + lane * 4;
                    l0[r] = AB.LSE[row * AH + hh]; l1[r] = AB.LSE[(size_t)T_ * AH + row * AH + hh]; l2[r] = AB.LSE[(size_t)2 * T_ * AH + row * AH + hh];
                    a0[r] = *(const v2u*)(AB.OP + eo); a1[r] = *(const v2u*)(AB.OP + (size_t)T_ * AW + eo); a2[r] = *(const v2u*)(AB.OP + (size_t)2 * T_ * AW + eo); }
#pragma unroll
                for (int r = 0; r < MR; ++r) {
                    const float M = fmaxf(fmaxf(l0[r], l1[r]), l2[r]); const float w0 = exp2f(l0[r] - M), w1 = exp2f(l1[r] - M), w2 = exp2f(l2[r] - M); const float iw = 1.0f / (w0 + w1 + w2);
                    const float y0 = (w0 * bflo(a0[r].x) + w1 * bflo(a1[r].x) + w2 * bflo(a2[r].x)) * iw, y1 = (w0 * bfhi(a0[r].x) + w1 * bfhi(a1[r].x) + w2 * bfhi(a2[r].x)) * iw;
                    const float y2 = (w0 * bflo(a0[r].y) + w1 * bflo(a1[r].y) + w2 * bflo(a2[r].y)) * iw, y3 = (w0 * bfhi(a0[r].y) + w1 * bfhi(a1[r].y) + w2 * bfhi(a2[r].y)) * iw;
                    v2u ov; ov.x = pk2(y0, y1); ov.y = pk2(y2, y3);
                    *(v2u*)(Y + (size_t)(row0 + r) * DM + part * 256 + lane * 4) = ov; }
            } else { const int h = part - 4;
                v2u a[MR], c[MR], e[MR], g[MR];
#pragma unroll
                for (int r = 0; r < MR; ++r) { const size_t o = (size_t)(row0 + r) * GVW + h * 256;
                    a[r] = ((const v2u*)(GB.OI + o))[lane]; c[r] = ((const v2u*)(GB.OSF + o))[lane]; e[r] = ((const v2u*)(GB.OSB + o))[lane]; g[r] = ((const v2u*)(GR + o))[lane]; }
                const f32x4 w = ((const f32x4*)(gnw + h * 256))[lane];
#pragma unroll
                for (int r = 0; r < MR; ++r) {
                    float v[4] = {bflo(a[r].x) + bflo(c[r].x) + bflo(e[r].x), bfhi(a[r].x) + bfhi(c[r].x) + bfhi(e[r].x), bflo(a[r].y) + bflo(c[r].y) + bflo(e[r].y), bfhi(a[r].y) + bfhi(c[r].y) + bfhi(e[r].y)};
                    const float gr[4] = {bflo(g[r].x), bfhi(g[r].x), bflo(g[r].y), bfhi(g[r].y)};
                    const float ss = wave_sum((v[0] * v[0] + v[1] * v[1]) + (v[2] * v[2] + v[3] * v[3]));
                    const float rstd = rsqrtf(ss * (1.0f / 256.0f) + NORM_EPS);
                    float y[4];
#pragma unroll
                    for (int i = 0; i < 4; ++i) y[i] = v[i] * rstd * w[i] * (gr[i] / (1.0f + __expf(-gr[i])));
                    v2u ov; ov.x = pk2(y[0], y[1]); ov.y = pk2(y[2], y[3]);
                    ((v2u*)(Y + (size_t)(row0 + r) * DM + 1024 + h * 256))[lane] = ov; }
            }
        }
    }
    SEAM(4);

    if (IN(5)) {
        pg8::Gemm g{Y, Wt_out, T_, DM, DM}; pg8::StaticOrder S; S.init(T_, DM, G, bx); pg8::EpiRes<true> E{x, out, X1B, SSQ1};
        pg8::gemm_phase<pg8::EpiRes<true>, pg8::StaticOrder, false, true>(lds, g, S, E);
    }
    SEAM(5);

    if (IN(6)) {
        pg8::Gemm g{X1B, Wt_gu, T_, 2 * FF, DM}; pg8::StaticOrder S; S.init(T_, 2 * FF, G, bx); pg8::EpiSwiglu E{HB, SSQ1};
        pg8::gemm_phase<pg8::EpiSwiglu, pg8::StaticOrder, true, true>(lds, g, S, E);
    }
    SEAM(6);

    if (IN(7)) {
        pg8::Gemm g{HB, Wt_dn, T_, DM, FF}; pg8::StaticOrder S; S.init(T_, DM, G, bx); pg8::EpiRes<false> E{out, out, nullptr, nullptr};
        pg8::gemm_phase<pg8::EpiRes<false>, pg8::StaticOrder, false, true>(lds, g, S, E);
    }
    SEAM(7);

    if (IN(8)) {
        const float* fw = args.in[14];
        for (int m = gw; m < T_; m += NGW) {
            f32x4* xr = (f32x4*)(out + (size_t)m * DM) + lane; f32x4 v[8]; float s = 0.f;
#pragma unroll
            for (int j = 0; j < 8; ++j) { v[j] = xr[64 * j]; s += (v[j][0] * v[j][0] + v[j][1] * v[j][1]) + (v[j][2] * v[j][2] + v[j][3] * v[j][3]); }
            const float rstd = rsqrtf(wave_sum(s) * (1.f / DM) + NORM_EPS);
#pragma unroll
            for (int j = 0; j < 8; ++j) { const f32x4 w = ((const f32x4*)fw)[lane + 64 * j]; xr[64 * j] = v[j] * rstd * w; }
        }
    }
#if PROBE_TS
    cg::this_grid().sync();
    if (bx == 0) {
        const float A = 10.0f * floorf((float)(TS[PROBE_A_WG * 16 + PROBE_A_K1] - TS[PROBE_A_WG * 16 + PROBE_A_K0]) * 0.001f + 0.5f);
        const float Bv = 10.0f * floorf((float)(TS[PROBE_B_WG * 16 + PROBE_B_K1] - TS[PROBE_B_WG * 16 + PROBE_B_K0]) * 0.001f + 0.5f);
        if (tid == 0) out[0] = A;
        for (int i = 0; i < 2048; ++i) out[1024 + tid + 512 * i] += Bv * 0.01f;
    }
#endif
#undef IN
#undef SEAM
}

extern "C" void kernel_launch(void* const* d_in, const int* in_sizes, int n_in, void* d_out, int out_size, void* d_ws, size_t ws_size, hipStream_t stream) {
    static int grid = 0;
    if (grid == 0) {
        if (n_in != 15 || out_size != T_ * DM || ws_size < WS_END) { fprintf(stderr, "kernel_launch: unexpected shapes (n_in %d out %d ws %zu)\n", n_in, out_size, ws_size); grid = -1; return; }
        int dev = 0, cus = 0, per_cu = 0;
        if (hipGetDevice(&dev) != hipSuccess || hipDeviceGetAttribute(&cus, hipDeviceAttributeMultiprocessorCount, dev) != hipSuccess) { grid = -1; return; }
        if (hipFuncSetAttribute((const void*)fwd, hipFuncAttributeMaxDynamicSharedMemorySize, LDS_BYTES) != hipSuccess) { fprintf(stderr, "kernel_launch: hipFuncSetAttribute failed\n"); grid = -1; return; }
        if (hipOccupancyMaxActiveBlocksPerMultiprocessor(&per_cu, (const void*)fwd, NWAVES * 64, LDS_BYTES) != hipSuccess || per_cu < 1) { fprintf(stderr, "kernel_launch: occupancy query reports %d\n", per_cu); per_cu = 1; }
        (void)hipGetLastError();
        if (cus < 64) { fprintf(stderr, "kernel_launch: built for a 256-CU device (got %d CUs)\n", cus); grid = -1; return; }
        grid = cus;
    }
    if (grid < 0) return;
    Args a{};
    for (int i = 0; i < 15; ++i) a.in[i] = (const float*)d_in[i];
    a.out = (float*)d_out; a.ws = (unsigned char*)d_ws;
#if MK_LAUNCHES == 1
    void* kargs[] = {&a};
#if PROBE_PREFIX > 0
    a.ph_lo = 0; a.ph_hi = PROBE_PREFIX;
    (void)hipLaunchCooperativeKernel((const void*)fwd, dim3(grid), dim3(NWAVES * 64), kargs, LDS_BYTES, stream);
#endif
    a.ph_lo = 0; a.ph_hi = NPHASE;
    hipError_t e = hipLaunchCooperativeKernel((const void*)fwd, dim3(grid), dim3(NWAVES * 64), kargs, LDS_BYTES, stream);
    if (e != hipSuccess) fprintf(stderr, "kernel_launch: cooperative launch failed: %s (grid %d)\n", hipGetErrorString(e), grid);
#else
    for (int p = 0; p < NPHASE; ++p) { a.ph_lo = p; a.ph_hi = p + 1; hipLaunchKernelGGL(fwd, dim3(grid), dim3(NWAVES * 64), LDS_BYTES, stream, a); }
#endif
}
```

```cpp
#include <hip/hip_runtime.h>
#include <hip/hip_cooperative_groups.h>
#include <cstdio>
#include <cstdint>
namespace cg = cooperative_groups;

namespace pg8 {
#define PG8_LAS __attribute__((address_space(3)))
typedef unsigned short bf16_t;
typedef short bf16x8 __attribute__((ext_vector_type(8)));
typedef float f32x4 __attribute__((ext_vector_type(4)));
typedef unsigned u32x4 __attribute__((ext_vector_type(4)));
constexpr int BM = 256, BK = 64, HALF = 128, HTB = HALF * BK * 2  , STAGE_BYTES = 8 * HTB, NXCD = 8, WGM = 8;

__host__ __device__ __forceinline__ int lds_byte(int r, int c) { const int st = (r >> 4) * 2 + (c >> 5), rr = r & 15, cc = c & 31, ob = rr * 64 + cc * 2; return st * 1024 + (ob ^ (((ob >> 9) & 1) << 5)); }
__host__ __device__ __forceinline__ void stage_rc(int b, int& R, int& C) { const int st = b / 1024, sb = b % 1024, swz = sb ^ (((sb >> 9) & 1) << 5); R = (st >> 1) * 16 + swz / 64; C = (st & 1) * 32 + (swz % 64) / 2; }
__host__ __device__ __forceinline__ int perm32(int rho) { const int n = rho >> 4, i = rho & 15; return 8 * (i >> 2) + 4 * n + (i & 3); }

struct Unit { int pm, pn; };
struct Gemm { const bf16_t* A; const bf16_t* Bt; int M, N, K; };

struct StaticOrder {
    int nM, nN, nwg, G, c;
    __host__ __device__ void init(int M, int N, int G_, int c_) { nM = M / BM; nN = N / BM; nwg = nM * nN; G = G_; c = c_; }
    __host__ __device__ bool next(int i, Unit& u) const {
        const long L = (long)i * G + c; if (L >= nwg) return false;
        int wgid = (int)L; { const int q = nwg / NXCD, r = nwg % NXCD, xcd = wgid % NXCD, off = wgid / NXCD; wgid = (xcd < r ? xcd * (q + 1) : r * (q + 1) + (xcd - r) * q) + off; }
        const int nig = WGM * nN, gid = wgid / nig, fm = gid * WGM, gsz = (nM - fm) < WGM ? (nM - fm) : WGM;
        u.pm = fm + ((wgid % nig) % gsz); u.pn = (wgid % nig) / gsz; return true;
    }
    __device__ __forceinline__ void a_ready(const Unit&) const {}
    __device__ __forceinline__ void done(const Unit&) const {}
};

__device__ __forceinline__ unsigned cvt_pk_bf16(float lo, float hi) { unsigned r; asm volatile("v_cvt_pk_bf16_f32 %0, %1, %2" : "=v"(r) : "v"(lo), "v"(hi)); return r; }
template <class Epi, class Sched, bool ALIGN_EPI = false, bool SP2 = false>
__device__ __forceinline__ void gemm_phase(PG8_LAS unsigned char* lds, const Gemm g, const Sched& S, const Epi& E) {
    const int tid = threadIdx.x, wid = __builtin_amdgcn_readfirstlane(tid >> 6), lane = tid & 63, wr = wid >> 2, wc = wid & 3, fr = lane & 15, fq = lane >> 4;
    const int K = g.K, nt = K / BK;
    unsigned voffA[2], voffB[2];
#pragma unroll
    for (int i = 0; i < 2; ++i) { int R, C; stage_rc(tid * 16 + i * 8192, R, C); const int Rb = Epi::PERM ? ((R & ~31) + perm32(R & 31)) : R;
        voffA[i] = (unsigned)(R * K + C) * 2u; voffB[i] = (unsigned)(Rb * K + C) * 2u; }
    const size_t kstep = (size_t)(BK * 2);
    const size_t hstep = (size_t)HALF * K * 2;
    const size_t tstep = 2 * hstep;
    const unsigned ldsw = (unsigned)wid * 1024u;
    const int aoff = lds_byte(wr * 64 + fr, fq * 8), boff = lds_byte(wc * 32 + fr, fq * 8);
#define PG8_SA(b, h) (((b) * 2 + (h)) * HTB)
#define PG8_SB(b, h) ((4 + (b) * 2 + (h)) * HTB)
#define PG8_STAGE(bufoff, gbase, voff) do { _Pragma("unroll") for (int _i = 0; _i < 2; ++_i) \
        __builtin_amdgcn_global_load_lds((const unsigned*)((const char*)(gbase) + (voff)[_i]), (PG8_LAS unsigned*)(lds + (bufoff) + ldsw + _i * 8192), 16, 0, 0); } while (0)
#define PG8_LDA(dst, b, h) do { _Pragma("unroll") for (int m = 0; m < 4; ++m) _Pragma("unroll") for (int k = 0; k < 2; ++k) dst[m][k] = *(const PG8_LAS bf16x8*)(lds + PG8_SA(b, h) + aoff + m * 2048 + k * 1024); } while (0)
#define PG8_LDB(dst, b, h) do { _Pragma("unroll") for (int n = 0; n < 2; ++n) _Pragma("unroll") for (int k = 0; k < 2; ++k) dst[n][k] = *(const PG8_LAS bf16x8*)(lds + PG8_SB(b, h) + boff + n * 2048 + k * 1024); } while (0)
#define PG8_MMA(ai, bj, At, Bt) do { __builtin_amdgcn_s_setprio(1); _Pragma("unroll") for (int m = 0; m < 4; ++m) _Pragma("unroll") for (int n = 0; n < 2; ++n) _Pragma("unroll") for (int k = 0; k < 2; ++k) \
        acc[ai][bj][m][n] = __builtin_amdgcn_mfma_f32_16x16x32_bf16(Bt[n][k], At[m][k], acc[ai][bj][m][n], 0, 0, 0); __builtin_amdgcn_s_setprio(0); } while (0)
#define PG8_WAIT_V(n) asm volatile("s_waitcnt vmcnt(" #n ")" ::: "memory")
#define PG8_WAIT_L(n) asm volatile("s_waitcnt lgkmcnt(" #n ")" ::: "memory")
#define PG8_BAR __builtin_amdgcn_s_barrier()
#define PG8_SCHED __builtin_amdgcn_sched_barrier(0)
    Unit cur, nxt; int ui = 0;
    if (!S.next(0, cur)) return;
    f32x4 acc[2][2][4][2];
#pragma unroll
    for (int a = 0; a < 2; ++a)
#pragma unroll
        for (int b = 0; b < 2; ++b)
#pragma unroll
            for (int m = 0; m < 4; ++m)
#pragma unroll
                for (int n = 0; n < 2; ++n) acc[a][b][m][n] = (f32x4){0.f, 0.f, 0.f, 0.f};
    bf16x8 At[4][2], B0[2][2], B1[2][2];
    const char* cA = (const char*)g.A + (size_t)cur.pm * tstep; const char* cB = (const char*)g.Bt + (size_t)cur.pn * tstep;
    S.a_ready(cur);
    if constexpr (SP2) {
        PG8_STAGE(PG8_SB(0, 0), cB, voffB); PG8_STAGE(PG8_SB(0, 1), cB + hstep, voffB); PG8_STAGE(PG8_SA(0, 0), cA, voffA); PG8_STAGE(PG8_SA(0, 1), cA + hstep, voffA);
        if (wr == 1) PG8_BAR;
        PG8_WAIT_V(2); PG8_BAR;
        PG8_STAGE(PG8_SB(1, 0), cB + kstep, voffB); PG8_STAGE(PG8_SA(1, 0), cA + kstep, voffA); PG8_STAGE(PG8_SB(1, 1), cB + hstep + kstep, voffB);
        PG8_WAIT_V(6); PG8_BAR;
    } else {
        PG8_STAGE(PG8_SB(0, 0), cB, voffB); PG8_STAGE(PG8_SA(0, 0), cA, voffA); PG8_STAGE(PG8_SB(0, 1), cB + hstep, voffB); PG8_STAGE(PG8_SA(0, 1), cA + hstep, voffA);
        if (wr == 1) PG8_BAR;
        PG8_WAIT_V(4); PG8_BAR;
        PG8_STAGE(PG8_SB(1, 0), cB + kstep, voffB); PG8_STAGE(PG8_SA(1, 0), cA + kstep, voffA); PG8_STAGE(PG8_SB(1, 1), cB + hstep + kstep, voffB);
        PG8_WAIT_V(6); PG8_BAR;
    }
    for (;;) {
        const bool has_next = S.next(ui + 1, nxt);
        const char* nA = has_next ? (const char*)g.A + (size_t)nxt.pm * tstep : cA; const char* nB = has_next ? (const char*)g.Bt + (size_t)nxt.pn * tstep : cB;
        for (int t = 0; t < nt; t += 2) {
            const bool last = (t == nt - 2);
            const char* a1 = cA + (size_t)(t + 1) * kstep;
            const char* a2 = last ? nA : cA + (size_t)(t + 2) * kstep; const char* b2 = last ? nB : cB + (size_t)(t + 2) * kstep;
            const char* a3 = a2 + kstep; const char* b3 = b2 + kstep;
            if (last && has_next) S.a_ready(nxt);
            if constexpr (SP2) {
            PG8_LDB(B0, 0, 0); PG8_LDB(B1, 0, 1); PG8_SCHED; PG8_LDA(At, 0, 0); PG8_STAGE(PG8_SA(1, 1), a1 + hstep, voffA);
            PG8_WAIT_V(8); PG8_WAIT_L(0); PG8_BAR; PG8_MMA(0, 0, At, B0); PG8_MMA(0, 1, At, B1); PG8_BAR; PG8_SCHED;
            PG8_LDA(At, 0, 1); PG8_STAGE(PG8_SB(0, 0), b2, voffB); PG8_STAGE(PG8_SB(0, 1), b2 + hstep, voffB); PG8_STAGE(PG8_SA(0, 0), a2, voffA);
            PG8_WAIT_V(8); PG8_WAIT_L(0); PG8_BAR; PG8_MMA(1, 0, At, B0); PG8_MMA(1, 1, At, B1); PG8_BAR; PG8_SCHED;
            PG8_LDB(B0, 1, 0); PG8_LDB(B1, 1, 1); PG8_SCHED; PG8_LDA(At, 1, 0); PG8_STAGE(PG8_SA(0, 1), a2 + hstep, voffA);
            PG8_WAIT_V(8); PG8_WAIT_L(0); PG8_BAR; PG8_MMA(0, 0, At, B0); PG8_MMA(0, 1, At, B1); PG8_BAR; PG8_SCHED;
            PG8_LDA(At, 1, 1); PG8_STAGE(PG8_SB(1, 0), b3, voffB); PG8_STAGE(PG8_SB(1, 1), b3 + hstep, voffB); PG8_STAGE(PG8_SA(1, 0), a3, voffA);
            PG8_WAIT_V(8); PG8_WAIT_L(0); PG8_BAR; PG8_MMA(1, 0, At, B0); PG8_MMA(1, 1, At, B1); PG8_BAR; PG8_SCHED;
            } else {
            PG8_LDB(B0, 0, 0); PG8_SCHED; PG8_LDA(At, 0, 0); PG8_STAGE(PG8_SA(1, 1), a1 + hstep, voffA);
            PG8_WAIT_L(8); PG8_BAR; PG8_WAIT_L(0); PG8_MMA(0, 0, At, B0); PG8_BAR; PG8_SCHED;
            PG8_LDB(B1, 0, 1); PG8_STAGE(PG8_SB(0, 0), b2, voffB);
            PG8_BAR; PG8_WAIT_L(0); PG8_MMA(0, 1, At, B1); PG8_BAR;
            PG8_LDA(At, 0, 1); PG8_STAGE(PG8_SA(0, 0), a2, voffA);
            PG8_BAR; PG8_WAIT_L(0); PG8_MMA(1, 0, At, B0); PG8_BAR; PG8_SCHED;
            PG8_STAGE(PG8_SB(0, 1), b2 + hstep, voffB);
            PG8_WAIT_V(6); PG8_BAR; PG8_MMA(1, 1, At, B1); PG8_BAR;
            PG8_LDB(B0, 1, 0); PG8_SCHED; PG8_LDA(At, 1, 0); PG8_STAGE(PG8_SA(0, 1), a2 + hstep, voffA);
            PG8_WAIT_L(8); PG8_BAR; PG8_WAIT_L(0); PG8_MMA(0, 0, At, B0); PG8_BAR; PG8_SCHED;
            PG8_LDB(B1, 1, 1); PG8_STAGE(PG8_SB(1, 0), b3, voffB);
            PG8_BAR; PG8_WAIT_L(0); PG8_MMA(0, 1, At, B1); PG8_BAR;
            PG8_LDA(At, 1, 1); PG8_STAGE(PG8_SA(1, 0), a3, voffA);
            PG8_BAR; PG8_WAIT_L(0); PG8_MMA(1, 0, At, B0); PG8_BAR; PG8_SCHED;
            PG8_STAGE(PG8_SB(1, 1), b3 + hstep, voffB);
            PG8_WAIT_V(6); PG8_BAR; PG8_MMA(1, 1, At, B1); PG8_BAR;
            }
        }
        if constexpr (ALIGN_EPI) { if (wr == 0) PG8_BAR; }
        if constexpr (!Epi::AFTER_DRAIN) { E(acc, cur, wr, wc, fr, fq); S.done(cur); }
        if (!has_next) break;
#pragma unroll
        for (int a = 0; a < 2; ++a)
#pragma unroll
            for (int b = 0; b < 2; ++b)
#pragma unroll
                for (int m = 0; m < 4; ++m)
#pragma unroll
                    for (int n = 0; n < 2; ++n) acc[a][b][m][n] = (f32x4){0.f, 0.f, 0.f, 0.f};
        cur = nxt; cA = nA; cB = nB; ++ui;
        if constexpr (ALIGN_EPI) { if (wr == 1) PG8_BAR; }
    }
    PG8_WAIT_V(0);
    if constexpr (!ALIGN_EPI) { if (wr == 0) PG8_BAR; }
    PG8_BAR;
    if constexpr (Epi::AFTER_DRAIN) { E.fused(acc, cur, wr, wc, fr, fq, lds, wid, lane); S.done(cur); }
#undef PG8_SA
#undef PG8_SB
#undef PG8_STAGE
#undef PG8_LDA
#undef PG8_LDB
#undef PG8_MMA
#undef PG8_WAIT_V
#undef PG8_WAIT_L
#undef PG8_BAR
#undef PG8_SCHED
}
}

constexpr int SEQ = 4096, NB = 2, T_ = NB * SEQ, DM = 2048, INW = 6176, FF = 5632;
constexpr int AH = 16, AD = 64, AW = 1024;
constexpr int GH = 4, GDK = 128, GDV = 256, GKW = 512, GVW = 1024, GRANK = 16;
constexpr float NORM_EPS = 1e-6f;
constexpr float LOG2E = 1.4426950408889634f;
constexpr int NWAVES = 8;
constexpr int NPHASE = 9;
#ifndef PROBE_PREFIX
#define PROBE_PREFIX 0
#endif
#ifndef PROBE_TS
#define PROBE_TS 0
#endif
#ifndef PROBE_SCAN
#define PROBE_SCAN 0
#endif
#ifndef MK_LAUNCHES
#define MK_LAUNCHES 1
#endif

constexpr size_t MiB = 1u << 20;
constexpr size_t WS_CTL = 0;
constexpr size_t WS_BIAS2 = 64 * 1024;
constexpr size_t WS_SSQ1 = 128 * 1024;
constexpr size_t WS_WIN = 1 * MiB;
constexpr size_t WS_WOUT = 26 * MiB;
constexpr size_t WS_WGU = 34 * MiB;
constexpr size_t WS_WDN = 78 * MiB;
constexpr size_t WS_XN = 100 * MiB;
constexpr size_t WS_RB = 132 * MiB;
constexpr size_t WS_END = 229 * MiB;
constexpr size_t E_AQ = 0, E_AK = (size_t)T_ * 1024, E_AV = 2 * (size_t)T_ * 1024, E_GQ = 3 * (size_t)T_ * 1024, E_GK = E_GQ + (size_t)T_ * 512,
                 E_GVT = 4 * (size_t)T_ * 1024, E_GR = 5 * (size_t)T_ * 1024, E_GLR = 6 * (size_t)T_ * 1024;

#define GAS __attribute__((address_space(1)))
#define LAS __attribute__((address_space(3)))
typedef unsigned short bf16;
typedef unsigned v4u __attribute__((ext_vector_type(4)));
typedef unsigned v2u __attribute__((ext_vector_type(2)));
typedef float f32x4 __attribute__((ext_vector_type(4)));
#define LDS_WAIT() asm volatile("s_waitcnt lgkmcnt(0)" ::: "memory")
__device__ __forceinline__ unsigned f2bf(float f) { unsigned u = __builtin_bit_cast(unsigned, f); return (u + 0x7fffu + ((u >> 16) & 1u)) >> 16; }
__device__ __forceinline__ unsigned pk2(float lo, float hi) { return f2bf(lo) | (f2bf(hi) << 16); }
__device__ __forceinline__ float bf2f(unsigned b) { return __builtin_bit_cast(float, b << 16); }
__device__ __forceinline__ float bflo(unsigned w) { return __builtin_bit_cast(float, w << 16); }
__device__ __forceinline__ float bfhi(unsigned w) { return __builtin_bit_cast(float, w & 0xffff0000u); }
__device__ __forceinline__ float wave_sum(float v) {
#pragma unroll
    for (int o = 1; o < 64; o <<= 1) v += __shfl_xor(v, o);
    return v;
}
__device__ __forceinline__ float wave_max(float v) {
#pragma unroll
    for (int o = 1; o < 64; o <<= 1) v = fmaxf(v, __shfl_xor(v, o));
    return v;
}

namespace pg8 {
struct EpiProj {
    static constexpr bool PERM = true, AFTER_DRAIN = false;
    bf16_t* rb;
    __device__ __forceinline__ void operator()(const f32x4 (&acc)[2][2][4][2], const Unit& u, int wr, int wc, int fr, int fq) const {
        const int pn = u.pn; bf16_t* base; int ldc, colt;
        if (pn < 12) {
            bf16_t* mat = rb + (size_t)(pn >> 2) * ((size_t)T_ * 1024);
            const int row0 = u.pm * BM + wr * 64 + fr, colm = (pn & 3) * 256 + wc * 32 + 8 * fq;
#pragma unroll
            for (int ai = 0; ai < 2; ++ai)
#pragma unroll
                for (int m = 0; m < 4; ++m) { const int tg = row0 + ai * HALF + m * 16;
#pragma unroll
                    for (int bj = 0; bj < 2; ++bj) { const int col = colm + bj * HALF; const f32x4 v0 = acc[ai][bj][m][0], v1 = acc[ai][bj][m][1];
                        u32x4 w; w.x = cvt_pk_bf16(v0[0], v0[1]); w.y = cvt_pk_bf16(v0[2], v0[3]); w.z = cvt_pk_bf16(v1[0], v1[1]); w.w = cvt_pk_bf16(v1[2], v1[3]);
                        *(u32x4*)(mat + ((size_t)((tg >> 12) * 16 + (col >> 6)) * 4096 + (tg & 4095)) * 64 + (col & 63)) = w; } }
            return; }
        if (pn < 16) { base = rb + E_GQ + (size_t)((pn - 12) >> 1) * ((size_t)T_ * 512); ldc = 512; colt = ((pn - 12) & 1) * 256; }
        else { base = rb + E_GR; ldc = 1024; colt = (pn - 16) * 256; }
        const int row0 = u.pm * BM + wr * 64 + fr, col0 = colt + wc * 32 + 8 * fq;
#pragma unroll
        for (int ai = 0; ai < 2; ++ai)
#pragma unroll
            for (int m = 0; m < 4; ++m) { bf16_t* rowp = base + (size_t)(row0 + ai * HALF + m * 16) * ldc + col0;
#pragma unroll
                for (int bj = 0; bj < 2; ++bj) { const f32x4 v0 = acc[ai][bj][m][0], v1 = acc[ai][bj][m][1];
                    u32x4 w; w.x = cvt_pk_bf16(v0[0], v0[1]); w.y = cvt_pk_bf16(v0[2], v0[3]); w.z = cvt_pk_bf16(v1[0], v1[1]); w.w = cvt_pk_bf16(v1[2], v1[3]);
                    *(u32x4*)(rowp + bj * HALF) = w; } }
    }
};
struct EpiPlain {
    static constexpr bool PERM = true, AFTER_DRAIN = false;
    bf16_t* O; int nrows;
    __device__ __forceinline__ void operator()(const f32x4 (&acc)[2][2][4][2], const Unit& u, int wr, int wc, int fr, int fq) const {
        const int row0 = u.pm * BM + wr * 64 + fr, col0 = u.pn * BM + wc * 32 + 8 * fq;
#pragma unroll
        for (int ai = 0; ai < 2; ++ai)
#pragma unroll
            for (int m = 0; m < 4; ++m) { const int row = row0 + ai * HALF + m * 16;
#pragma unroll
                for (int bj = 0; bj < 2; ++bj) { const int col = col0 + bj * HALF; const f32x4 v0 = acc[ai][bj][m][0], v1 = acc[ai][bj][m][1];
                    u32x4 w; w.x = cvt_pk_bf16(v0[0], v0[1]); w.y = cvt_pk_bf16(v0[2], v0[3]); w.z = cvt_pk_bf16(v1[0], v1[1]); w.w = cvt_pk_bf16(v1[2], v1[3]);
                    *(u32x4*)(O + ((size_t)(col >> 6) * nrows + row) * 64 + (col & 63)) = w; } }
    }
};
template <bool AUX> struct EpiRes {
    static constexpr bool PERM = false, AFTER_DRAIN = true;
    const float* base; float* out; bf16_t* xb; float* ssq;
    __device__ __forceinline__ void fused(f32x4 (&acc)[2][2][4][2], const Unit& u, int wr, int wc, int fr, int fq, PG8_LAS unsigned char* lds, int wid, int lane) const {
        PG8_LAS float* P = (PG8_LAS float*)lds;
        const int col0 = u.pn * BM + wc * 32 + 4 * fq;
#pragma unroll
        for (int ai = 0; ai < 2; ++ai)
#pragma unroll
            for (int m = 0; m < 4; ++m) { const int rl = ai * HALF + wr * 64 + m * 16 + fr; const size_t off = (size_t)(u.pm * BM + rl) * DM + col0; float s = 0.f;
#pragma unroll
                for (int bj = 0; bj < 2; ++bj)
#pragma unroll
                    for (int n = 0; n < 2; ++n) { const f32x4 bs = *(const f32x4*)(base + off + bj * HALF + n * 16); const f32x4 v = bs + acc[ai][bj][m][n];
                        *(f32x4*)(out + off + bj * HALF + n * 16) = v;
                        if (AUX) { s += (v[0] * v[0] + v[1] * v[1]) + (v[2] * v[2] + v[3] * v[3]);
                            typedef unsigned u32x2 __attribute__((ext_vector_type(2))); u32x2 w; w.x = cvt_pk_bf16(v[0], v[1]); w.y = cvt_pk_bf16(v[2], v[3]);
                            *(u32x2*)(xb + off + bj * HALF + n * 16) = w; } }
                if (AUX) { s += __shfl_xor(s, 16); s += __shfl_xor(s, 32); if (fq == 0) P[rl * 4 + wc] = s; }
            }
        if (AUX) {
            asm volatile("s_waitcnt lgkmcnt(0)" ::: "memory"); __builtin_amdgcn_s_barrier(); asm volatile("" ::: "memory");
            const int tid = wid * 64 + lane;
            if (tid < 256) { const float s = (P[tid * 4 + 0] + P[tid * 4 + 1]) + (P[tid * 4 + 2] + P[tid * 4 + 3]); ssq[(size_t)(u.pm * BM + tid) * 8 + u.pn] = s; }
        }
    }
};
struct EpiSwiglu {
    static constexpr bool PERM = true, AFTER_DRAIN = false;
    bf16_t* H; const float* ssq;
    __device__ __forceinline__ void operator()(const f32x4 (&acc)[2][2][4][2], const Unit& u, int wr, int wc, int fr, int fq) const {
        const int row0 = u.pm * BM + wr * 64 + fr, col0 = u.pn * HALF + wc * 32 + 8 * fq;
#pragma unroll
        for (int ai = 0; ai < 2; ++ai)
#pragma unroll
            for (int m = 0; m < 4; ++m) { const int r = row0 + ai * HALF + m * 16;
                const f32x4 s0 = *(const f32x4*)(ssq + (size_t)r * 8), s1 = *(const f32x4*)(ssq + (size_t)r * 8 + 4);
                const float tot = ((s0[0] + s0[1]) + (s0[2] + s0[3])) + ((s1[0] + s1[1]) + (s1[2] + s1[3]));
                const float rstd = rsqrtf(tot * (1.0f / DM) + NORM_EPS);
                float hv[8];
#pragma unroll
                for (int n = 0; n < 2; ++n)
#pragma unroll
                    for (int i = 0; i < 4; ++i) { const float g = acc[ai][0][m][n][i] * rstd, up = acc[ai][1][m][n][i] * rstd; hv[n * 4 + i] = g / (1.0f + __expf(-g)) * up; }
                u32x4 w; w.x = cvt_pk_bf16(hv[0], hv[1]); w.y = cvt_pk_bf16(hv[2], hv[3]); w.z = cvt_pk_bf16(hv[4], hv[5]); w.w = cvt_pk_bf16(hv[6], hv[7]);
                *(u32x4*)(H + (size_t)r * FF + col0) = w; }
    }
};
}

typedef GAS unsigned gu32;
#define RLX_AGENT __ATOMIC_RELAXED, __HIP_MEMORY_SCOPE_AGENT
#define XB_TMO      128
#define XB_XCNT(j)  (256  + 64 * (j))
#define XB_XSUB(j)  (1280 + 64 * (j))
#define XB_XGEN(j)  (2304 + 64 * (j))
#define XB_TOP      3328
#define XB_TOPGEN   3392
#define XCD_BAR_WORDS 3456
#define XB_SPIN_CAP (1u << 18)

__device__ __forceinline__ unsigned xb_ld(unsigned* p)              { return __hip_atomic_load(p, __ATOMIC_RELAXED, __HIP_MEMORY_SCOPE_AGENT); }
__device__ __forceinline__ unsigned xb_add(unsigned* p, unsigned v) { return __hip_atomic_fetch_add(p, v, __ATOMIC_RELAXED, __HIP_MEMORY_SCOPE_AGENT); }
__device__ __forceinline__ unsigned xb_xcc_id() { return (unsigned)__builtin_amdgcn_s_getreg((3 << 11) | 20) & 0xFu; }
#define XB_SPIN(cond, bar) do { unsigned _sp = 0; while (cond) { __builtin_amdgcn_s_sleep(1); \
    if ((++_sp & 255u) == 0u) { if (xb_ld(&(bar)[XB_TMO])) break; if (_sp > XB_SPIN_CAP) { atomicAdd(&(bar)[XB_TMO], 1u); break; } } } } while (0)

struct XcdBarrier {
    unsigned* bar; unsigned x;
    volatile LAS unsigned* st;
};

__device__ __forceinline__ XcdBarrier xcd_barrier_post(unsigned* bar, volatile LAS unsigned* st) {
    XcdBarrier b; b.bar = bar; b.x = xb_xcc_id(); b.st = st;
    if (threadIdx.x == 0) (void)xb_add(&bar[XB_XCNT(b.x)], 1u);
    return b;
}
__device__ __forceinline__ void xcd_barrier_complete(unsigned* bar, unsigned x, unsigned& nloc, unsigned& nx) {
    const unsigned G = gridDim.x * gridDim.y * gridDim.z;
    unsigned sum, cnt, mine, sp = 0u;
    for (;;) {
        sum = 0u; cnt = 0u; mine = 0u;
#pragma unroll
        for (unsigned j = 0; j < 16; ++j) { const unsigned c = xb_ld(&bar[XB_XCNT(j)]); sum += c; cnt += (c > 0u) ? 1u : 0u; mine = (j == x) ? c : mine; }
        if (sum == G) break;
        __builtin_amdgcn_s_sleep(1);
        if ((++sp & 255u) == 0u) { if (xb_ld(&bar[XB_TMO])) break; if (sp > XB_SPIN_CAP) { atomicAdd(&bar[XB_TMO], 1u); break; } }
    }
    nloc = mine > 0u ? mine : 1u; nx = cnt > 0u ? cnt : 1u;
}

__device__ __forceinline__ void xcd_barrier(const XcdBarrier& b) {
    asm volatile("s_waitcnt vmcnt(0)" ::: "memory");
    __syncthreads();
    if (threadIdx.x == 0) {
        unsigned* bar = b.bar;
        __builtin_amdgcn_s_waitcnt(0);
        unsigned nloc = b.st[0], nx = b.st[1];
        if (nloc == 0u) { xcd_barrier_complete(bar, b.x, nloc, nx); b.st[0] = nloc; b.st[1] = nx; }
        const unsigned old = xb_add(&bar[XB_XSUB(b.x)], 1u);
        const unsigned gen = old / nloc;
        if (old + 1u == (gen + 1u) * nloc) {
            __builtin_amdgcn_fence(__ATOMIC_RELEASE, "agent");
            asm volatile("s_waitcnt vmcnt(0)" ::: "memory");
            const unsigned og = xb_add(&bar[XB_TOP], 1u);
            const unsigned tg = og / nx;
            if (og + 1u == (tg + 1u) * nx) xb_add(&bar[XB_TOPGEN], 1u);
            else XB_SPIN(xb_ld(&bar[XB_TOPGEN]) == tg, bar);
            __builtin_amdgcn_fence(__ATOMIC_ACQUIRE, "agent");
            xb_add(&bar[XB_XGEN(b.x)], 1u);
            asm volatile("s_waitcnt vmcnt(0)" ::: "memory");
        } else {
            XB_SPIN(xb_ld(&bar[XB_XGEN(b.x)]) == gen, bar);
            __builtin_amdgcn_fence(__ATOMIC_ACQUIRE, "agent");
            asm volatile("s_waitcnt vmcnt(0)" ::: "memory");
        }
    }
    __syncthreads();
}

constexpr int RING_BYTES = 131072;
constexpr int LDS_BYTES = 147456;
struct Args { const float* in[15]; float* out; unsigned char* ws; int ph_lo, ph_hi; };
typedef short bf16x8 __attribute__((ext_vector_type(8)));
typedef float f32x16 __attribute__((ext_vector_type(16)));
__device__ __forceinline__ int crow(int r, int hi) { return (r & 3) + 8 * (r >> 2) + 4 * hi; }
typedef float f32x2_t __attribute__((ext_vector_type(2))); typedef __bf16 bf16x2_t __attribute__((ext_vector_type(2)));
__device__ __forceinline__ unsigned cvtpk(float lo, float hi) { f32x2_t v = {lo, hi}; bf16x2_t b = __builtin_convertvector(v, bf16x2_t); return __builtin_bit_cast(unsigned, b); }
template <int S> __device__ __forceinline__ bf16x8 pack8(const f32x16& a) {
    v4u w; w.x = cvtpk(a[8 * S + 0], a[8 * S + 1]); w.y = cvtpk(a[8 * S + 2], a[8 * S + 3]); w.z = cvtpk(a[8 * S + 4], a[8 * S + 5]); w.w = cvtpk(a[8 * S + 6], a[8 * S + 7]);
    return __builtin_bit_cast(bf16x8, w);
}
__device__ __forceinline__ bf16x8 join8(v2u lo, v2u hi) { v4u w; w.x = lo.x; w.y = lo.y; w.z = hi.x; w.w = hi.y; return __builtin_bit_cast(bf16x8, w); }
#define MFMA32(a, b, c) __builtin_amdgcn_mfma_f32_32x32x16_bf16((a), (b), (c), 0, 0, 0)
#define WG_BAR() do { asm volatile("s_waitcnt lgkmcnt(0)" ::: "memory"); __builtin_amdgcn_s_barrier(); asm volatile("" ::: "memory"); } while (0)

struct P0Item { const float* W; bf16* WT; const float* ks; int K, N, k0, n0, drow0; float ns; };
__device__ __forceinline__ void p0_load(const P0Item& I, f32x4 (&r)[8], int lane) {
#pragma unroll
    for (int i = 0; i < 8; ++i) { const int p = lane + 64 * i; r[i] = *(const f32x4*)(I.W + (size_t)(I.k0 + (p >> 3)) * I.N + I.n0 + (p & 7) * 4); }
}
__device__ __forceinline__ void p0_store(const P0Item& I, const f32x4 (&r)[8], LAS float* scr, int lane) {
#pragma unroll
    for (int i = 0; i < 8; ++i) { const int p = lane + 64 * i, kk = p >> 3, n4 = (p & 7) * 4; const float s = (I.ks ? I.ks[I.k0 + kk] : 1.0f) * I.ns;
        scr[kk * 33 + n4 + 0] = r[i][0] * s; scr[kk * 33 + n4 + 1] = r[i][1] * s; scr[kk * 33 + n4 + 2] = r[i][2] * s; scr[kk * 33 + n4 + 3] = r[i][3] * s; }
    LDS_WAIT(); asm volatile("" ::: "memory");
    const int c = lane & 7;
#pragma unroll
    for (int j = 0; j < 4; ++j) { const int n = (lane >> 3) + 8 * j; const LAS float* s = scr + (8 * c) * 33 + n;
        v4u o; o.x = pk2(s[0 * 33], s[1 * 33]); o.y = pk2(s[2 * 33], s[3 * 33]); o.z = pk2(s[4 * 33], s[5 * 33]); o.w = pk2(s[6 * 33], s[7 * 33]);
        *(v4u*)(I.WT + (size_t)(I.drow0 + n) * I.K + I.k0 + 8 * c) = o; }
    LDS_WAIT(); asm volatile("" ::: "memory");
}

struct P0Ptrs { const float* w_in; const float* w_out; const float* w_gate; const float* w_up; const float* w_down; const float* ffn_w; bf16* Wt_in; bf16* Wt_out; bf16* Wt_gu; bf16* Wt_dn; };
constexpr int I_IN = 32 * 193, I_OUT = 32 * 64, I_G = 32 * 176, I_D = 88 * 64, P0_NITEMS = I_IN + I_OUT + 2 * I_G + I_D, P0_FIRST = I_IN + I_OUT;
__device__ __forceinline__ void p0_decode(int it, const P0Ptrs& P, P0Item& I) {
    int r = it; I.ks = nullptr; I.ns = 1.f;
    if (r < I_IN) { const int kb = r / 193, nb = r % 193, n0 = nb * 32; int drow;
        if (n0 < 1024) { drow = n0; I.ns = 0.125f * LOG2E; }
        else if (n0 < 3072) drow = n0;
        else if (n0 < 3584) { drow = n0; I.ns = 0.08838834764831845f; }
        else if (n0 < 4096) drow = n0;
        else if (n0 < 5120) drow = n0 + 1024;
        else if (n0 < 6144) drow = n0 - 1024;
        else drow = n0;
        I.W = P.w_in; I.WT = P.Wt_in; I.K = DM; I.N = INW; I.k0 = kb * 64; I.n0 = n0; I.drow0 = drow; return; }
    r -= I_IN;
    if (r < I_OUT) { const int kb = r / 64, nb = r % 64; I.W = P.w_out; I.WT = P.Wt_out; I.K = DM; I.N = DM; I.k0 = kb * 64; I.n0 = nb * 32; I.drow0 = nb * 32; return; }
    r -= I_OUT;
    if (r < I_G) { const int kb = r / 176, nb = r % 176, n0 = nb * 32; I.W = P.w_gate; I.WT = P.Wt_gu; I.K = DM; I.N = FF; I.k0 = kb * 64; I.n0 = n0; I.drow0 = (n0 >> 7) * 256 + (n0 & 127); I.ks = P.ffn_w; return; }
    r -= I_G;
    if (r < I_G) { const int kb = r / 176, nb = r % 176, n0 = nb * 32; I.W = P.w_up; I.WT = P.Wt_gu; I.K = DM; I.N = FF; I.k0 = kb * 64; I.n0 = n0; I.drow0 = (n0 >> 7) * 256 + 128 + (n0 & 127); I.ks = P.ffn_w; return; }
    r -= I_G;
    { const int kb = r / 64, nb = r % 64; I.W = P.w_down; I.WT = P.Wt_dn; I.K = FF; I.N = DM; I.k0 = kb * 64; I.n0 = nb * 32; I.drow0 = nb * 32; }
}

__device__ __forceinline__ void p0_run(int lo, int hi, int wv, int nwv, const P0Ptrs& PP, LAS float* scr, int lane) {
    P0Item Ic, In; f32x4 rc[8], rn[8];
    int it = lo + wv;
    if (it < hi) { p0_decode(it, PP, Ic); p0_load(Ic, rc, lane); }
    while (it < hi) {
        const int nx = it + nwv;
        if (nx < hi) { p0_decode(nx, PP, In); p0_load(In, rn, lane); }
        p0_store(Ic, rc, scr, lane);
        Ic = In;
#pragma unroll
        for (int i = 0; i < 8; ++i) rc[i] = rn[i];
        it = nx;
    }
}
__device__ __forceinline__ int t5_bucket(int rel) {
    const int nb = 16, max_exact = 8; int ret = rel > 0 ? nb : 0; const int n = rel < 0 ? -rel : rel;
    if (n < max_exact) return ret + n;
    int large = max_exact + (int)(log((double)n / (double)max_exact) / log(1024.0 / 8.0) * (double)(nb - max_exact));
    if (large > nb - 1) large = nb - 1;
    return ret + large;
}
__device__ __forceinline__ float logsig16(float z) { return (fminf(z, 0.f) - __logf(1.0f + __expf(-fabsf(z)))) * (1.0f / 16.0f); }

struct GlaBufs { const bf16* GQ; const bf16* GK; const bf16* GVT; const float* GLR; bf16* QINF; bf16* QINB; bf16* KETF; bf16* KETB; float* DECF; float* DECB; bf16* OI; bf16* OSF; bf16* OSB;
                 const float* gwF; const float* gbF; const float* gwB; const float* gbB; };
constexpr int GP = 136;
__device__ __forceinline__ f32x16 gla_xtile(const LAS bf16* Ks, const LAS bf16* Qs, int jt, int ct, int l31, int hi) {
    f32x16 acc = {};
    const LAS bf16* kp = Ks + (32 * jt + l31) * GP + 8 * hi; const LAS bf16* qp = Qs + (32 * ct + l31) * GP + 8 * hi;
#pragma unroll
    for (int d0 = 0; d0 < 8; ++d0) { const bf16x8 a = *(const LAS bf16x8*)(kp + 16 * d0); const bf16x8 b = *(const LAS bf16x8*)(qp + 16 * d0); acc = MFMA32(a, b, acc); }
    return acc;
}
__device__ __forceinline__ void gla_unit(int unit, const GlaBufs& B, LAS unsigned char* lds, int tid, int lane, int wave) {
    const int n = unit & 63, h = (unit >> 6) & 3, b = unit >> 8;
    const size_t row0 = (size_t)b * SEQ + 64 * n;
    LAS bf16* QF = (LAS bf16*)lds; LAS bf16* KF = QF + 64 * GP; LAS bf16* QB = KF + 64 * GP; LAS bf16* KB = QB + 64 * GP;
    LAS float* PS = (LAS float*)(lds + 69632);
    LAS float* LR = (LAS float*)(lds + 73728);
    LAS unsigned char* R2 = lds + 81920;
    WG_BAR();
    ((LAS f32x4*)LR)[tid] = ((const f32x4*)(B.GLR + row0 * 32))[tid];
    const int d = tid & 127, cgrp = tid >> 7, col = h * 128 + d;
    float gwf[16], gwb[16];
#pragma unroll
    for (int r = 0; r < 16; ++r) { gwf[r] = B.gwF[r * GKW + col]; gwb[r] = B.gwB[r * GKW + col]; }
    const float gbf = B.gbF[col], gbb = B.gbB[col];
    bf16 qraw[16], kraw[16];
#pragma unroll
    for (int cc = 0; cc < 16; ++cc) { const size_t row = row0 + cgrp * 16 + cc; qraw[cc] = B.GQ[row * GKW + col]; kraw[cc] = B.GK[row * GKW + col]; }
    WG_BAR();
    float laf[16], lab[16];
#pragma unroll
    for (int cc = 0; cc < 16; ++cc) { const int c = cgrp * 16 + cc; float zf = gbf, zb = gbb;
#pragma unroll
        for (int r4 = 0; r4 < 4; ++r4) { const f32x4 a = *(const LAS f32x4*)(LR + c * 32 + 4 * r4), e = *(const LAS f32x4*)(LR + c * 32 + 16 + 4 * r4);
#pragma unroll
            for (int i = 0; i < 4; ++i) { zf += a[i] * gwf[4 * r4 + i]; zb += e[i] * gwb[4 * r4 + i]; } }
        laf[cc] = logsig16(zf); lab[cc] = logsig16(zb); }
#pragma unroll
    for (int cc = 1; cc < 16; ++cc) laf[cc] += laf[cc - 1];
#pragma unroll
    for (int cc = 14; cc >= 0; --cc) lab[cc] += lab[cc + 1];
    PS[cgrp * 128 + d] = laf[15]; PS[(4 + cgrp) * 128 + d] = lab[0];
    WG_BAR();
    float offf = 0.f, offb = 0.f, totf = 0.f, totb = 0.f;
#pragma unroll
    for (int g = 0; g < 4; ++g) { const float pf = PS[g * 128 + d], pb = PS[(4 + g) * 128 + d]; totf += pf; totb += pb; if (g < cgrp) offf += pf; if (g > cgrp) offb += pb; }
    float kef[16], keb[16];
#pragma unroll
    for (int cc = 0; cc < 16; ++cc) { const int c = cgrp * 16 + cc; const size_t row = row0 + c;
        const float Gf = laf[cc] + offf, Gb = lab[cc] + offb;
        const float q = bf2f(qraw[cc]), k = bf2f(kraw[cc]);
        const float qf = q * __expf(Gf), kf = k * __expf(-Gf), qb = q * __expf(Gb), kb = k * __expf(-Gb);
        kef[cc] = k * __expf(totf - Gf); keb[cc] = k * __expf(totb - Gb);
        const bf16 qfh = (bf16)f2bf(qf), qbh = (bf16)f2bf(qb);
        QF[c * GP + d] = qfh; KF[c * GP + d] = (bf16)f2bf(kf); QB[c * GP + d] = qbh; KB[c * GP + d] = (bf16)f2bf(kb);
        const size_t qo = (((size_t)(b * 64 + n) * 4 + h) * 64 + c) * 128 + d; B.QINF[qo] = qfh; B.QINB[qo] = qbh; }
    { v4u w0, w1; LAS unsigned char* dst = R2 + d * 144 + cgrp * 32;
      w0.x = pk2(kef[0], kef[1]); w0.y = pk2(kef[2], kef[3]); w0.z = pk2(kef[4], kef[5]); w0.w = pk2(kef[6], kef[7]);
      w1.x = pk2(kef[8], kef[9]); w1.y = pk2(kef[10], kef[11]); w1.z = pk2(kef[12], kef[13]); w1.w = pk2(kef[14], kef[15]);
      ((LAS v4u*)dst)[0] = w0; ((LAS v4u*)dst)[1] = w1;
      dst += 128 * 144;
      w0.x = pk2(keb[0], keb[1]); w0.y = pk2(keb[2], keb[3]); w0.z = pk2(keb[4], keb[5]); w0.w = pk2(keb[6], keb[7]);
      w1.x = pk2(keb[8], keb[9]); w1.y = pk2(keb[10], keb[11]); w1.z = pk2(keb[12], keb[13]); w1.w = pk2(keb[14], keb[15]);
      ((LAS v4u*)dst)[0] = w0; ((LAS v4u*)dst)[1] = w1; }
    if (cgrp == 0) { B.DECF[(size_t)(b * 64 + n) * GKW + col] = __expf(totf); B.DECB[(size_t)(b * 64 + n) * GKW + col] = __expf(totb); }
    WG_BAR();
    {
#pragma unroll
        for (int i = 0; i < 4; ++i) { const int pc = tid + 512 * (i & 1), dirb = i >> 1, row = pc >> 3, ch = pc & 7;
            const v4u v = *(const LAS v4u*)(R2 + dirb * (128 * 144) + row * 144 + ch * 16);
            *(v4u*)((dirb ? B.KETB : B.KETF) + ((size_t)(b * 64 + n) * GKW + h * 128) * 64 + pc * 8) = v; }
    }
    const int l31 = lane & 31, hi = lane >> 5;
    bf16x8 vt[2][2];
    { const bf16* vbase = B.GVT + ((size_t)(b * 64 + n) * GVW + h * 256 + 32 * wave + l31) * 64 + 4 * hi;
#pragma unroll
      for (int jt = 0; jt < 2; ++jt)
#pragma unroll
          for (int s = 0; s < 2; ++s) { const bf16* p = vbase + 32 * jt + 16 * s; vt[jt][s] = join8(*(const v2u*)p, *(const v2u*)(p + 8)); } }
    f32x16 o0 = {}, o1 = {};
    {
        f32x16 X = gla_xtile(KF, QF, 0, 0, l31, hi);
#pragma unroll
        for (int r = 0; r < 16; ++r) if (crow(r, hi) > l31) X[r] = 0.f;
        o0 = MFMA32(vt[0][0], pack8<0>(X), o0); o0 = MFMA32(vt[0][1], pack8<1>(X), o0);
        X = gla_xtile(KF, QF, 0, 1, l31, hi);
        o1 = MFMA32(vt[0][0], pack8<0>(X), o1); o1 = MFMA32(vt[0][1], pack8<1>(X), o1);
        X = gla_xtile(KF, QF, 1, 1, l31, hi);
#pragma unroll
        for (int r = 0; r < 16; ++r) if (crow(r, hi) > l31) X[r] = 0.f;
        o1 = MFMA32(vt[1][0], pack8<0>(X), o1); o1 = MFMA32(vt[1][1], pack8<1>(X), o1);
    }
    {
        f32x16 X = gla_xtile(KB, QB, 0, 0, l31, hi);
#pragma unroll
        for (int r = 0; r < 16; ++r) if (crow(r, hi) < l31) X[r] = 0.f;
        o0 = MFMA32(vt[0][0], pack8<0>(X), o0); o0 = MFMA32(vt[0][1], pack8<1>(X), o0);
        X = gla_xtile(KB, QB, 1, 0, l31, hi);
        o0 = MFMA32(vt[1][0], pack8<0>(X), o0); o0 = MFMA32(vt[1][1], pack8<1>(X), o0);
        X = gla_xtile(KB, QB, 1, 1, l31, hi);
#pragma unroll
        for (int r = 0; r < 16; ++r) if (crow(r, hi) < l31) X[r] = 0.f;
        o1 = MFMA32(vt[1][0], pack8<0>(X), o1); o1 = MFMA32(vt[1][1], pack8<1>(X), o1);
    }
    WG_BAR();
    { LAS unsigned char* ot = R2 + l31 * 528 + (32 * wave + 4 * hi) * 2;
#pragma unroll
      for (int g = 0; g < 4; ++g) { v2u w; w.x = cvtpk(o0[4 * g], o0[4 * g + 1]); w.y = cvtpk(o0[4 * g + 2], o0[4 * g + 3]); *(LAS v2u*)(ot + 16 * g) = w;
          v2u w1; w1.x = cvtpk(o1[4 * g], o1[4 * g + 1]); w1.y = cvtpk(o1[4 * g + 2], o1[4 * g + 3]); *(LAS v2u*)(ot + 32 * 528 + 16 * g) = w1; } }
    WG_BAR();
#pragma unroll
    for (int i = 0; i < 4; ++i) { const int pc = tid + 512 * i, row = pc >> 5, ch = pc & 31;
        *(v4u*)(B.OI + (row0 + row) * GVW + h * 256 + ch * 8) = *(const LAS v4u*)(R2 + row * 528 + ch * 16); }
}

constexpr int SC_Q = 0, SC_K = 17408, SC_V = 35840, SC_D = 54272, SC_STAGE = 54784;
struct ScanRegs { v4u q[8], k[8], v[8]; f32x4 d; };
constexpr int SC_DUMP = 2 * 54784, SC_OST = SC_DUMP + 2048, SC_OP = 272, SC_OSZ = 64 * SC_OP;
constexpr int SC_PF = 6;
__device__ __forceinline__ void gla_scan(int item, const GlaBufs& B, LAS unsigned char* lds, int tid, int lane, int wave) {
    const int half = item & 1, dir = (item >> 1) & 1, h = (item >> 2) & 3, b = item >> 4;
    const bf16* QIN = dir ? B.QINB : B.QINF; const bf16* KET = dir ? B.KETB : B.KETF; const float* DEC = dir ? B.DECB : B.DECF;
    bf16* OS = dir ? B.OSB : B.OSF;
    const int l31 = lane & 31, hi = lane >> 5;
    const int par = (wave >> 1) & 1, pl = 64 * (wave & 1) + lane;
#define SC_CHUNK(st) (dir ? 63 - (st) : (st))
#define SC_LOAD(R, st) do { const int nn_ = SC_CHUNK(st); const size_t cg_ = (size_t)b * 64 + nn_; \
        const v4u* qs_ = (const v4u*)(QIN + (cg_ * 4 + h) * (64 * 128)) + pl; const v4u* ks_ = (const v4u*)(KET + (cg_ * GKW + h * 128) * 64) + pl; \
        const v4u* vs_ = (const v4u*)(B.GVT + (cg_ * GVW + h * 256 + 128 * half) * 64) + pl;     \
        _Pragma("unroll") for (int i_ = 0; i_ < 8; ++i_) { R.q[i_] = qs_[128 * i_]; R.k[i_] = ks_[128 * i_]; R.v[i_] = vs_[128 * i_]; } \
        if (pl < 32) R.d = *(const f32x4*)(DEC + (size_t)(b * 64 + nn_) * GKW + h * 128 + pl * 4); } while (0)
#if PROBE_SCAN == 2
#define SC_LOAD2(R, st) do { SC_LOAD(R, st); _Pragma("unroll") for (int i_ = 0; i_ < 8; ++i_) asm volatile("" : "+v"(R.q[i_]), "+v"(R.k[i_]), "+v"(R.v[i_])); SC_LOAD(R, st); } while (0)
#else
#define SC_LOAD2(R, st) SC_LOAD(R, st)
#endif
#define SC_WRITE(R, sg) do { LAS unsigned char* s_ = lds + (sg) * SC_STAGE; \
        _Pragma("unroll") for (int i_ = 0; i_ < 8; ++i_) { const int pp_ = pl + 128 * i_; \
            *(LAS v4u*)(s_ + SC_Q + (pp_ >> 4) * 272 + (pp_ & 15) * 16) = R.q[i_]; \
            *(LAS v4u*)(s_ + SC_K + (pp_ >> 3) * 144 + (pp_ & 7) * 16) = R.k[i_]; \
            *(LAS v4u*)(s_ + SC_V + (pp_ >> 3) * 144 + (pp_ & 7) * 16) = R.v[i_]; } \
        if (pl < 32) *(LAS f32x4*)(s_ + SC_D + pl * 16) = R.d; } while (0)
    WG_BAR();
    if (wave >= 4) {
        ScanRegs R;
        const int t4 = tid & 255;
#define SC_OUT(so) do { const LAS unsigned char* ot_ = lds + SC_OST + ((so) & 1) * SC_OSZ; bf16* og_ = OS + ((size_t)b * SEQ + 64 * SC_CHUNK(so)) * GVW + h * 256 + 128 * half; \
        _Pragma("unroll") for (int i_ = 0; i_ < 4; ++i_) { const int p_ = t4 + 256 * i_; *(v4u*)(og_ + (size_t)(p_ >> 4) * GVW + (p_ & 15) * 8) = *(const LAS v4u*)(ot_ + (p_ >> 4) * SC_OP + (p_ & 15) * 16); } } while (0)
        if (par == 0) { SC_LOAD(R, 0); SC_WRITE(R, 0); SC_LOAD(R, 2); } else { SC_LOAD(R, 1); }
        WG_BAR();
        for (int st = 0; st < 64; ++st) {
            if (((st + 1) & 1) == par) { if (st + 1 < 64) SC_WRITE(R, (st + 1) & 1); if (st + 3 < 64) SC_LOAD2(R, st + 3); }
            if (st > 0) SC_OUT(st - 1);
            WG_BAR();
        }
        SC_OUT(63);
#undef SC_OUT
    } else {
        f32x16 S0 = {}, S1 = {}, S2 = {}, S3 = {};
        WG_BAR();
        for (int st = 0; st < 64; ++st) {
            const int n = SC_CHUNK(st); const LAS unsigned char* sg = lds + (st & 1) * SC_STAGE;
            if (st + SC_PF < 64) {
                const size_t cg_ = (size_t)b * 64 + SC_CHUNK(st + SC_PF); const int ln = 32 * wave + l31;
                const bf16* t0 = hi ? (KET + (cg_ * GKW + h * 128) * 64) : (QIN + (cg_ * 4 + h) * (64 * 128));
                const bf16* t1 = B.GVT + (cg_ * GVW + h * 256 + 128 * half) * 64;
                __builtin_amdgcn_global_load_lds((const unsigned*)(t0 + ln * 64), (LAS unsigned*)(lds + SC_DUMP + wave * 512), 4, 0, 0);
                __builtin_amdgcn_global_load_lds((const unsigned*)(t1 + ln * 64), (LAS unsigned*)(lds + SC_DUMP + wave * 512 + 256), 4, 0, 0);
            }
            const LAS unsigned char* qb0 = sg + SC_Q + l31 * 272 + 8 * hi; const LAS unsigned char* qb1 = qb0 + 32 * 272;
            bf16x8 q0[8], q1[8];
#pragma unroll
            for (int k = 0; k < 8; ++k) { q0[k] = join8(*(const LAS v2u*)(qb0 + 32 * k), *(const LAS v2u*)(qb0 + 32 * k + 16)); q1[k] = join8(*(const LAS v2u*)(qb1 + 32 * k), *(const LAS v2u*)(qb1 + 32 * k + 16)); }
            bf16x8 sa[8];
            sa[0] = pack8<0>(S0); sa[1] = pack8<1>(S0); sa[2] = pack8<0>(S1); sa[3] = pack8<1>(S1); sa[4] = pack8<0>(S2); sa[5] = pack8<1>(S2); sa[6] = pack8<0>(S3); sa[7] = pack8<1>(S3);
            f32x16 i0 = {}, i1 = {};
#pragma unroll
            for (int k = 0; k < 8; ++k) { i0 = MFMA32(sa[k], q0[k], i0); i1 = MFMA32(sa[k], q1[k], i1); }
#if PROBE_SCAN == 1
            { f32x16 j0 = {}, j1 = {};
              _Pragma("unroll") for (int k = 0; k < 8; ++k) { asm volatile("" : "+v"(sa[k])); j0 = MFMA32(sa[k], q0[k], j0); j1 = MFMA32(sa[k], q1[k], j1); }
              asm volatile("" :: "v"(j0), "v"(j1)); }
#endif
            __builtin_amdgcn_sched_barrier(0);
            const LAS unsigned char* vb_ = sg + SC_V + (32 * wave + l31) * 144 + 16 * hi;
            f32x4 dv[16]; bf16x8 vf[4];
#pragma unroll
            for (int k = 0; k < 16; ++k) dv[k] = *(const LAS f32x4*)(sg + SC_D + (32 * (k >> 2) + 8 * (k & 3) + 4 * hi) * 4);
#pragma unroll
            for (int s = 0; s < 4; ++s) vf[s] = *(const LAS bf16x8*)(vb_ + 32 * s);
#pragma unroll
            for (int g = 0; g < 4; ++g) {
#pragma unroll
                for (int i = 0; i < 4; ++i) { S0[4 * g + i] *= dv[g][i]; S1[4 * g + i] *= dv[4 + g][i]; S2[4 * g + i] *= dv[8 + g][i]; S3[4 * g + i] *= dv[12 + g][i]; } }
            __builtin_amdgcn_sched_barrier(0);
            const LAS unsigned char* kb_ = sg + SC_K + l31 * 144 + 16 * hi;
            bf16x8 kf[16];
#pragma unroll
            for (int k = 0; k < 16; ++k) kf[k] = *(const LAS bf16x8*)(kb_ + (32 * (k >> 2)) * 144 + 32 * (k & 3));
#pragma unroll
            for (int s = 0; s < 4; ++s) { S0 = MFMA32(kf[s], vf[s], S0); S1 = MFMA32(kf[4 + s], vf[s], S1); S2 = MFMA32(kf[8 + s], vf[s], S2); S3 = MFMA32(kf[12 + s], vf[s], S3); }
            __builtin_amdgcn_sched_barrier(0);
            { LAS unsigned char* ot = lds + SC_OST + (st & 1) * SC_OSZ + l31 * SC_OP + (32 * wave + 4 * hi) * 2;
#pragma unroll
              for (int g = 0; g < 4; ++g) {
                  v2u w; w.x = cvtpk(i0[4 * g], i0[4 * g + 1]); w.y = cvtpk(i0[4 * g + 2], i0[4 * g + 3]); *(LAS v2u*)(ot + 16 * g) = w;
                  v2u w1; w1.x = cvtpk(i1[4 * g], i1[4 * g + 1]); w1.y = cvtpk(i1[4 * g + 2], i1[4 * g + 3]); *(LAS v2u*)(ot + 32 * SC_OP + 16 * g) = w1; } }
            WG_BAR();
        }
    }
#undef SC_CHUNK
#undef SC_LOAD
#undef SC_WRITE
}

struct AttnBufs { const bf16* AQ; const bf16* AK; const bf16* AV; const float* BIAS2; bf16* OP; float* LSE; };
constexpr int AT_KP = 144;
constexpr int AT_VT = 384 * AT_KP;
constexpr int AT_VP = 784;
constexpr int AT_BT = AT_VT + 64 * AT_VP;
constexpr int AT_OS = AT_BT + 4 * 784, AT_OP = 144;
struct AttnPre { v4u k[6]; v4u v[6]; bf16x8 q[4]; float bt[2]; };
struct AttnUnit { int b, h, p, r, L, j, kb; };
__device__ __forceinline__ AttnUnit attn_decode(int u) {
    AttnUnit U; const int bh = u / 48, w48 = u % 48, idx = w48 & 15; U.p = w48 >> 4; U.b = bh >> 4; U.h = bh & 15;
    U.r = (U.p == 0) ? 1 : (U.p == 1 ? 4 : 16); U.L = SEQ / U.r;
    U.j = (U.p == 0) ? 0 : (U.p == 1 ? (idx >> 2) : idx); U.kb = (U.p == 0) ? idx : (U.p == 1 ? (idx & 3) : 0);
    return U;
}
__device__ __forceinline__ void attn_issue(const AttnUnit& U, const AttnBufs& A, AttnPre& R, int tid, int lane, int wave) {
    const size_t hb = (size_t)(U.b * AH + U.h) * SEQ; const int wbase = U.kb * 256 - 64;
    const v4u z = {0u, 0u, 0u, 0u};
#pragma unroll
    for (int i = 0; i < 6; ++i) { const int pc = tid + 512 * i, sp = wbase + (pc >> 3);
        R.k[i] = z; if (sp >= 0 && sp < U.L) R.k[i] = *(const v4u*)(A.AK + (hb + (size_t)sp * U.r + U.j) * AD + (pc & 7) * 8); }
#pragma unroll
    for (int g = 0; g < 3; ++g) { const int sp0 = wbase + 2 * (64 * g + lane), sp1 = sp0 + 1;
        R.v[2 * g] = z; R.v[2 * g + 1] = z;
        if (sp0 >= 0 && sp0 < U.L) R.v[2 * g] = *(const v4u*)(A.AV + (hb + (size_t)sp0 * U.r + U.j) * AD + 8 * wave);
        if (sp1 >= 0 && sp1 < U.L) R.v[2 * g + 1] = *(const v4u*)(A.AV + (hb + (size_t)sp1 * U.r + U.j) * AD + 8 * wave); }
    { const int l31 = lane & 31, hi = lane >> 5; const size_t tq = hb + (size_t)(U.kb * 256 + 32 * wave + l31) * U.r + U.j;
#pragma unroll
      for (int d0 = 0; d0 < 4; ++d0) R.q[d0] = *(const bf16x8*)(A.AQ + tq * AD + 16 * d0 + 8 * hi); }
#pragma unroll
    for (int i = 0; i < 2; ++i) { const int e = tid + 512 * i; float v = -INFINITY;
        if (e < 4 * 196) { const int dl = (e % 196) + (e / 196) - 95; if (dl >= -64 && dl <= 64) v = A.BIAS2[(U.p * 129 + dl + 64) * 16 + U.h]; }
        R.bt[i] = v; }
}
__device__ __forceinline__ void attn_stage(const AttnPre& R, LAS unsigned char* lds, int tid, int lane, int wave) {
#pragma unroll
    for (int i = 0; i < 6; ++i) { const int pc = tid + 512 * i; *(LAS v4u*)(lds + (pc >> 3) * AT_KP + (pc & 7) * 16) = R.k[i]; }
#pragma unroll
    for (int g = 0; g < 3; ++g) { const int kk0 = 2 * (64 * g + lane); const v4u a = R.v[2 * g], c2 = R.v[2 * g + 1];
        const int w16 = kk0 & 15, slot = (kk0 & ~15) | (w16 & 3) | (((w16 >> 3) & 1) << 2) | (((w16 >> 2) & 1) << 3);
        LAS unsigned char* dst = lds + AT_VT + (8 * wave) * AT_VP + slot * 2;
        *(LAS unsigned*)(dst + 0 * AT_VP) = (a.x & 0xffffu) | (c2.x << 16);
        *(LAS unsigned*)(dst + 1 * AT_VP) = (a.x >> 16) | (c2.x & 0xffff0000u);
        *(LAS unsigned*)(dst + 2 * AT_VP) = (a.y & 0xffffu) | (c2.y << 16);
        *(LAS unsigned*)(dst + 3 * AT_VP) = (a.y >> 16) | (c2.y & 0xffff0000u);
        *(LAS unsigned*)(dst + 4 * AT_VP) = (a.z & 0xffffu) | (c2.z << 16);
        *(LAS unsigned*)(dst + 5 * AT_VP) = (a.z >> 16) | (c2.z & 0xffff0000u);
        *(LAS unsigned*)(dst + 6 * AT_VP) = (a.w & 0xffffu) | (c2.w << 16);
        *(LAS unsigned*)(dst + 7 * AT_VP) = (a.w >> 16) | (c2.w & 0xffff0000u); }
#pragma unroll
    for (int i = 0; i < 2; ++i) { const int e = tid + 512 * i; if (e < 4 * 196) ((LAS float*)(lds + AT_BT))[e] = R.bt[i]; }
}
__device__ __forceinline__ void attn_compute(const AttnUnit& U, const AttnBufs& A, const bf16x8 (&qf)[4], LAS unsigned char* lds, int lane, int wave) {
    const int l31 = lane & 31, hi = lane >> 5;
    const int i0 = U.kb * 256 + 32 * wave;
    const size_t tq = (size_t)U.b * SEQ + (size_t)(i0 + l31) * U.r + U.j;
    f32x16 S[5];
    const int cshift = 3 - (l31 & 3);
    const LAS unsigned char* btl = lds + AT_BT + cshift * 784 + (4 * hi + 28 - 4 * (l31 >> 2)) * 4;
    const LAS unsigned char* kbp = lds + (32 * wave + l31) * AT_KP + 16 * hi;
    float m = -INFINITY;
#pragma unroll
    for (int t = 0; t < 5; ++t) { const int sb = i0 - 64 + 32 * t;
        if (sb >= 0 && sb < U.L) {
            bf16x8 kf[4];
#pragma unroll
            for (int d0 = 0; d0 < 4; ++d0) kf[d0] = *(const LAS bf16x8*)(kbp + (32 * t) * AT_KP + 32 * d0);
            f32x4 bv[4];
#pragma unroll
            for (int g = 0; g < 4; ++g) bv[g] = *(const LAS f32x4*)(btl + (32 * t + 8 * g) * 4);
            f32x16 acc = {};
#pragma unroll
            for (int d0 = 0; d0 < 4; ++d0) acc = MFMA32(kf[d0], qf[d0], acc);
#pragma unroll
            for (int g = 0; g < 4; ++g)
#pragma unroll
                for (int i = 0; i < 4; ++i) { acc[4 * g + i] += bv[g][i]; m = fmaxf(m, acc[4 * g + i]); }
            S[t] = acc;
        } else {
#pragma unroll
            for (int i = 0; i < 16; ++i) S[t][i] = -INFINITY;
        } }
    m = fmaxf(m, __shfl_xor(m, 32));
    float ssum = 0.f;
#pragma unroll
    for (int t = 0; t < 5; ++t)
#pragma unroll
        for (int i = 0; i < 16; ++i) { const float e = exp2f(S[t][i] - m); S[t][i] = e; ssum += e; }
    ssum += __shfl_xor(ssum, 32);
    f32x16 o0 = {}, o1 = {};
    const LAS unsigned char* vb = lds + AT_VT + l31 * AT_VP + (32 * wave) * 2 + 16 * hi;
#pragma unroll
    for (int t = 0; t < 5; ++t) { const int sb = i0 - 64 + 32 * t;
        if (sb >= 0 && sb < U.L) {
            const bf16x8 v00 = *(const LAS bf16x8*)(vb + (32 * t) * 2), v01 = *(const LAS bf16x8*)(vb + (32 * t + 16) * 2);
            const bf16x8 v10 = *(const LAS bf16x8*)(vb + 32 * AT_VP + (32 * t) * 2), v11 = *(const LAS bf16x8*)(vb + 32 * AT_VP + (32 * t + 16) * 2);
            const bf16x8 p0 = pack8<0>(S[t]), p1 = pack8<1>(S[t]);
            o0 = MFMA32(v00, p0, o0); o0 = MFMA32(v01, p1, o0);
            o1 = MFMA32(v10, p0, o1); o1 = MFMA32(v11, p1, o1);
        } }
    const float inv = 1.0f / ssum;
    { LAS unsigned char* ot = lds + AT_OS + wave * (32 * AT_OP) + l31 * AT_OP + 8 * hi;
#pragma unroll
      for (int g = 0; g < 4; ++g) { v2u w; w.x = cvtpk(o0[4 * g] * inv, o0[4 * g + 1] * inv); w.y = cvtpk(o0[4 * g + 2] * inv, o0[4 * g + 3] * inv); *(LAS v2u*)(ot + 16 * g) = w;
          v2u w1; w1.x = cvtpk(o1[4 * g] * inv, o1[4 * g + 1] * inv); w1.y = cvtpk(o1[4 * g + 2] * inv, o1[4 * g + 3] * inv); *(LAS v2u*)(ot + 64 + 16 * g) = w1; }
      asm volatile("s_waitcnt lgkmcnt(0)" ::: "memory");
      bf16* ob = A.OP + (size_t)U.p * ((size_t)T_ * AW) + U.h * AD;
#pragma unroll
      for (int i = 0; i < 4; ++i) { const int pc = lane + 64 * i, row = pc >> 3, ch = pc & 7;
          const v4u v = *(const LAS v4u*)(lds + AT_OS + wave * (32 * AT_OP) + row * AT_OP + ch * 16);
          *(v4u*)(ob + ((size_t)U.b * SEQ + (size_t)(i0 + row) * U.r + U.j) * AW + ch * 8) = v; } }
    if (hi == 0) A.LSE[(size_t)U.p * ((size_t)T_ * AH) + tq * AH + U.h] = m + log2f(ssum);
}
__device__ __forceinline__ void attn_units(int u0, int ustep, const AttnBufs& A, LAS unsigned char* lds, int tid, int lane, int wave) {
    if (u0 >= 1536) return;
    AttnPre R; AttnUnit U = attn_decode(u0);
    attn_issue(U, A, R, tid, lane, wave);
    for (int u = u0; u < 1536; u += ustep) {
        WG_BAR();
        attn_stage(R, lds, tid, lane, wave);
        bf16x8 qf[4];
#pragma unroll
        for (int d0 = 0; d0 < 4; ++d0) qf[d0] = R.q[d0];
        const AttnUnit Uc = U;
        if (u + ustep < 1536) { U = attn_decode(u + ustep); attn_issue(U, A, R, tid, lane, wave); }
        WG_BAR();
        attn_compute(Uc, A, qf, lds, lane, wave);
    }
}
__global__ void __launch_bounds__(NWAVES * 64, 2) fwd(Args args) {
    extern __shared__ __attribute__((aligned(16))) unsigned char lds_raw[];
    LAS unsigned char* lds = (LAS unsigned char*)lds_raw;
    const int tid = threadIdx.x, lane = tid & 63, wave = __builtin_amdgcn_readfirstlane(tid >> 6);
    const int G = gridDim.x; const int bx = blockIdx.x; const int vcu = (G % 8 == 0) ? (bx % 8) * (G / 8) + bx / 8 : bx;
    const int gw = vcu * NWAVES + wave, NGW = G * NWAVES;
    unsigned char* ws = args.ws;
    const float* x = args.in[0]; float* out = args.out;
    bf16* Wt_in = (bf16*)(ws + WS_WIN); bf16* Wt_out = (bf16*)(ws + WS_WOUT); bf16* Wt_gu = (bf16*)(ws + WS_WGU); bf16* Wt_dn = (bf16*)(ws + WS_WDN);
    bf16* XN = (bf16*)(ws + WS_XN); bf16* RB = (bf16*)(ws + WS_RB);
    float* BIAS2 = (float*)(ws + WS_BIAS2); float* SSQ1 = (float*)(ws + WS_SSQ1);
    float* GLR = (float*)(RB + E_GLR);
    GlaBufs GB;
    GB.GQ = RB + E_GQ; GB.GK = RB + E_GK; GB.GVT = RB + E_GVT; GB.GLR = GLR;
    GB.OI = (bf16*)(ws + WS_XN); GB.QINF = GB.OI + (size_t)T_ * 1024; GB.QINB = GB.QINF + (size_t)T_ * 512;
    GB.KETF = (bf16*)(ws + WS_WIN); GB.KETB = GB.KETF + (size_t)T_ * 512;
    GB.DECF = (float*)(ws + WS_WIN + 16 * MiB); GB.DECB = GB.DECF + 128 * 512;
    GB.OSF = RB + E_GQ; GB.OSB = (bf16*)((unsigned char*)out + 48 * MiB);
    GB.gwF = args.in[4]; GB.gbF = args.in[5]; GB.gwB = args.in[6]; GB.gbB = args.in[7];
    bf16* Y = RB;
    bf16* X1B = (bf16*)(ws + WS_XN);
    bf16* HB = RB;
    AttnBufs AB; AB.AQ = RB + E_AQ; AB.AK = RB + E_AK; AB.AV = RB + E_AV; AB.BIAS2 = BIAS2;
    AB.OP = (bf16*)out; AB.LSE = (float*)(ws + WS_WIN + 17 * MiB);
    const int lo = args.ph_lo, hi = args.ph_hi;
#define IN(k) (lo <= (k) && (k) < hi)
    volatile LAS unsigned* bst = (volatile LAS unsigned*)(lds + LDS_BYTES - 16);
    if (tid < 2) bst[tid] = 0u;
    __syncthreads();
    const XcdBarrier gbar = xcd_barrier_post((unsigned*)ws, bst);
#define SEAM(k) do { if (IN(k) && IN((k) + 1)) { xcd_barrier(gbar); } } while (0)
    unsigned long long* TS = (unsigned long long*)(ws + 768 * 1024);
#define STAMP(k) do { if (PROBE_TS && tid == 0) TS[bx * 16 + (k)] = __builtin_amdgcn_s_memrealtime(); } while (0)

    P0Ptrs PP; PP.w_in = args.in[2]; PP.w_out = args.in[9]; PP.w_gate = args.in[11]; PP.w_up = args.in[12]; PP.w_down = args.in[13]; PP.ffn_w = args.in[10];
    PP.Wt_in = Wt_in; PP.Wt_out = Wt_out; PP.Wt_gu = Wt_gu; PP.Wt_dn = Wt_dn;

    if (IN(0)) {
        LAS float* scr = (LAS float*)(lds + wave * 16384);
        p0_run(0, P0_FIRST, gw, NGW, PP, scr, lane);
        const float* nw = args.in[1];
        for (int m = gw; m < T_; m += NGW) {
            const f32x4* xr = (const f32x4*)(x + (size_t)m * DM) + lane; f32x4 v[8]; float s = 0.f;
#pragma unroll
            for (int j = 0; j < 8; ++j) { v[j] = xr[64 * j]; s += (v[j][0] * v[j][0] + v[j][1] * v[j][1]) + (v[j][2] * v[j][2] + v[j][3] * v[j][3]); }
            const float rstd = rsqrtf(wave_sum(s) * (1.f / DM) + NORM_EPS);
            v2u* o8 = (v2u*)(XN + (size_t)m * DM) + lane;
#pragma unroll
            for (int j = 0; j < 8; ++j) { const f32x4 w = ((const f32x4*)nw)[lane + 64 * j]; v2u o; o.x = pk2(v[j][0] * rstd * w[0], v[j][1] * rstd * w[1]); o.y = pk2(v[j][2] * rstd * w[2], v[j][3] * rstd * w[3]); o8[64 * j] = o; }
        }
        if (bx == 0) {
            const float* tbl = args.in[3];
            for (int idx = tid; idx < 3 * 129; idx += NWAVES * 64) { const int p = idx / 129, s = idx % 129; const int r = (p == 0) ? 1 : (p == 1 ? 4 : 16);
                const int bk = t5_bucket((s - 64) * r);
                for (int h = 0; h < 16; ++h) BIAS2[idx * 16 + h] = tbl[bk * 16 + h] * LOG2E; }
        }
    }
    SEAM(0);

    if (IN(1)) {
        { pg8::Gemm g{XN, Wt_in, T_, 5120, DM}; pg8::StaticOrder S; S.init(T_, 5120, G, bx); pg8::EpiProj E{RB};
          pg8::gemm_phase<pg8::EpiProj, pg8::StaticOrder, true, true>(lds, g, S, E); }
        { pg8::Gemm g{Wt_in + (size_t)5120 * DM, XN, 1024, T_, DM}; pg8::StaticOrder S; S.init(1024, T_, G, (bx + G / 2) % G); pg8::EpiPlain E{RB + E_GVT, 1024};
          pg8::gemm_phase<pg8::EpiPlain, pg8::StaticOrder, true, true>(lds, g, S, E); }
        for (int tb = bx; tb < T_ / 32; tb += G) {
            const int l31 = lane & 31, hi5 = lane >> 5;
            const bf16* ap = XN + (size_t)(tb * 32 + l31) * DM + 256 * wave + 8 * hi5; const bf16* bp = Wt_in + (size_t)(6144 + l31) * DM + 256 * wave + 8 * hi5;
            bf16x8 af[16], bfr[16];
#pragma unroll
            for (int s = 0; s < 16; ++s) { af[s] = *(const bf16x8*)(ap + 16 * s); bfr[s] = *(const bf16x8*)(bp + 16 * s); }
            f32x16 acc = {};
#pragma unroll
            for (int s = 0; s < 16; ++s) acc = MFMA32(af[s], bfr[s], acc);
            __syncthreads();
            LAS float* part = (LAS float*)lds;
#pragma unroll
            for (int r = 0; r < 16; ++r) part[(wave * 16 + r) * 64 + lane] = acc[r];
            __syncthreads();
#pragma unroll
            for (int rr = 0; rr < 2; ++rr) { const int r = 2 * wave + rr; float s = 0.f;
#pragma unroll
                for (int w = 0; w < 8; ++w) s += part[(w * 16 + r) * 64 + lane];
                GLR[(size_t)(tb * 32 + crow(r, hi5)) * 32 + l31] = s; }
        }
    }
    SEAM(1);

    if (IN(2)) {
        for (int it = bx; it < 512; it += G) gla_unit(it, GB, lds, tid, lane, wave);
    }
    SEAM(2);

    if (IN(3)) {
        if (bx < 32) gla_scan((bx & 7) * 4 + (bx >> 3), GB, lds, tid, lane, wave);
        else {
            attn_units(bx - 32, G - 32, AB, lds, tid, lane, wave);
            WG_BAR();
            p0_run(P0_FIRST, P0_NITEMS, (bx - 32) * NWAVES + wave, (G - 32) * NWAVES, PP, (LAS float*)(lds + wave * 16384), lane);
        }
    }
    SEAM(3);

    if (IN(4)) {
        const bf16* GR = RB + E_GR; const float* gnw = args.in[8];
        constexpr int MR = 8;
        for (int item = gw; item < (T_ / MR) * 4; item += NGW) { const int row0 = (item >> 2) * MR, part = item & 3;
            if (part < 2) {
                const int hh = 8 * part + (lane >> 3);
                float l0[MR], l1[MR], l2[MR]; v4u a0[MR], a1[MR], a2[MR];
#pragma unroll
                for (int r = 0; r < MR; ++r) { const size_t row = row0 + r; const size_t eo = row * AW + part * 512 + lane * 8;
                    l0[r] = AB.LSE[row * AH + hh]; l1[r] = AB.LSE[(size_t)T_ * AH + row * AH + hh]; l2[r] = AB.LSE[(size_t)2 * T_ * AH + row * AH + hh];
                    a0[r] = *(const v4u*)(AB.OP + eo); a1[r] = *(const v4u*)(AB.OP + (size_t)T_ * AW + eo); a2[r] = *(const v4u*)(AB.OP + (size_t)2 * T_ * AW + eo); }
#pragma unroll
                for (int r = 0; r < MR; ++r) {
                    const float M = fmaxf(fmaxf(l0[r], l1[r]), l2[r]); float w0 = exp2f(l0[r] - M), w1 = exp2f(l1[r] - M), w2 = exp2f(l2[r] - M); const float iw = 1.0f / (w0 + w1 + w2);
                    w0 *= iw; w1 *= iw; w2 *= iw;
                    v4u ov;
#pragma unroll
                    for (int k = 0; k < 4; ++k) { const unsigned x0 = a0[r][k], x1 = a1[r][k], x2 = a2[r][k];
                        ov[k] = pk2(w0 * bflo(x0) + w1 * bflo(x1) + w2 * bflo(x2), w0 * bfhi(x0) + w1 * bfhi(x1) + w2 * bfhi(x2)); }
                    *(v4u*)(Y + (size_t)(row0 + r) * DM + part * 512 + lane * 8) = ov; }
            } else { const int h = 2 * (part - 2) + (lane >> 5);
                v4u a[MR], c[MR], e[MR], g[MR];
#pragma unroll
                for (int r = 0; r < MR; ++r) { const size_t o = (size_t)(row0 + r) * GVW + (part - 2) * 512 + lane * 8;
                    a[r] = *(const v4u*)(GB.OI + o); c[r] = *(const v4u*)(GB.OSF + o); e[r] = *(const v4u*)(GB.OSB + o); g[r] = *(const v4u*)(GR + o); }
                const f32x4 wa = *(const f32x4*)(gnw + (part - 2) * 512 + lane * 8), wb = *(const f32x4*)(gnw + (part - 2) * 512 + lane * 8 + 4);
                const float w[8] = {wa[0], wa[1], wa[2], wa[3], wb[0], wb[1], wb[2], wb[3]};
                (void)h;
#pragma unroll
                for (int r = 0; r < MR; ++r) {
                    float v[8], gr[8]; float ss = 0.f;
#pragma unroll
                    for (int k = 0; k < 4; ++k) { v[2 * k] = bflo(a[r][k]) + bflo(c[r][k]) + bflo(e[r][k]); v[2 * k + 1] = bfhi(a[r][k]) + bfhi(c[r][k]) + bfhi(e[r][k]);
                        gr[2 * k] = bflo(g[r][k]); gr[2 * k + 1] = bfhi(g[r][k]); ss += v[2 * k] * v[2 * k] + v[2 * k + 1] * v[2 * k + 1]; }
#pragma unroll
                    for (int o = 1; o < 32; o <<= 1) ss += __shfl_xor(ss, o);
                    const float rstd = rsqrtf(ss * (1.0f / 256.0f) + NORM_EPS);
                    v4u ov;
#pragma unroll
                    for (int k = 0; k < 4; ++k) { const float y0 = v[2 * k] * rstd * w[2 * k] * (gr[2 * k] / (1.0f + __expf(-gr[2 * k]))), y1 = v[2 * k + 1] * rstd * w[2 * k + 1] * (gr[2 * k + 1] / (1.0f + __expf(-gr[2 * k + 1])));
                        ov[k] = pk2(y0, y1); }
                    *(v4u*)(Y + (size_t)(row0 + r) * DM + 1024 + (part - 2) * 512 + lane * 8) = ov; }
            }
        }
    }
    SEAM(4);

    if (IN(5)) {
        pg8::Gemm g{Y, Wt_out, T_, DM, DM}; pg8::StaticOrder S; S.init(T_, DM, G, bx); pg8::EpiRes<true> E{x, out, X1B, SSQ1};
        pg8::gemm_phase<pg8::EpiRes<true>, pg8::StaticOrder, false, true>(lds, g, S, E);
    }
    SEAM(5);

    if (IN(6)) {
        pg8::Gemm g{X1B, Wt_gu, T_, 2 * FF, DM}; pg8::StaticOrder S; S.init(T_, 2 * FF, G, bx); pg8::EpiSwiglu E{HB, SSQ1};
        pg8::gemm_phase<pg8::EpiSwiglu, pg8::StaticOrder, true, true>(lds, g, S, E);
    }
    SEAM(6);

    if (IN(7)) {
        pg8::Gemm g{HB, Wt_dn, T_, DM, FF}; pg8::StaticOrder S; S.init(T_, DM, G, bx); pg8::EpiRes<false> E{out, out, nullptr, nullptr};
        pg8::gemm_phase<pg8::EpiRes<false>, pg8::StaticOrder, false, true>(lds, g, S, E);
    }
    SEAM(7);

    if (IN(8)) {
        const float* fw = args.in[14];
        for (int m = gw; m < T_; m += NGW) {
            f32x4* xr = (f32x4*)(out + (size_t)m * DM) + lane; f32x4 v[8]; float s = 0.f;
#pragma unroll
            for (int j = 0; j < 8; ++j) { v[j] = xr[64 * j]; s += (v[j][0] * v[j][0] + v[j][1] * v[j][1]) + (v[j][2] * v[j][2] + v[j][3] * v[j][3]); }
            const float rstd = rsqrtf(wave_sum(s) * (1.f / DM) + NORM_EPS);
#pragma unroll
            for (int j = 0; j < 8; ++j) { const f32x4 w = ((const f32x4*)fw)[lane + 64 * j]; xr[64 * j] = v[j] * rstd * w; }
        }
    }
#if PROBE_TS
    cg::this_grid().sync();
    if (bx == 0) {
        const float A = 10.0f * floorf((float)(TS[PROBE_A_WG * 16 + PROBE_A_K1] - TS[PROBE_A_WG * 16 + PROBE_A_K0]) * 0.001f + 0.5f);
        const float Bv = 10.0f * floorf((float)(TS[PROBE_B_WG * 16 + PROBE_B_K1] - TS[PROBE_B_WG * 16 + PROBE_B_K0]) * 0.001f + 0.5f);
        if (tid == 0) out[0] = A;
        for (int i = 0; i < 2048; ++i) out[1024 + tid + 512 * i] += Bv * 0.01f;
    }
#endif
#undef IN
#undef SEAM
}

extern "C" void kernel_launch(void* const* d_in, const int* in_sizes, int n_in, void* d_out, int out_size, void* d_ws, size_t ws_size, hipStream_t stream) {
    static int grid = 0;
    if (grid == 0) {
        if (n_in != 15 || out_size != T_ * DM || ws_size < WS_END) { fprintf(stderr, "kernel_launch: unexpected shapes (n_in %d out %d ws %zu)\n", n_in, out_size, ws_size); grid = -1; return; }
        int dev = 0, cus = 0, per_cu = 0;
        if (hipGetDevice(&dev) != hipSuccess || hipDeviceGetAttribute(&cus, hipDeviceAttributeMultiprocessorCount, dev) != hipSuccess) { grid = -1; return; }
        if (hipFuncSetAttribute((const void*)fwd, hipFuncAttributeMaxDynamicSharedMemorySize, LDS_BYTES) != hipSuccess) { fprintf(stderr, "kernel_launch: hipFuncSetAttribute failed\n"); grid = -1; return; }
        if (hipOccupancyMaxActiveBlocksPerMultiprocessor(&per_cu, (const void*)fwd, NWAVES * 64, LDS_BYTES) != hipSuccess || per_cu < 1) { fprintf(stderr, "kernel_launch: occupancy query reports %d\n", per_cu); per_cu = 1; }
        (void)hipGetLastError();
        if (cus < 64) { fprintf(stderr, "kernel_launch: built for a 256-CU device (got %d CUs)\n", cus); grid = -1; return; }
        grid = cus;
    }
    if (grid < 0) return;
    (void)hipMemsetAsync(d_ws, 0, 16384, stream);
    Args a{};
    for (int i = 0; i < 15; ++i) a.in[i] = (const float*)d_in[i];
    a.out = (float*)d_out; a.ws = (unsigned char*)d_ws;
#if MK_LAUNCHES == 1
    void* kargs[] = {&a};
#if PROBE_PREFIX > 0
    a.ph_lo = 0; a.ph_hi = PROBE_PREFIX;
    (void)hipLaunchCooperativeKernel((const void*)fwd, dim3(grid), dim3(NWAVES * 64), kargs, LDS_BYTES, stream);
#endif
    a.ph_lo = 0; a.ph_hi = NPHASE;
    hipError_t e = hipLaunchCooperativeKernel((const void*)fwd, dim3(grid), dim3(NWAVES * 64), kargs, LDS_BYTES, stream);
    if (e != hipSuccess) fprintf(stderr, "kernel_launch: cooperative launch failed: %s (grid %d)\n", hipGetErrorString(e), grid);
#else
    for (int p = 0; p < NPHASE; ++p) { a.ph_lo = p; a.ph_hi = p + 1; hipLaunchKernelGGL(fwd, dim3(grid), dim3(NWAVES * 64), LDS_BYTES, stream, a); }
#endif
}
```
